# Optimizing an MI355X kernel written in HIP

```python
import jax, jax.numpy as jnp
from jax import lax
import numpy as np

D_MODEL = 1024
BATCH = 2
SEQ = 16384
DEPTH = 1
DEC_BATCH = 32
DEC_SEQ = 16
PAST_LEN = 4096

CHUNK = 64
HEAD_K = 128
HEAD_V = 128
N_HEADS = D_MODEL // HEAD_V
KEY_DIM = N_HEADS * HEAD_K
VAL_DIM = N_HEADS * HEAD_V
QKV_DIM = 2 * KEY_DIM + VAL_DIM
GDN_CONV = 4
SC_WIDTH = D_MODEL
SC_CONV = 3
D_FF = 2816
FFN_CONV = 3
IN_DIM = QKV_DIM + VAL_DIM + 2 * N_HEADS + 3 * SC_WIDTH + 2 * D_MODEL
ALPHA = (2 * DEPTH) ** 0.25
BETA_INIT = (8 * DEPTH) ** -0.25
LN_EPS = 1e-5
NORM_EPS = 1e-6

kernel_name = "hybrid_gdn_shortconv_convglu_stream_step"


def causal_dwconv(x, w, hist):
    K = w.shape[0]
    T = x.shape[1]
    xp = jnp.concatenate([hist.astype(x.dtype), x], axis=1)
    y = xp[:, :T] * w[0]
    for j in range(1, K):
        y = y + xp[:, j:j + T] * w[j]
    return y, xp[:, xp.shape[1] - (K - 1):]


def layer_norm(x, g, b):
    xf = x.astype(jnp.float32)
    mu = jnp.mean(xf, axis=-1, keepdims=True)
    var = jnp.mean(jnp.square(xf - mu), axis=-1, keepdims=True)
    return ((xf - mu) * lax.rsqrt(var + LN_EPS) * g.astype(jnp.float32) + b.astype(jnp.float32)).astype(x.dtype)


def l2norm(x):
    return x * lax.rsqrt(jnp.sum(x * x, axis=-1, keepdims=True) + NORM_EPS)


def gated_delta_chunked(q, k, v, g, beta, S0, block):
    Bsz, T, H, dk = q.shape
    dv = v.shape[-1]
    N = T // block

    def to_blocks(a):
        return a.reshape((Bsz, N, block, H) + a.shape[3:]).swapaxes(2, 3)

    qc, kc, vc = to_blocks(q), to_blocks(k), to_blocks(v)
    gc, bc = to_blocks(g), to_blocks(beta)
    G = jnp.cumsum(gc, axis=-1)
    causal = jnp.tril(jnp.ones((block, block), dtype=bool))
    strict = jnp.tril(jnp.ones((block, block), dtype=bool), -1)
    decay = jnp.exp(jnp.where(causal, G[..., :, None] - G[..., None, :], -jnp.inf))
    kk = jnp.einsum('bnhid,bnhjd->bnhij', kc, kc)
    A = jnp.where(strict, bc[..., :, None] * kk * decay, 0.0)
    eye = jnp.eye(block, dtype=jnp.float32)
    rhs = jnp.concatenate([vc * bc[..., None], kc * (bc * jnp.exp(G))[..., None]], axis=-1)
    sol = lax.linalg.triangular_solve(A + eye, rhs, left_side=True, lower=True, unit_diagonal=True)
    u, w = sol[..., :dv], sol[..., dv:]
    qk = jnp.einsum('bnhid,bnhjd->bnhij', qc, kc) * decay
    q_dec = qc * jnp.exp(G)[..., None]
    G_last = G[..., -1]
    k_tail = kc * jnp.exp(G_last[..., None] - G)[..., None]

    def step(S, xs):
        q_d, w_b, u_b, qk_b, k_t, g_l = xs
        v_new = u_b - jnp.einsum('bhcd,bhde->bhce', w_b, S)
        o = jnp.einsum('bhcd,bhde->bhce', q_d, S) + jnp.einsum('bhij,bhje->bhie', qk_b, v_new)
        S = S * jnp.exp(g_l)[..., None, None] + jnp.einsum('bhcd,bhce->bhde', k_t, v_new)
        return S, o

    xs = tuple(a.swapaxes(0, 1) for a in (q_dec, w, u, qk, k_tail, G_last))
    S, o = lax.scan(step, S0, xs)
    o = o.transpose(1, 0, 3, 2, 4).reshape(Bsz, T, H, dv)
    return o, S


def hybrid_layer(x, gdn_hist, S0, sc_hist, ffn_hist, w_in, gdn_conv_w, a_log, dt_bias, o_norm_g,
                 sc_conv_w, w_o, ln1_g, ln1_b, w_up, ffn_conv_w, w_down, ln2_g, ln2_b):
    f32 = jnp.float32
    Bsz, T, _ = x.shape
    cuts = np.cumsum([QKV_DIM, VAL_DIM, N_HEADS, N_HEADS, SC_WIDTH, SC_WIDTH, SC_WIDTH, D_MODEL]).tolist()
    qkv, z, b_lin, a_lin, sB, sC, sH, gA, gB = jnp.split(x @ w_in, cuts, axis=-1)

    qkv, gdn_new = causal_dwconv(qkv, gdn_conv_w, gdn_hist)
    qkv = jax.nn.silu(qkv).astype(f32)
    q, k, v = jnp.split(qkv, [KEY_DIM, 2 * KEY_DIM], axis=-1)
    q = l2norm(q.reshape(Bsz, T, N_HEADS, HEAD_K)) * (HEAD_K ** -0.5)
    k = l2norm(k.reshape(Bsz, T, N_HEADS, HEAD_K))
    v = v.reshape(Bsz, T, N_HEADS, HEAD_V)
    beta = jax.nn.sigmoid(b_lin.astype(f32))
    g = -jnp.exp(a_log.astype(f32)) * jax.nn.softplus(a_lin.astype(f32) + dt_bias.astype(f32))
    o, S_new = gated_delta_chunked(q, k, v, g, beta, S0.astype(f32), min(CHUNK, T))
    o = o * lax.rsqrt(jnp.mean(o * o, axis=-1, keepdims=True) + NORM_EPS) * o_norm_g.astype(f32)
    o = o * jax.nn.silu(z.astype(f32).reshape(Bsz, T, N_HEADS, HEAD_V))
    y_gdn = o.reshape(Bsz, T, VAL_DIM).astype(x.dtype)

    c, sc_new = causal_dwconv(sC * sH, sc_conv_w, sc_hist)
    y_sc = sB * c

    mixed = jax.nn.sigmoid(gA) * y_gdn + jax.nn.sigmoid(gB) * y_sc
    x = layer_norm(ALPHA * x + mixed @ w_o, ln1_g, ln1_b)

    a, vff = jnp.split(x @ w_up, [D_FF], axis=-1)
    a, ffn_new = causal_dwconv(a, ffn_conv_w, ffn_hist)
    x = layer_norm(ALPHA * x + (jax.nn.gelu(a, approximate=False) * vff) @ w_down, ln2_g, ln2_b)
    return x, gdn_new, S_new, sc_new, ffn_new


def setup_inputs(seed: int = 0) -> dict:
    key = jax.random.key(seed)
    ks = jax.random.split(key, 24)
    nrm = lambda k, s: jax.random.normal(k, s, jnp.float32)
    L = DEPTH
    u = jax.random.uniform(ks[9], (L, N_HEADS), jnp.float32)
    dt = jnp.exp(u * (np.log(0.1) - np.log(0.001)) + np.log(0.001)).astype(jnp.float32)
    return {
        "x_prompt": nrm(ks[0], (BATCH, SEQ, D_MODEL)),
        "x_sample": nrm(ks[1], (DEC_BATCH, DEC_SEQ, D_MODEL)),
        "state_gdn_conv": nrm(ks[2], (L, DEC_BATCH, GDN_CONV - 1, QKV_DIM)),
        "state_gdn_S": 0.1 * nrm(ks[3], (L, DEC_BATCH, N_HEADS, HEAD_K, HEAD_V)),
        "state_sc_conv": nrm(ks[4], (L, DEC_BATCH, SC_CONV - 1, SC_WIDTH)),
        "state_ffn_conv": nrm(ks[5], (L, DEC_BATCH, FFN_CONV - 1, D_FF)),
        "w_in": nrm(ks[6], (L, D_MODEL, IN_DIM)) * D_MODEL ** -0.5,
        "gdn_conv_w": nrm(ks[7], (L, GDN_CONV, QKV_DIM)) * GDN_CONV ** -0.5,
        "a_log": jnp.log(jax.random.uniform(ks[8], (L, N_HEADS), jnp.float32, 1.0, 16.0)),
        "dt_bias": dt + jnp.log(-jnp.expm1(-dt)),
        "o_norm_g": 1.0 + 0.02 * nrm(ks[10], (L, HEAD_V)),
        "sc_conv_w": nrm(ks[11], (L, SC_CONV, SC_WIDTH)) * SC_CONV ** -0.5,
        "w_o": nrm(ks[12], (L, D_MODEL, D_MODEL)) * (D_MODEL ** -0.5 * BETA_INIT),
        "ln1_g": 1.0 + 0.02 * nrm(ks[13], (L, D_MODEL)),
        "ln1_b": 0.02 * nrm(ks[14], (L, D_MODEL)),
        "w_up": nrm(ks[15], (L, D_MODEL, 2 * D_FF)) * D_MODEL ** -0.5,
        "ffn_conv_w": nrm(ks[16], (L, FFN_CONV, D_FF)) * FFN_CONV ** -0.5,
        "w_down": nrm(ks[17], (L, D_FF, D_MODEL)) * (D_FF ** -0.5 * BETA_INIT),
        "ln2_g": 1.0 + 0.02 * nrm(ks[18], (L, D_MODEL)),
        "ln2_b": 0.02 * nrm(ks[19], (L, D_MODEL)),
    }


def reference(x_prompt, x_sample, state_gdn_conv, state_gdn_S, state_sc_conv, state_ffn_conv,
              w_in, gdn_conv_w, a_log, dt_bias, o_norm_g, sc_conv_w, w_o, ln1_g, ln1_b,
              w_up, ffn_conv_w, w_down, ln2_g, ln2_b):
    hp, hs = x_prompt, x_sample
    p_gc, p_S, p_sc, p_ff = [], [], [], []
    s_gc, s_S, s_sc, s_ff = [], [], [], []
    for l in range(DEPTH):
        params = (w_in[l], gdn_conv_w[l], a_log[l], dt_bias[l], o_norm_g[l], sc_conv_w[l], w_o[l],
                  ln1_g[l], ln1_b[l], w_up[l], ffn_conv_w[l], w_down[l], ln2_g[l], ln2_b[l])
        z_gc = jnp.zeros((BATCH, GDN_CONV - 1, QKV_DIM), x_prompt.dtype)
        z_S = jnp.zeros((BATCH, N_HEADS, HEAD_K, HEAD_V), jnp.float32)
        z_sc = jnp.zeros((BATCH, SC_CONV - 1, SC_WIDTH), x_prompt.dtype)
        z_ff = jnp.zeros((BATCH, FFN_CONV - 1, D_FF), x_prompt.dtype)
        hp, a1, a2, a3, a4 = hybrid_layer(hp, z_gc, z_S, z_sc, z_ff, *params)
        p_gc.append(a1); p_S.append(a2); p_sc.append(a3); p_ff.append(a4)
        hs, b1, b2, b3, b4 = hybrid_layer(hs, state_gdn_conv[l], state_gdn_S[l], state_sc_conv[l],
                                          state_ffn_conv[l], *params)
        s_gc.append(b1); s_S.append(b2); s_sc.append(b3); s_ff.append(b4)
    return (hp, hs,
            jnp.stack(p_gc), jnp.stack(p_S), jnp.stack(p_sc), jnp.stack(p_ff),
            jnp.stack(s_gc), jnp.stack(s_S), jnp.stack(s_sc), jnp.stack(s_ff))
```

```cpp
#include <hip/hip_runtime.h>
#include <hip/hip_cooperative_groups.h>
#include <cstdio>
namespace cg = cooperative_groups;
__device__ __forceinline__ int opaque_tid() { int t; asm volatile("v_mov_b32 %0, %1" : "=v"(t) : "v"(threadIdx.x)); return t; }
namespace pg8 {
#define PG8_LAS __attribute__((address_space(3)))
typedef unsigned short bf16_t;
typedef short bf16x8 __attribute__((ext_vector_type(8)));
typedef float f32x4 __attribute__((ext_vector_type(4)));
typedef unsigned u32x4 __attribute__((ext_vector_type(4)));
constexpr int BM = 256, BK = 64, HALF = 128, HTB = HALF * BK * 2  , STAGE_BYTES = 8 * HTB, NXCD = 8, WGM = 8;
__host__ __device__ __forceinline__ int lds_byte(int r, int c) { const int st = (r >> 4) * 2 + (c >> 5), rr = r & 15, cc = c & 31, ob = rr * 64 + cc * 2; return st * 1024 + (ob ^ (((ob >> 9) & 1) << 5)); }
__host__ __device__ __forceinline__ void stage_rc(int b, int& R, int& C) { const int st = b / 1024, sb = b % 1024, swz = sb ^ (((sb >> 9) & 1) << 5); R = (st >> 1) * 16 + swz / 64; C = (st & 1) * 32 + (swz % 64) / 2; }
__host__ __device__ __forceinline__ int perm32(int rho) { const int n = rho >> 4, i = rho & 15; return 8 * (i >> 2) + 4 * n + (i & 3); }
struct Unit { int pm, pn; };
struct Gemm { const bf16_t* A; const bf16_t* Bt; int M, N, K; };
typedef float f32x2c_ __attribute__((ext_vector_type(2))); typedef __bf16 bf16x2c_ __attribute__((ext_vector_type(2)));
__device__ __forceinline__ unsigned cvt_pk_bf16(float lo, float hi) { const f32x2c_ v = {lo, hi}; const bf16x2c_ b = __builtin_convertvector(v, bf16x2c_); return __builtin_bit_cast(unsigned, b); }
typedef float f32x2 __attribute__((ext_vector_type(2)));
template <class Epi, class Sched, bool STAMP = false>
__device__ __forceinline__ void gemm_phase(PG8_LAS unsigned char* lds, const Gemm g, const Sched& S, const Epi& E, unsigned long long* stamps) {
    const int tid = opaque_tid(), wid = __builtin_amdgcn_readfirstlane(tid >> 6), lane = tid & 63, wr = wid >> 2, wc = wid & 3, fr = lane & 15, fq = lane >> 4;
    const int K = g.K, nt = K / BK;
    int ts_lo = 0, ts_hi = 0, nts = 0; const unsigned long long rt_entry = STAMP ? (unsigned long long)wall_clock64() : 0ull;
#define PG8_STAMP() do { if (STAMP && wid == 0 && nts < 64) { const unsigned long long _c = (unsigned long long)clock64(); \
        ts_lo = (lane == nts) ? (int)(unsigned)_c : ts_lo; ts_hi = (lane == nts) ? (int)(unsigned)(_c >> 32) : ts_hi; ++nts; } } while (0)
    PG8_STAMP();
    unsigned voffA[2], voffB[2];
#pragma unroll
    for (int i = 0; i < 2; ++i) { int R, C; stage_rc(tid * 16 + i * 8192, R, C); const int Rb = Epi::PERM ? ((R & ~31) + perm32(R & 31)) : R;
        voffA[i] = (unsigned)(R * K + C) * 2u; voffB[i] = (unsigned)(Rb * K + C) * 2u; }
    const size_t kstep = (size_t)(BK * 2);
    const size_t hstep = (size_t)HALF * K * 2;
    const size_t tstep = 2 * hstep;
    const unsigned ldsw = (unsigned)wid * 1024u;
    const int aoff = lds_byte(wr * 64 + fr, fq * 8), boff = lds_byte(wc * 32 + fr, fq * 8);
#define PG8_SA(b, h) (((b) * 2 + (h)) * HTB)
#define PG8_SB(b, h) ((4 + (b) * 2 + (h)) * HTB)
#define PG8_STAGE(bufoff, gbase, voff) do { _Pragma("unroll") for (int _i = 0; _i < 2; ++_i) \
        __builtin_amdgcn_global_load_lds((const unsigned*)((const char*)(gbase) + (voff)[_i]), (PG8_LAS unsigned*)(lds + (bufoff) + ldsw + _i * 8192), 16, 0, 0); } while (0)
#define PG8_LDA(dst, b, h) do { _Pragma("unroll") for (int m = 0; m < 4; ++m) _Pragma("unroll") for (int k = 0; k < 2; ++k) dst[m][k] = *(const PG8_LAS bf16x8*)(lds + PG8_SA(b, h) + aoff + m * 2048 + k * 1024); } while (0)
#define PG8_LDB(dst, b, h) do { _Pragma("unroll") for (int n = 0; n < 2; ++n) _Pragma("unroll") for (int k = 0; k < 2; ++k) dst[n][k] = *(const PG8_LAS bf16x8*)(lds + PG8_SB(b, h) + boff + n * 2048 + k * 1024); } while (0)
#define PG8_MMA(ai, bj, At, Bt) do { __builtin_amdgcn_s_setprio(1); _Pragma("unroll") for (int m = 0; m < 4; ++m) _Pragma("unroll") for (int n = 0; n < 2; ++n) _Pragma("unroll") for (int k = 0; k < 2; ++k) \
        acc[ai][bj][m][n] = __builtin_amdgcn_mfma_f32_16x16x32_bf16(Bt[n][k], At[m][k], acc[ai][bj][m][n], 0, 0, 0); __builtin_amdgcn_s_setprio(0); } while (0)
#define PG8_WAIT_V(n) asm volatile("s_waitcnt vmcnt(" #n ")" ::: "memory")
#define PG8_WAIT_L(n) asm volatile("s_waitcnt lgkmcnt(" #n ")" ::: "memory")
#define PG8_BAR __builtin_amdgcn_s_barrier()
#define PG8_SCHED __builtin_amdgcn_sched_barrier(0)
    Unit cur, nxt; int ui = 0;
    if (!S.next(0, cur)) return;
    f32x4 acc[2][2][4][2];
#pragma unroll
    for (int a = 0; a < 2; ++a)
#pragma unroll
        for (int b = 0; b < 2; ++b)
#pragma unroll
            for (int m = 0; m < 4; ++m)
#pragma unroll
                for (int n = 0; n < 2; ++n) acc[a][b][m][n] = (f32x4){0.f, 0.f, 0.f, 0.f};
    bf16x8 At[4][2], B0[2][2], B1[2][2];
    const char* cA = (const char*)g.A + (size_t)cur.pm * tstep; const char* cB = (const char*)g.Bt + (size_t)cur.pn * tstep;
    S.a_ready(cur);
    PG8_STAGE(PG8_SB(0, 0), cB, voffB); PG8_STAGE(PG8_SA(0, 0), cA, voffA); PG8_STAGE(PG8_SB(0, 1), cB + hstep, voffB); PG8_STAGE(PG8_SA(0, 1), cA + hstep, voffA);
    if (wr == 1) PG8_BAR;
    PG8_WAIT_V(4); PG8_BAR;
    PG8_STAGE(PG8_SB(1, 0), cB + kstep, voffB); PG8_STAGE(PG8_SA(1, 0), cA + kstep, voffA); PG8_STAGE(PG8_SB(1, 1), cB + hstep + kstep, voffB);
    PG8_WAIT_V(6); PG8_BAR;
    PG8_STAMP();
    for (;;) {
        const bool has_next = S.next(ui + 1, nxt);
        const char* nA = has_next ? (const char*)g.A + (size_t)nxt.pm * tstep : cA; const char* nB = has_next ? (const char*)g.Bt + (size_t)nxt.pn * tstep : cB;
        for (int t = 0; t < nt; t += 2) {
            const bool last = (t == nt - 2);
            const char* a1 = cA + (size_t)(t + 1) * kstep;
            const char* a2 = last ? nA : cA + (size_t)(t + 2) * kstep; const char* b2 = last ? nB : cB + (size_t)(t + 2) * kstep;
            const char* a3 = a2 + kstep; const char* b3 = b2 + kstep;
            if (last && has_next) S.a_ready(nxt);
            PG8_LDB(B0, 0, 0); PG8_SCHED; PG8_LDA(At, 0, 0); PG8_STAGE(PG8_SA(1, 1), a1 + hstep, voffA);
            PG8_WAIT_L(8); PG8_BAR; PG8_WAIT_L(0); PG8_MMA(0, 0, At, B0); PG8_BAR; PG8_SCHED;
            PG8_LDB(B1, 0, 1); PG8_STAGE(PG8_SB(0, 0), b2, voffB);
            PG8_BAR; PG8_WAIT_L(0); PG8_MMA(0, 1, At, B1); PG8_BAR;
            PG8_LDA(At, 0, 1); PG8_STAGE(PG8_SA(0, 0), a2, voffA);
            PG8_BAR; PG8_WAIT_L(0); PG8_MMA(1, 0, At, B0); PG8_BAR; PG8_SCHED;
            PG8_STAGE(PG8_SB(0, 1), b2 + hstep, voffB);
            PG8_WAIT_V(6); PG8_BAR; PG8_MMA(1, 1, At, B1); PG8_BAR;
            PG8_LDB(B0, 1, 0); PG8_SCHED; PG8_LDA(At, 1, 0); PG8_STAGE(PG8_SA(0, 1), a2 + hstep, voffA);
            PG8_WAIT_L(8); PG8_BAR; PG8_WAIT_L(0); PG8_MMA(0, 0, At, B0); PG8_BAR; PG8_SCHED;
            PG8_LDB(B1, 1, 1); PG8_STAGE(PG8_SB(1, 0), b3, voffB);
            PG8_BAR; PG8_WAIT_L(0); PG8_MMA(0, 1, At, B1); PG8_BAR;
            PG8_LDA(At, 1, 1); PG8_STAGE(PG8_SA(1, 0), a3, voffA);
            PG8_BAR; PG8_WAIT_L(0); PG8_MMA(1, 0, At, B0); PG8_BAR; PG8_SCHED;
            PG8_STAGE(PG8_SB(1, 1), b3 + hstep, voffB);
            PG8_WAIT_V(6); PG8_BAR; PG8_MMA(1, 1, At, B1); PG8_BAR;
        }
        PG8_STAMP();
        if constexpr (!Epi::AFTER_DRAIN) { E(acc, cur, wr, wc, fr, fq); S.done(cur); }
        PG8_STAMP();
        if (!has_next) break;
#pragma unroll
        for (int a = 0; a < 2; ++a)
#pragma unroll
            for (int b = 0; b < 2; ++b)
#pragma unroll
                for (int m = 0; m < 4; ++m)
#pragma unroll
                    for (int n = 0; n < 2; ++n) acc[a][b][m][n] = (f32x4){0.f, 0.f, 0.f, 0.f};
        cur = nxt; cA = nA; cB = nB; ++ui;
    }
    PG8_WAIT_V(0);
    if (wr == 0) PG8_BAR;
    PG8_BAR;
    if constexpr (Epi::AFTER_DRAIN) { E.fused(acc, cur, wr, wc, fr, fq, lds, wid, lane); S.done(cur); }
    PG8_STAMP();
    if (STAMP && wid == 0) { stamps[lane] = lane < nts ? (((unsigned long long)(unsigned)ts_hi << 32) | (unsigned)ts_lo) : 0ull;
        if (lane == 62) stamps[62] = rt_entry; if (lane == 63) stamps[63] = (unsigned long long)wall_clock64(); }
#undef PG8_STAMP
#undef PG8_SA
#undef PG8_SB
#undef PG8_STAGE
#undef PG8_LDA
#undef PG8_LDB
#undef PG8_MMA
#undef PG8_WAIT_V
#undef PG8_WAIT_L
#undef PG8_BAR
#undef PG8_SCHED
}
}

using pg8::bf16_t; using pg8::bf16x8; using pg8::f32x4; using pg8::u32x4; using pg8::Unit; using pg8::Gemm; using pg8::cvt_pk_bf16;
typedef unsigned u32x2 __attribute__((ext_vector_type(2)));
#define LAS __attribute__((address_space(3)))
constexpr int NSLAB = 9, NSTAGE = 11, NINT = NSLAB + NSTAGE - 1;
constexpr int IN_DIM = 9232;
constexpr float ALPHA = 1.189207115002721f;
constexpr int LDS_BYTES = 152 * 1024;
constexpr size_t O_YP = 0, O_PGC = 34078720, O_PS = 34097152, O_PSC = 34359296, O_PFF = 34363392, O_SGC = 34374656, O_SS = 34669568, O_SSC = 38863872, O_SFF = 38929408;
constexpr int R_W = 0, R_QD = 16384, R_KT = 32768, R_QK = 49152, R_U = 57344, R_HDR = 73728, REC_BYTES = 73984;
constexpr size_t A256(size_t x) { return (x + 255) & ~(size_t)255; }
constexpr size_t WS_WIN = 0;
constexpr size_t WS_WO = WS_WIN + (size_t)9216 * 1024 * 2;
constexpr size_t WS_WUP = WS_WO + (size_t)1024 * 1024 * 2;
constexpr size_t WS_WD = WS_WUP + (size_t)5632 * 1024 * 2;
constexpr size_t WS_XB = WS_WD + (size_t)1024 * 2816 * 2;
constexpr size_t SZ_XB = (size_t)4096 * 1024 * 2;
constexpr size_t WS_AB = WS_XB + 2 * SZ_XB;
constexpr size_t WS_QKV = A256(WS_AB + (size_t)33280 * 16 * 4);
constexpr size_t SZ_QKV = (size_t)4096 * 3072 * 2;
constexpr size_t WS_GATE = WS_QKV + 2 * SZ_QKV;
constexpr size_t SZ_G1 = (size_t)4096 * 1024 * 2, SZ_GATE = 3 * SZ_G1;
constexpr size_t WS_REC = WS_GATE + 4 * SZ_GATE;
constexpr size_t SZ_REC = (size_t)512 * REC_BYTES;
constexpr size_t WS_ORAW = WS_REC + 2 * SZ_REC;
constexpr size_t WS_MIX = WS_ORAW + 2 * SZ_G1;
constexpr size_t WS_X1B = WS_MIX + 2 * SZ_G1;
constexpr size_t WS_AV = WS_X1B + 2 * SZ_G1;
constexpr size_t SZ_AV = (size_t)4096 * 5632 * 2;
constexpr size_t WS_H = WS_AV + 2 * SZ_AV;
constexpr size_t SZ_H = (size_t)4096 * 2816 * 2;
constexpr size_t WS_STATS = WS_H + 2 * SZ_H;
constexpr size_t WS_HQ = WS_STATS + (size_t)33280 * 16;
constexpr size_t SZ_HQ = (size_t)2 * 3 * 3072 * 4;
constexpr size_t WS_HS = WS_HQ + 2 * SZ_HQ;
constexpr size_t SZ_HS = (size_t)2 * 2 * 1024 * 4;
constexpr size_t WS_HF = WS_HS + 2 * SZ_HS;
constexpr size_t SZ_HF = (size_t)2 * 2 * 2816 * 4;
constexpr size_t WS_END = WS_HF + 2 * SZ_HF;

struct Params { const float* in[20]; float* out; unsigned char* ws; int i_lo, i_hi, use_sync, pad; };

__device__ __forceinline__ float bf2f(unsigned short b) { return __uint_as_float((unsigned)b << 16); }
__device__ __forceinline__ float bflo(unsigned w) { return __uint_as_float(w << 16); }
__device__ __forceinline__ float bfhi(unsigned w) { return __uint_as_float(w & 0xffff0000u); }
__device__ __forceinline__ unsigned short f2bf(float f) { return (unsigned short)(cvt_pk_bf16(f, 0.f) & 0xffffu); }
__device__ __forceinline__ float sigmoidf_(float x) { return 1.0f / (1.0f + __expf(-x)); }
__device__ __forceinline__ int slab_rows(int s) { return s < 8 ? 4096 : 512; }
__device__ __forceinline__ int slab_panels(int s) { return s < 8 ? 16 : 2; }
__device__ __forceinline__ int grow_of(int s, int lr) { return s < 8 ? ((lr >> 11) * 16384 + s * 2048 + (lr & 2047)) : (32768 + lr); }
__device__ __forceinline__ const float* xrow(const Params& p, int grow) { return grow < 32768 ? p.in[0] + (size_t)grow * 1024 : p.in[1] + (size_t)(grow - 32768) * 1024; }
__device__ __forceinline__ bool valid_slab(int s) { return s >= 0 && s < NSLAB; }

struct Deal {
    int w, G, nd, q0, n, npm, r0;
    __device__ __forceinline__ int cand(int r) const { const int F = G - nd; if (w >= nd) return r < 3 ? r * F + (w - nd) : 3 * F + (r - 3) * G + w; return 3 * F + r * G + w; }
    __device__ __forceinline__ void init(int w_, int G_, int nd_, int q0_, int n_, int npm_) { w = w_; G = G_; nd = nd_ < G_ ? nd_ : 0; q0 = q0_; n = n_; npm = npm_; r0 = 0; while (cand(r0) < q0) ++r0; }
    __device__ __forceinline__ bool next(int i, Unit& u) const { const int q = cand(r0 + i); if (q >= q0 + n) return false; const int j = q - q0; u.pm = j % npm; u.pn = j / npm; return true; }
    __device__ __forceinline__ void a_ready(const Unit&) const {}
    __device__ __forceinline__ void done(const Unit&) const {}
};
struct DealDown {
    int w, G, n, npm;
    __device__ __forceinline__ bool next(int i, Unit& u) const { const int j = w + i * G; if (j >= n || (n <= G && i > 0)) return false; u.pm = j % npm; u.pn = j / npm; return true; }
    __device__ __forceinline__ void a_ready(const Unit&) const {}
    __device__ __forceinline__ void done(const Unit&) const {}
};

struct EpiIn {
    static constexpr bool PERM = true, AFTER_DRAIN = false;
    bf16_t* qkv; bf16_t* gate; const float* gnorm;
    __device__ __forceinline__ void operator()(const f32x4 (&acc)[2][2][4][2], const Unit& u, int wr, int wc, int fr, int fq) const {
        const int row0 = u.pm * 256 + wr * 64 + fr;
        if (u.pn < 12) {
#pragma unroll
            for (int ai = 0; ai < 2; ++ai)
#pragma unroll
                for (int m = 0; m < 4; ++m) { bf16_t* rowp = qkv + (size_t)(row0 + ai * 128 + m * 16) * 3072 + u.pn * 256 + wc * 32 + 8 * fq;
#pragma unroll
                    for (int bj = 0; bj < 2; ++bj) { const f32x4 v0 = acc[ai][bj][m][0], v1 = acc[ai][bj][m][1]; u32x4 w;
                        w.x = cvt_pk_bf16(v0[0], v0[1]); w.y = cvt_pk_bf16(v0[2], v0[3]); w.z = cvt_pk_bf16(v1[0], v1[1]); w.w = cvt_pk_bf16(v1[2], v1[3]);
                        *(u32x4*)(rowp + bj * 128) = w; } }
        } else {
            const int type = (u.pn - 12) >> 3, j = (u.pn - 12) & 7, ch = j * 128 + wc * 32 + 8 * fq;
            bf16_t* base = gate + (size_t)type * 4096 * 1024 + ch;
            float gn[8];
#pragma unroll
            for (int k = 0; k < 8; ++k) gn[k] = (type == 0) ? gnorm[(ch + k) & 127] : 1.0f;
#pragma unroll
            for (int ai = 0; ai < 2; ++ai)
#pragma unroll
                for (int m = 0; m < 4; ++m) { float o[8];
#pragma unroll
                    for (int n = 0; n < 2; ++n)
#pragma unroll
                        for (int k = 0; k < 4; ++k) { const float X = acc[ai][0][m][n][k], Y = acc[ai][1][m][n][k]; float r;
                            if (type == 0) r = sigmoidf_(Y) * X * sigmoidf_(X) * gn[n * 4 + k]; else if (type == 1) r = sigmoidf_(Y) * X; else r = X * Y;
                            o[n * 4 + k] = r; }
                    u32x4 w; w.x = cvt_pk_bf16(o[0], o[1]); w.y = cvt_pk_bf16(o[2], o[3]); w.z = cvt_pk_bf16(o[4], o[5]); w.w = cvt_pk_bf16(o[6], o[7]);
                    *(u32x4*)(base + (size_t)(row0 + ai * 128 + m * 16) * 1024) = w; }
        }
    }
};
struct EpiUp {
    static constexpr bool PERM = true, AFTER_DRAIN = false;
    bf16_t* av;
    __device__ __forceinline__ void operator()(const f32x4 (&acc)[2][2][4][2], const Unit& u, int wr, int wc, int fr, int fq) const {
        const int row0 = u.pm * 256 + wr * 64 + fr;
#pragma unroll
        for (int ai = 0; ai < 2; ++ai)
#pragma unroll
            for (int m = 0; m < 4; ++m) { bf16_t* rowp = av + (size_t)(row0 + ai * 128 + m * 16) * 5632 + u.pn * 256 + wc * 32 + 8 * fq;
#pragma unroll
                for (int bj = 0; bj < 2; ++bj) { const f32x4 v0 = acc[ai][bj][m][0], v1 = acc[ai][bj][m][1]; u32x4 w;
                    w.x = cvt_pk_bf16(v0[0], v0[1]); w.y = cvt_pk_bf16(v0[2], v0[3]); w.z = cvt_pk_bf16(v1[0], v1[1]); w.w = cvt_pk_bf16(v1[2], v1[3]);
                    *(u32x4*)(rowp + bj * 128) = w; } }
    }
};
struct EpiRes {
    static constexpr bool PERM = false, AFTER_DRAIN = false;
    const float* resp; const float* ress; float* y; float* stats; int s, soff;
    __device__ __forceinline__ void operator()(const f32x4 (&acc)[2][2][4][2], const Unit& u, int wr, int wc, int fr, int fq) const {
        const int col0 = u.pn * 256 + wc * 32 + 4 * fq;
#pragma unroll
        for (int ai = 0; ai < 2; ++ai)
#pragma unroll
            for (int m = 0; m < 4; ++m) {
                const int lr = u.pm * 256 + ai * 128 + wr * 64 + m * 16 + fr, grow = grow_of(s, lr);
                const float* rp = (grow < 32768 ? resp + (size_t)grow * 1024 : ress + (size_t)(grow - 32768) * 1024) + col0;
                float* yp = y + (size_t)grow * 1024 + col0; float sm = 0.f, sq = 0.f;
#pragma unroll
                for (int bj = 0; bj < 2; ++bj)
#pragma unroll
                    for (int n = 0; n < 2; ++n) { const f32x4 r = *(const f32x4*)(rp + bj * 128 + n * 16); const f32x4 v = r * ALPHA + acc[ai][bj][m][n];
                        *(f32x4*)(yp + bj * 128 + n * 16) = v; sm += (v[0] + v[1]) + (v[2] + v[3]); sq += (v[0] * v[0] + v[1] * v[1]) + (v[2] * v[2] + v[3] * v[3]); }
                sm += __shfl_xor(sm, 16); sm += __shfl_xor(sm, 32); sq += __shfl_xor(sq, 16); sq += __shfl_xor(sq, 32);
                if (fq == 0) { atomicAdd(stats + (size_t)grow * 4 + soff, sm); atomicAdd(stats + (size_t)grow * 4 + soff + 1, sq); }
            }
    }
};

__device__ __forceinline__ int src_col_in(int np) {
    const int pn = np >> 8; if (pn < 12) return np;
    const int within = np & 255, half = within >> 7, cl = within & 127, type = (pn - 12) >> 3, j = (pn - 12) & 7;
    const int base = type == 0 ? (half ? 7184 : 3072) : (type == 1 ? (half ? 8208 : 4112) : (half ? 6160 : 5136));
    return base + j * 128 + cl;
}
__device__ void stage_wconv(const Params& p, LAS unsigned char* lds) {
    LAS float* t = (LAS float*)lds;
    const int tid = opaque_tid();
    for (int ti = blockIdx.x; ti < 4672; ti += gridDim.x) {
        const float* W; bf16_t* D; int N, K, tk, tn, which;
        if (ti < 2304) { which = 0; W = p.in[6]; D = (bf16_t*)(p.ws + WS_WIN); N = IN_DIM; K = 1024; tk = ti / 144; tn = ti % 144; }
        else if (ti < 2560) { const int q = ti - 2304; which = 1; W = p.in[12]; D = (bf16_t*)(p.ws + WS_WO); N = 1024; K = 1024; tk = q / 16; tn = q % 16; }
        else if (ti < 3968) { const int q = ti - 2560; which = 2; W = p.in[15]; D = (bf16_t*)(p.ws + WS_WUP); N = 5632; K = 1024; tk = q / 88; tn = q % 88; }
        else { const int q = ti - 3968; which = 3; W = p.in[17]; D = (bf16_t*)(p.ws + WS_WD); N = 1024; K = 2816; tk = q / 16; tn = q % 16; }
        const int c = tid & 63, r8 = tid >> 6;
        const int np = tn * 64 + c, sc = which == 0 ? src_col_in(np) : np;
#pragma unroll
        for (int i = 0; i < 8; ++i) { const int r = r8 + 8 * i; t[r * 65 + c] = W[(size_t)(tk * 64 + r) * N + sc]; }
        __syncthreads();
#pragma unroll
        for (int i = 0; i < 8; ++i) { const int rr = r8 + 8 * i; D[(size_t)(tn * 64 + rr) * K + tk * 64 + c] = f2bf(t[c * 65 + rr]); }
        __syncthreads();
    }
}

__device__ void stage_cvt(const Params& p, int s, LAS unsigned char* lds) {
    LAS float* sW = (LAS float*)lds;
    const int tid = opaque_tid(), wid = tid >> 6, lane = tid & 63;
    for (int idx = tid; idx < 16384; idx += 512) { const int k = idx >> 4, o = idx & 15; sW[o * 1024 + k] = p.in[6][(size_t)k * IN_DIM + 4096 + o]; }
    __syncthreads();
    bf16_t* xb = (bf16_t*)(p.ws + WS_XB + (size_t)(s & 1) * SZ_XB);
    float* ab = (float*)(p.ws + WS_AB); float* stats = (float*)(p.ws + WS_STATS);
    const int rows = slab_rows(s);
    for (int lr = blockIdx.x * 8 + wid; lr < rows; lr += gridDim.x * 8) {
        const int grow = grow_of(s, lr); const float* xr = xrow(p, grow);
        f32x4 xv[4];
#pragma unroll
        for (int i = 0; i < 4; ++i) xv[i] = *(const f32x4*)(xr + lane * 4 + 256 * i);
#pragma unroll
        for (int i = 0; i < 4; ++i) { u32x2 w; w.x = cvt_pk_bf16(xv[i][0], xv[i][1]); w.y = cvt_pk_bf16(xv[i][2], xv[i][3]); *(u32x2*)(xb + (size_t)lr * 1024 + lane * 4 + 256 * i) = w; }
        float mine = 0.f;
#pragma unroll 1
        for (int o = 0; o < 16; ++o) { float a = 0.f;
#pragma unroll
            for (int i = 0; i < 4; ++i) { const f32x4 wv = *(const LAS f32x4*)(sW + o * 1024 + lane * 4 + 256 * i); a += xv[i][0] * wv[0] + xv[i][1] * wv[1] + xv[i][2] * wv[2] + xv[i][3] * wv[3]; }
#pragma unroll
            for (int d = 32; d >= 1; d >>= 1) a += __shfl_xor(a, d);
            if (lane == o) mine = a; }
        if (lane < 16) ab[(size_t)grow * 16 + lane] = mine;
        if (lane < 4) stats[(size_t)grow * 4 + lane] = 0.f;
    }
}

constexpr int P_G = 0, P_BETA = 256, P_EG = 512, P_ET = 768, P_KB = 1024, P_QB = 18432, P_RT = 35840, P_ABF = 69632, P_ADIAG = 78336, P_TB = 82432;
__device__ __forceinline__ bf16x8 mk8(unsigned a, unsigned b, unsigned c, unsigned d) { u32x4 v = {a, b, c, d}; return __builtin_bit_cast(bf16x8, v); }
__device__ void prep_unit(const Params& p, int s, int idx, LAS unsigned char* lds) {
    const int tid = opaque_tid(), wid = tid >> 6, lane = tid & 63;
    const bool sample = (s == 8);
    int h, lr0, grow0, ntok, recidx, hb  ; bool first, last;
    if (!sample) { const int b = idx >> 8, rem = idx & 255, c = rem >> 3; h = rem & 7; lr0 = b * 2048 + c * 64; grow0 = b * 16384 + s * 2048 + c * 64; ntok = 64; recidx = (b * 8 + h) * 32 + c; hb = b; first = (c == 0); last = (c == 31); }
    else { const int seq = idx >> 3; h = idx & 7; lr0 = seq * 16; grow0 = 32768 + seq * 16; ntok = 16; recidx = idx; hb = seq; first = true; last = true; }
    LAS float* sG = (LAS float*)(lds + P_G); LAS float* sBeta = (LAS float*)(lds + P_BETA); LAS float* sEG = (LAS float*)(lds + P_EG); LAS float* sET = (LAS float*)(lds + P_ET);
    unsigned char* rec = p.ws + WS_REC + (size_t)(s & 1) * SZ_REC + (size_t)recidx * REC_BYTES;
    const bf16_t* qkv = (const bf16_t*)(p.ws + WS_QKV + (size_t)(s & 1) * SZ_QKV);
    if (wid == 0) {
        const int t = lane; const bool v = t < ntok; const int gr = grow0 + (v ? t : 0);
        const float* ab = (const float*)(p.ws + WS_AB) + (size_t)gr * 16;
        const float bl = ab[h], al = ab[8 + h] + p.in[9][h];
        const float sp = al > 20.f ? al : log1pf(__expf(al));
        float g = v ? -__expf(p.in[8][h]) * sp : 0.f; const float beta = v ? sigmoidf_(bl) : 0.f;
#pragma unroll
        for (int d = 1; d < 64; d <<= 1) { const float o = __shfl_up(g, d); if (lane >= d) g += o; }
        const float gl = __shfl(g, 63);
        sG[t] = g; sBeta[t] = beta; sEG[t] = __expf(g); sET[t] = __expf(gl - g);
        if (lane == 0) *(float*)(rec + R_HDR) = __expf(gl);
    }
    __syncthreads();
    const float* cw = p.in[7];
#pragma unroll 1
    for (int it = 0; it < 3; ++it) {
        const int i = it * 512 + tid, o = i & 15, rest = i >> 4, tensor = rest % 3, tp = rest / 3, t0 = 2 * tp;
        const int cb = tensor * 1024 + h * 128 + o * 8;
        float x[5][8];
#pragma unroll
        for (int r = 0; r < 5; ++r) { const int t = t0 - 3 + r;
            if (t >= 0 || !first) { const u32x4 w = *(const u32x4*)(qkv + (size_t)(lr0 + t) * 3072 + cb);
                x[r][0] = bflo(w.x); x[r][1] = bfhi(w.x); x[r][2] = bflo(w.y); x[r][3] = bfhi(w.y); x[r][4] = bflo(w.z); x[r][5] = bfhi(w.z); x[r][6] = bflo(w.w); x[r][7] = bfhi(w.w); }
            else if (sample) { const float* hp = p.in[2] + ((size_t)hb * 3 + (3 + t)) * 3072 + cb;
#pragma unroll
                for (int k = 0; k < 8; ++k) x[r][k] = hp[k]; }
            else if (s == 0) {
#pragma unroll
                for (int k = 0; k < 8; ++k) x[r][k] = 0.f; }
            else { const float* hp = (const float*)(p.ws + WS_HQ + (size_t)((s - 1) & 1) * SZ_HQ) + ((size_t)hb * 3 + (3 + t)) * 3072 + cb;
#pragma unroll
                for (int k = 0; k < 8; ++k) x[r][k] = hp[k]; } }
        if (last && t0 + 1 == ntok - 1) {
#pragma unroll
            for (int r = 0; r < 3; ++r) {
                float* d1 = sample ? p.out + O_SGC + ((size_t)hb * 3 + r) * 3072 + cb : (float*)(p.ws + WS_HQ + (size_t)(s & 1) * SZ_HQ) + ((size_t)hb * 3 + r) * 3072 + cb;
#pragma unroll
                for (int k = 0; k < 8; ++k) d1[k] = x[2 + r][k];
                if (!sample && s == 7) { float* d2 = p.out + O_PGC + ((size_t)hb * 3 + r) * 3072 + cb;
#pragma unroll
                    for (int k = 0; k < 8; ++k) d2[k] = x[2 + r][k]; } } }
        float y0[8], y1[8], ss0 = 0.f, ss1 = 0.f;
#pragma unroll
        for (int k = 0; k < 8; ++k) { const float w0 = cw[cb + k], w1 = cw[3072 + cb + k], w2 = cw[6144 + cb + k], w3 = cw[9216 + cb + k];
            float a = w0 * x[0][k] + w1 * x[1][k] + w2 * x[2][k] + w3 * x[3][k]; float b = w0 * x[1][k] + w1 * x[2][k] + w2 * x[3][k] + w3 * x[4][k];
            a = a * sigmoidf_(a); b = b * sigmoidf_(b); y0[k] = a; y1[k] = b; ss0 += a * a; ss1 += b * b; }
#pragma unroll
        for (int d = 1; d < 16; d <<= 1) { ss0 += __shfl_xor(ss0, d); ss1 += __shfl_xor(ss1, d); }
        const int t1 = t0 + 1; const bool v0 = t0 < ntok, v1 = t1 < ntok;
        float m0, m1;
        if (tensor == 0) { m0 = rsqrtf(ss0 + 1e-6f) * 0.08838834764831845f; m1 = rsqrtf(ss1 + 1e-6f) * 0.08838834764831845f; }
        else if (tensor == 1) { m0 = rsqrtf(ss0 + 1e-6f); m1 = rsqrtf(ss1 + 1e-6f); }
        else { m0 = 1.f; m1 = 1.f; }
#pragma unroll
        for (int k = 0; k < 8; ++k) { y0[k] = v0 ? y0[k] * m0 : 0.f; y1[k] = v1 ? y1[k] * m1 : 0.f; }
        const float b0 = sBeta[t0], b1 = sBeta[t1], eg0 = sEG[t0], eg1 = sEG[t1], et0 = sET[t0], et1 = sET[t1];
        if (tensor == 0) {
            u32x4 w; w.x = cvt_pk_bf16(y0[0], y0[1]); w.y = cvt_pk_bf16(y0[2], y0[3]); w.z = cvt_pk_bf16(y0[4], y0[5]); w.w = cvt_pk_bf16(y0[6], y0[7]);
            *(LAS u32x4*)(lds + P_QB + t0 * 272 + o * 16) = w;
            w.x = cvt_pk_bf16(y1[0], y1[1]); w.y = cvt_pk_bf16(y1[2], y1[3]); w.z = cvt_pk_bf16(y1[4], y1[5]); w.w = cvt_pk_bf16(y1[6], y1[7]);
            *(LAS u32x4*)(lds + P_QB + t1 * 272 + o * 16) = w;
            const int kb = o >> 2, oo = o & 3, half = oo >> 1, g0 = (oo & 1) * 2;
#pragma unroll
            for (int tt = 0; tt < 2; ++tt) { const int t = t0 + tt; const float e = tt ? eg1 : eg0; const float* yy = tt ? y1 : y0; const int mt = t >> 4, m = t & 15;
                bf16_t* b_ = (bf16_t*)(rec + R_QD) + ((size_t)((mt * 4 + kb) * 64 + g0 * 16 + m) * 8 + half * 4);
                u32x2 a; a.x = cvt_pk_bf16(yy[0] * e, yy[1] * e); a.y = cvt_pk_bf16(yy[2] * e, yy[3] * e); *(u32x2*)b_ = a;
                a.x = cvt_pk_bf16(yy[4] * e, yy[5] * e); a.y = cvt_pk_bf16(yy[6] * e, yy[7] * e); *(u32x2*)(b_ + 16 * 8) = a; }
        } else if (tensor == 1) {
            u32x4 w; w.x = cvt_pk_bf16(y0[0], y0[1]); w.y = cvt_pk_bf16(y0[2], y0[3]); w.z = cvt_pk_bf16(y0[4], y0[5]); w.w = cvt_pk_bf16(y0[6], y0[7]);
            *(LAS u32x4*)(lds + P_KB + t0 * 272 + o * 16) = w;
            w.x = cvt_pk_bf16(y1[0], y1[1]); w.y = cvt_pk_bf16(y1[2], y1[3]); w.z = cvt_pk_bf16(y1[4], y1[5]); w.w = cvt_pk_bf16(y1[6], y1[7]);
            *(LAS u32x4*)(lds + P_KB + t1 * 272 + o * 16) = w;
            const int dt = o >> 1, kb = t0 >> 5, r = t0 & 31, half = r >> 4, rr = r & 15, gp = rr >> 2, ep = half * 4 + (rr & 3);
#pragma unroll
            for (int k = 0; k < 8; ++k) { const int m = (o & 1) * 8 + k;
                *(LAS unsigned*)(lds + P_RT + (128 + o * 8 + k) * 132 + t0 * 2) = cvt_pk_bf16(y0[k] * b0 * eg0, y1[k] * b1 * eg1);
                *(unsigned*)((bf16_t*)(rec + R_KT) + ((size_t)((dt * 2 + kb) * 64 + gp * 16 + m) * 8 + ep)) = cvt_pk_bf16(y0[k] * et0, y1[k] * et1); }
        } else {
#pragma unroll
            for (int k = 0; k < 8; ++k) *(LAS unsigned*)(lds + P_RT + (o * 8 + k) * 132 + t0 * 2) = cvt_pk_bf16(y0[k] * b0, y1[k] * b1);
        }
    }
    __syncthreads();
    const int n = lane & 15, g = lane >> 4;
    {
        const int itile = wid >> 1;
        bf16x8 ak[4], aq[4];
#pragma unroll
        for (int kb = 0; kb < 4; ++kb) { ak[kb] = *(const LAS bf16x8*)(lds + P_KB + (itile * 16 + n) * 272 + kb * 64 + g * 16); aq[kb] = *(const LAS bf16x8*)(lds + P_QB + (itile * 16 + n) * 272 + kb * 64 + g * 16); }
#pragma unroll
        for (int jj = 0; jj < 2; ++jj) { const int jt = (wid & 1) * 2 + jj;
            f32x4 ckk = {0.f, 0.f, 0.f, 0.f}, cqk = {0.f, 0.f, 0.f, 0.f};
#pragma unroll
            for (int kb = 0; kb < 4; ++kb) { const bf16x8 bk = *(const LAS bf16x8*)(lds + P_KB + (jt * 16 + n) * 272 + kb * 64 + g * 16);
                ckk = __builtin_amdgcn_mfma_f32_16x16x32_bf16(ak[kb], bk, ckk, 0, 0, 0); cqk = __builtin_amdgcn_mfma_f32_16x16x32_bf16(aq[kb], bk, cqk, 0, 0, 0); }
            const int j = jt * 16 + n; const float Gj = sG[j];
#pragma unroll
            for (int e = 0; e < 4; ++e) { const int i = itile * 16 + 4 * g + e; const float dd = fminf(sG[i] - Gj, 0.f), ex = __expf(dd);
                const float av = (j < i) ? sBeta[i] * ckk[e] * ex : 0.f, qv = (j <= i) ? cqk[e] * ex : 0.f;
                *(LAS bf16_t*)(lds + P_ABF + i * 136 + j * 2) = f2bf(-av);
                if (itile == jt) *(LAS float*)(lds + P_ADIAG + ((itile * 16 + 4 * g + e) * 16 + n) * 4) = av;
                const int kb2 = jt >> 1, half = jt & 1, gp = n >> 2, ep = half * 4 + (n & 3), m = 4 * g + e;
                *((bf16_t*)(rec + R_QK) + ((size_t)((itile * 2 + kb2) * 64 + gp * 16 + m) * 8 + ep)) = f2bf(qv); }
        }
    }
    __syncthreads();
    if (wid == 0) {
        const int blk = lane >> 4, c = lane & 15; const LAS float* A = (const LAS float*)(lds + P_ADIAG) + blk * 256;
        float T[16];
#pragma unroll
        for (int r = 0; r < 16; ++r) { float a = (r == c) ? 1.f : 0.f;
#pragma unroll
            for (int jx = 0; jx < r; ++jx) a -= A[r * 16 + jx] * T[jx];
            T[r] = a; }
#pragma unroll
        for (int r = 0; r < 16; ++r) *(LAS bf16_t*)(lds + P_TB + (blk * 16 + r) * 40 + c * 2) = f2bf(T[r]);
    }
    __syncthreads();
    {
        bf16x8 Xop[2][2];
#pragma unroll
        for (int a = 0; a < 2; ++a)
#pragma unroll
            for (int b = 0; b < 2; ++b) Xop[a][b] = mk8(0u, 0u, 0u, 0u);
        unsigned xw[2][2][4];
#pragma unroll
        for (int a = 0; a < 2; ++a)
#pragma unroll
            for (int b = 0; b < 2; ++b)
#pragma unroll
                for (int c = 0; c < 4; ++c) xw[a][b][c] = 0u;
#pragma unroll
        for (int blk = 0; blk < 4; ++blk) {
            f32x4 acc[2];
#pragma unroll
            for (int ct = 0; ct < 2; ++ct) { const int f = 32 * wid + 16 * ct + n; const LAS unsigned* rp = (const LAS unsigned*)(lds + P_RT + f * 132 + 32 * blk + 8 * g);
                const unsigned r0 = rp[0], r1 = rp[1]; acc[ct] = (f32x4){bflo(r0), bfhi(r0), bflo(r1), bfhi(r1)}; }
            if (blk >= 1) { const LAS unsigned char* ap = lds + P_ABF + (blk * 16 + n) * 136 + 8 * g; const u32x2 a0 = *(const LAS u32x2*)ap, a1 = *(const LAS u32x2*)(ap + 32);
                const bf16x8 A = mk8(a0.x, a0.y, a1.x, a1.y);
#pragma unroll
                for (int ct = 0; ct < 2; ++ct) acc[ct] = __builtin_amdgcn_mfma_f32_16x16x32_bf16(A, mk8(xw[0][ct][0], xw[0][ct][1], xw[0][ct][2], xw[0][ct][3]), acc[ct], 0, 0, 0); }
            if (blk == 3) { const LAS unsigned char* ap = lds + P_ABF + (blk * 16 + n) * 136 + 64 + 8 * g; const u32x2 a0 = *(const LAS u32x2*)ap, a1 = *(const LAS u32x2*)(ap + 32);
                const bf16x8 A = mk8(a0.x, a0.y, a1.x, a1.y);
#pragma unroll
                for (int ct = 0; ct < 2; ++ct) acc[ct] = __builtin_amdgcn_mfma_f32_16x16x32_bf16(A, mk8(xw[1][ct][0], xw[1][ct][1], xw[1][ct][2], xw[1][ct][3]), acc[ct], 0, 0, 0); }
            const u32x2 tv = *(const LAS u32x2*)(lds + P_TB + (blk * 16 + n) * 40 + 8 * g);
            const bf16x8 Top = mk8(tv.x, tv.y, 0u, 0u);
#pragma unroll
            for (int ct = 0; ct < 2; ++ct) {
                const bf16x8 Yop = mk8(cvt_pk_bf16(acc[ct][0], acc[ct][1]), cvt_pk_bf16(acc[ct][2], acc[ct][3]), 0u, 0u);
                f32x4 x = {0.f, 0.f, 0.f, 0.f}; x = __builtin_amdgcn_mfma_f32_16x16x32_bf16(Top, Yop, x, 0, 0, 0);
                const unsigned p0 = cvt_pk_bf16(x[0], x[1]), p1 = cvt_pk_bf16(x[2], x[3]);
                xw[blk >> 1][ct][(blk & 1) * 2] = p0; xw[blk >> 1][ct][(blk & 1) * 2 + 1] = p1;
                if (wid < 4) { const int wv = 2 * wid + ct; u32x2 st; st.x = p0; st.y = p1; *(u32x2*)(rec + R_U + (size_t)((wv * 4 + blk) * 64 + lane) * 8) = st; }
                else { const int kbp = wid - 4, gp = n >> 2, ep = ct * 4 + (n & 3);
#pragma unroll
                    for (int e = 0; e < 4; ++e) { const int mp = 4 * g + e; *((bf16_t*)(rec + R_W) + ((size_t)((blk * 4 + kbp) * 64 + gp * 16 + mp) * 8 + ep)) = f2bf(-x[e]); } }
            }
        }
        (void)Xop;
    }
    __syncthreads();
}
__device__ void stage_prep(const Params& p, int s, LAS unsigned char* lds) {
    const int nu = s < 8 ? 512 : 256;
    for (int idx = blockIdx.x; idx < nu; idx += gridDim.x) prep_unit(p, s, idx, lds);
}

__device__ void scan_chain(const Params& p, int s, int chain, LAS unsigned char* lds) {
    const int tid = opaque_tid(), wv = tid >> 6, lane = tid & 63, n = lane & 15, g = lane >> 4;
    const bool sample = (s == 8);
    int h, lr0, nch, ntok; const unsigned char* rec; const float* Sin; float* Sout;
    if (!sample) { const int b = chain >> 3; h = chain & 7; lr0 = b * 2048; nch = 32; ntok = 64; rec = p.ws + WS_REC + (size_t)(s & 1) * SZ_REC + (size_t)chain * 32 * REC_BYTES;
        Sout = p.out + O_PS + (size_t)chain * 16384; Sin = s == 0 ? nullptr : Sout; }
    else { const int seq = chain >> 3; h = chain & 7; lr0 = seq * 16; nch = 1; ntok = 16; rec = p.ws + WS_REC + (size_t)(s & 1) * SZ_REC + (size_t)chain * REC_BYTES;
        Sin = p.in[3] + (size_t)chain * 16384; Sout = p.out + O_SS + (size_t)chain * 16384; }
    unsigned char* orec = p.ws + WS_ORAW + (size_t)(s & 1) * SZ_G1 + ((size_t)(lr0 / ntok) * 8 + h) * 16384 + (size_t)((wv * 4) * 64 + lane) * 8;
    f32x4 S[8];
#pragma unroll
    for (int dt = 0; dt < 8; ++dt) S[dt] = (f32x4){0.f, 0.f, 0.f, 0.f};
    if (Sin) {
#pragma unroll
        for (int i = 0; i < 8; ++i) *(LAS u32x4*)(lds + (i * 512 + tid) * 16) = *(const u32x4*)((const unsigned char*)Sin + (size_t)(i * 512 + tid) * 16);
        __syncthreads();
        const LAS float* sp = (const LAS float*)lds + (4 * g) * 128 + wv * 16 + n;
#pragma unroll
        for (int dt = 0; dt < 8; ++dt)
#pragma unroll
            for (int e = 0; e < 4; ++e) S[dt][e] = sp[(dt * 16 + e) * 128];
        __syncthreads();
    }
    u32x4 pre[9];
#pragma unroll
    for (int i = 0; i < 9; ++i) pre[i] = *(const u32x4*)(rec + (size_t)(i * 512 + tid) * 16);
#pragma unroll
    for (int i = 0; i < 9; ++i) *(LAS u32x4*)(lds + (i * 512 + tid) * 16) = pre[i];
    __syncthreads();
#pragma unroll 1
    for (int c = 0; c < nch; ++c) {
        const unsigned char* rc = rec + (size_t)c * REC_BYTES;
        const bool more = c + 1 < nch;
        if (more) {
#pragma unroll
            for (int i = 0; i < 9; ++i) pre[i] = *(const u32x4*)(rc + REC_BYTES + (size_t)(i * 512 + tid) * 16); }
        const float gamma = *(const float*)(rc + R_HDR);
        const LAS unsigned char* cur = lds + (c & 1) * 73728;
        bf16x8 Sop[4];
#pragma unroll
        for (int kb = 0; kb < 4; ++kb) Sop[kb] = mk8(cvt_pk_bf16(S[2 * kb][0], S[2 * kb][1]), cvt_pk_bf16(S[2 * kb][2], S[2 * kb][3]), cvt_pk_bf16(S[2 * kb + 1][0], S[2 * kb + 1][1]), cvt_pk_bf16(S[2 * kb + 1][2], S[2 * kb + 1][3]));
        f32x4 vn[4], oa[4];
#pragma unroll
        for (int mt = 0; mt < 4; ++mt) { const u32x2 uu = *(const LAS u32x2*)(cur + R_U + ((wv * 4 + mt) * 64 + lane) * 8);
            f32x4 a = {bflo(uu.x), bfhi(uu.x), bflo(uu.y), bfhi(uu.y)}; f32x4 o = {0.f, 0.f, 0.f, 0.f};
#pragma unroll
            for (int kb = 0; kb < 4; ++kb) { const bf16x8 wf = *(const LAS bf16x8*)(cur + R_W + ((mt * 4 + kb) * 64 + lane) * 16); const bf16x8 qf = *(const LAS bf16x8*)(cur + R_QD + ((mt * 4 + kb) * 64 + lane) * 16);
                a = __builtin_amdgcn_mfma_f32_16x16x32_bf16(wf, Sop[kb], a, 0, 0, 0); o = __builtin_amdgcn_mfma_f32_16x16x32_bf16(qf, Sop[kb], o, 0, 0, 0); }
            vn[mt] = a; oa[mt] = o; __builtin_amdgcn_sched_barrier(0); }
        bf16x8 Vop[2];
#pragma unroll
        for (int kb = 0; kb < 2; ++kb) Vop[kb] = mk8(cvt_pk_bf16(vn[2 * kb][0], vn[2 * kb][1]), cvt_pk_bf16(vn[2 * kb][2], vn[2 * kb][3]), cvt_pk_bf16(vn[2 * kb + 1][0], vn[2 * kb + 1][1]), cvt_pk_bf16(vn[2 * kb + 1][2], vn[2 * kb + 1][3]));
#pragma unroll
        for (int mt = 0; mt < 4; ++mt) {
#pragma unroll
            for (int kb = 0; kb < 2; ++kb) { const bf16x8 qk = *(const LAS bf16x8*)(cur + R_QK + ((mt * 2 + kb) * 64 + lane) * 16); oa[mt] = __builtin_amdgcn_mfma_f32_16x16x32_bf16(qk, Vop[kb], oa[mt], 0, 0, 0); }
            if (mt * 16 < ntok) { u32x2 st; st.x = cvt_pk_bf16(oa[mt][0], oa[mt][1]); st.y = cvt_pk_bf16(oa[mt][2], oa[mt][3]); *(u32x2*)(orec + (size_t)c * 8 * 16384 + mt * 512) = st; }
            __builtin_amdgcn_sched_barrier(0); }
#pragma unroll
        for (int dt = 0; dt < 8; ++dt) { S[dt] *= gamma;
#pragma unroll
            for (int kb = 0; kb < 2; ++kb) { const bf16x8 kf = *(const LAS bf16x8*)(cur + R_KT + ((dt * 2 + kb) * 64 + lane) * 16); S[dt] = __builtin_amdgcn_mfma_f32_16x16x32_bf16(kf, Vop[kb], S[dt], 0, 0, 0); } if (dt & 1) __builtin_amdgcn_sched_barrier(0); }
        if (more) {
#pragma unroll
            for (int i = 0; i < 9; ++i) *(LAS u32x4*)(lds + ((c + 1) & 1) * 73728 + (i * 512 + tid) * 16) = pre[i]; }
        __syncthreads();
    }
    {
        LAS float* sp = (LAS float*)lds + (4 * g) * 128 + wv * 16 + n;
#pragma unroll
        for (int dt = 0; dt < 8; ++dt)
#pragma unroll
            for (int e = 0; e < 4; ++e) sp[(dt * 16 + e) * 128] = S[dt][e];
        __syncthreads();
#pragma unroll
        for (int i = 0; i < 8; ++i) *(u32x4*)((unsigned char*)Sout + (size_t)(i * 512 + tid) * 16) = *(const LAS u32x4*)(lds + (i * 512 + tid) * 16);
    }
}
__device__ void stage_scan(const Params& p, int s, LAS unsigned char* lds) {
    const int G = gridDim.x;
    if (s < 8) { const int j = G - 1 - (int)blockIdx.x; for (int ch = j; ch < 16; ch += G) { scan_chain(p, s, ch, lds); __syncthreads(); } }
    else { for (int ch = blockIdx.x; ch < 256; ch += G) { scan_chain(p, s, ch, lds); __syncthreads(); } }
}

__device__ void stage_merge(const Params& p, int s) {
    const int tid = opaque_tid(), wid = tid >> 6, lane = tid & 63;
    const bool sample = (s == 8); const int rows = slab_rows(s);
    const bf16_t* oraw = (const bf16_t*)(p.ws + WS_ORAW + (size_t)(s & 1) * SZ_G1);
    const bf16_t* gE = (const bf16_t*)(p.ws + WS_GATE + (size_t)(s & 3) * SZ_GATE); const bf16_t* gR = gE + (size_t)4096 * 1024; const bf16_t* gP = gR + (size_t)4096 * 1024;
    bf16_t* mix = (bf16_t*)(p.ws + WS_MIX + (size_t)(s & 1) * SZ_G1);
    const float* scw = p.in[11];
    for (int lr = blockIdx.x * 8 + wid; lr < rows; lr += gridDim.x * 8) {
        const int hb = sample ? (lr >> 4) : (lr >> 11), tl = sample ? (lr & 15) : (lr & 2047), tlast = sample ? 15 : 2047;
#pragma unroll
        for (int part = 0; part < 2; ++part) { const int ch = (lane + 64 * part) * 8;
            float o[8];
            { const int hh = ch >> 7, dv0 = ch & 127, wv_ = dv0 >> 4, n0 = dv0 & 15, chunk = sample ? (lr >> 4) : (lr >> 6), tok = sample ? (lr & 15) : (lr & 63);
              const bf16_t* op = oraw + ((size_t)(((chunk * 8 + hh) * 8 + wv_) * 4 + (tok >> 4)) * 64 + ((tok & 15) >> 2) * 16 + n0) * 4 + (tok & 3);
#pragma unroll
              for (int k = 0; k < 8; ++k) o[k] = bf2f(op[k * 4]); }
            float ss = 0.f;
#pragma unroll
            for (int k = 0; k < 8; ++k) ss += o[k] * o[k];
#pragma unroll
            for (int d = 1; d < 16; d <<= 1) ss += __shfl_xor(ss, d);
            const float rstd = rsqrtf(ss * (1.0f / 128.0f) + 1e-6f);
            const u32x4 ew = *(const u32x4*)(gE + (size_t)lr * 1024 + ch), rw = *(const u32x4*)(gR + (size_t)lr * 1024 + ch);
            const float E[8] = {bflo(ew.x), bfhi(ew.x), bflo(ew.y), bfhi(ew.y), bflo(ew.z), bfhi(ew.z), bflo(ew.w), bfhi(ew.w)};
            const float R[8] = {bflo(rw.x), bfhi(rw.x), bflo(rw.y), bfhi(rw.y), bflo(rw.z), bfhi(rw.z), bflo(rw.w), bfhi(rw.w)};
            float pv[3][8];
#pragma unroll
            for (int r = 0; r < 3; ++r) { const int dt = r - 2;
                if (tl + dt >= 0) { const u32x4 w = *(const u32x4*)(gP + (size_t)(lr + dt) * 1024 + ch);
                    pv[r][0] = bflo(w.x); pv[r][1] = bfhi(w.x); pv[r][2] = bflo(w.y); pv[r][3] = bfhi(w.y); pv[r][4] = bflo(w.z); pv[r][5] = bfhi(w.z); pv[r][6] = bflo(w.w); pv[r][7] = bfhi(w.w); }
                else { const int hr = 2 + tl + dt;
                    const float* hp = sample ? p.in[4] + ((size_t)hb * 2 + hr) * 1024 + ch : (s == 0 ? nullptr : (const float*)(p.ws + WS_HS + (size_t)((s - 1) & 1) * SZ_HS) + ((size_t)hb * 2 + hr) * 1024 + ch);
#pragma unroll
                    for (int k = 0; k < 8; ++k) pv[r][k] = hp ? hp[k] : 0.f; } }
            if (tl >= tlast - 1) { const int hr = tl - (tlast - 1);
                float* d1 = sample ? p.out + O_SSC + ((size_t)hb * 2 + hr) * 1024 + ch : (float*)(p.ws + WS_HS + (size_t)(s & 1) * SZ_HS) + ((size_t)hb * 2 + hr) * 1024 + ch;
#pragma unroll
                for (int k = 0; k < 8; ++k) d1[k] = pv[2][k];
                if (!sample && s == 7) { float* d2 = p.out + O_PSC + ((size_t)hb * 2 + hr) * 1024 + ch;
#pragma unroll
                    for (int k = 0; k < 8; ++k) d2[k] = pv[2][k]; } }
            float m[8];
#pragma unroll
            for (int k = 0; k < 8; ++k) { const float c3 = scw[ch + k] * pv[0][k] + scw[1024 + ch + k] * pv[1][k] + scw[2048 + ch + k] * pv[2][k]; m[k] = o[k] * rstd * E[k] + R[k] * c3; }
            u32x4 w; w.x = cvt_pk_bf16(m[0], m[1]); w.y = cvt_pk_bf16(m[2], m[3]); w.z = cvt_pk_bf16(m[4], m[5]); w.w = cvt_pk_bf16(m[6], m[7]);
            *(u32x4*)(mix + (size_t)lr * 1024 + ch) = w; }
    }
}

__device__ void stage_ln(const Params& p, int s, int which) {
    const int tid = opaque_tid(), wid = tid >> 6, lane = tid & 63; const int rows = slab_rows(s);
    const float* gam = p.in[which ? 18 : 13]; const float* bet = p.in[which ? 19 : 14];
    const float* stats = (const float*)(p.ws + WS_STATS); bf16_t* x1b = (bf16_t*)(p.ws + WS_X1B + (size_t)(s & 1) * SZ_G1);
    for (int lr = blockIdx.x * 8 + wid; lr < rows; lr += gridDim.x * 8) {
        const int grow = grow_of(s, lr); float* yp = p.out + O_YP + (size_t)grow * 1024;
        const float sm = stats[(size_t)grow * 4 + which * 2], sq = stats[(size_t)grow * 4 + which * 2 + 1];
        const float mu = sm * (1.0f / 1024.0f), var = fmaxf(sq * (1.0f / 1024.0f) - mu * mu, 0.f), rstd = rsqrtf(var + 1e-5f);
#pragma unroll
        for (int i = 0; i < 4; ++i) { const int c = lane * 4 + 256 * i; const f32x4 v = *(const f32x4*)(yp + c), gg = *(const f32x4*)(gam + c), bb = *(const f32x4*)(bet + c);
            const f32x4 o = (v - mu) * rstd * gg + bb; *(f32x4*)(yp + c) = o;
            if (!which) { u32x2 w; w.x = cvt_pk_bf16(o[0], o[1]); w.y = cvt_pk_bf16(o[2], o[3]); *(u32x2*)(x1b + (size_t)lr * 1024 + c) = w; } }
    }
}

__device__ void stage_glu(const Params& p, int s) {
    const bool sample = (s == 8); const int rows = slab_rows(s);
    const bf16_t* av = (const bf16_t*)(p.ws + WS_AV + (size_t)(s & 1) * SZ_AV); bf16_t* hh = (bf16_t*)(p.ws + WS_H + (size_t)(s & 1) * SZ_H);
    const float* fw = p.in[16];
    const int total = rows * 352;
    const int tid = opaque_tid();
    for (int it = blockIdx.x * 512 + tid; it < total; it += gridDim.x * 512) {
        const int lr = it / 352, oc = it - lr * 352, ch = oc * 8;
        const int hb = sample ? (lr >> 4) : (lr >> 11), tl = sample ? (lr & 15) : (lr & 2047), tlast = sample ? 15 : 2047;
        float a[3][8];
#pragma unroll
        for (int r = 0; r < 3; ++r) { const int dt = r - 2;
            if (tl + dt >= 0) { const u32x4 w = *(const u32x4*)(av + (size_t)(lr + dt) * 5632 + ch);
                a[r][0] = bflo(w.x); a[r][1] = bfhi(w.x); a[r][2] = bflo(w.y); a[r][3] = bfhi(w.y); a[r][4] = bflo(w.z); a[r][5] = bfhi(w.z); a[r][6] = bflo(w.w); a[r][7] = bfhi(w.w); }
            else { const int hr = 2 + tl + dt;
                const float* hp = sample ? p.in[5] + ((size_t)hb * 2 + hr) * 2816 + ch : (s == 0 ? nullptr : (const float*)(p.ws + WS_HF + (size_t)((s - 1) & 1) * SZ_HF) + ((size_t)hb * 2 + hr) * 2816 + ch);
#pragma unroll
                for (int k = 0; k < 8; ++k) a[r][k] = hp ? hp[k] : 0.f; } }
        if (tl >= tlast - 1) { const int hr = tl - (tlast - 1);
            float* d1 = sample ? p.out + O_SFF + ((size_t)hb * 2 + hr) * 2816 + ch : (float*)(p.ws + WS_HF + (size_t)(s & 1) * SZ_HF) + ((size_t)hb * 2 + hr) * 2816 + ch;
#pragma unroll
            for (int k = 0; k < 8; ++k) d1[k] = a[2][k];
            if (!sample && s == 7) { float* d2 = p.out + O_PFF + ((size_t)hb * 2 + hr) * 2816 + ch;
#pragma unroll
                for (int k = 0; k < 8; ++k) d2[k] = a[2][k]; } }
        const u32x4 vw = *(const u32x4*)(av + (size_t)lr * 5632 + 2816 + ch);
        const float v[8] = {bflo(vw.x), bfhi(vw.x), bflo(vw.y), bfhi(vw.y), bflo(vw.z), bfhi(vw.z), bflo(vw.w), bfhi(vw.w)};
        float o[8];
#pragma unroll
        for (int k = 0; k < 8; ++k) { const float c3 = fw[ch + k] * a[0][k] + fw[2816 + ch + k] * a[1][k] + fw[5632 + ch + k] * a[2][k];
            o[k] = 0.5f * c3 * (1.0f + erff(c3 * 0.70710678118654752f)) * v[k]; }
        u32x4 w; w.x = cvt_pk_bf16(o[0], o[1]); w.y = cvt_pk_bf16(o[2], o[3]); w.z = cvt_pk_bf16(o[4], o[5]); w.w = cvt_pk_bf16(o[6], o[7]);
        *(u32x4*)(hh + (size_t)lr * 2816 + ch) = w;
    }
}

extern "C" __global__ void __launch_bounds__(512) mega(Params p) {
    extern __shared__ __attribute__((aligned(16))) unsigned char smem_raw[];
    LAS unsigned char* lds = (LAS unsigned char*)smem_raw;
    const int w = blockIdx.x, G = gridDim.x;
    for (int i = p.i_lo; i < p.i_hi; ++i) {
        #ifndef NO_WCONV
        if (i == 0) { stage_wconv(p, lds); __syncthreads(); }
#endif
        #ifndef NO_SCAN
        { const int s = i - 3; if (valid_slab(s)) { stage_scan(p, s, lds); __syncthreads(); } }
#endif
        const int sd = i - 9, s1 = i - 1, su = i - 7, so = i - 5;
        const int nd = valid_slab(sd) ? slab_panels(sd) * 4 : 0, n1 = valid_slab(s1) ? slab_panels(s1) * 36 : 0, nu = valid_slab(su) ? slab_panels(su) * 22 : 0, no = valid_slab(so) ? slab_panels(so) * 4 : 0;
#ifndef NO_DOWN
        if (nd) { DealDown S; S.w = w; S.G = G; S.n = nd; S.npm = slab_panels(sd);
            Gemm g; g.A = (const bf16_t*)(p.ws + WS_H + (size_t)(sd & 1) * SZ_H); g.Bt = (const bf16_t*)(p.ws + WS_WD); g.M = 4096; g.N = 1024; g.K = 2816;
            EpiRes E; E.resp = p.out + O_YP; E.ress = p.out + O_YP + (size_t)32768 * 1024; E.y = p.out + O_YP; E.stats = (float*)(p.ws + WS_STATS); E.s = sd; E.soff = 2;
            pg8::gemm_phase<EpiRes, DealDown, false>(lds, g, S, E, nullptr); __syncthreads(); }
#endif
#ifndef NO_G1
        if (n1) { Deal S; S.init(w, G, nd, 0, n1, slab_panels(s1));
            Gemm g; g.A = (const bf16_t*)(p.ws + WS_XB + (size_t)(s1 & 1) * SZ_XB); g.Bt = (const bf16_t*)(p.ws + WS_WIN); g.M = 4096; g.N = 9216; g.K = 1024;
            EpiIn E; E.qkv = (bf16_t*)(p.ws + WS_QKV + (size_t)(s1 & 1) * SZ_QKV); E.gate = (bf16_t*)(p.ws + WS_GATE + (size_t)(s1 & 3) * SZ_GATE); E.gnorm = p.in[10];
            pg8::gemm_phase<EpiIn, Deal, false>(lds, g, S, E, nullptr); __syncthreads(); }
#endif
#ifndef NO_UP
        if (nu) { Deal S; S.init(w, G, nd, n1, nu, slab_panels(su));
            Gemm g; g.A = (const bf16_t*)(p.ws + WS_X1B + (size_t)(su & 1) * SZ_G1); g.Bt = (const bf16_t*)(p.ws + WS_WUP); g.M = 4096; g.N = 5632; g.K = 1024;
            EpiUp E; E.av = (bf16_t*)(p.ws + WS_AV + (size_t)(su & 1) * SZ_AV);
            pg8::gemm_phase<EpiUp, Deal, false>(lds, g, S, E, nullptr); __syncthreads(); }
#endif
#ifndef NO_WO
        if (no) { Deal S; S.init(w, G, nd, n1 + nu, no, slab_panels(so));
            Gemm g; g.A = (const bf16_t*)(p.ws + WS_MIX + (size_t)(so & 1) * SZ_G1); g.Bt = (const bf16_t*)(p.ws + WS_WO); g.M = 4096; g.N = 1024; g.K = 1024;
            EpiRes E; E.resp = p.in[0]; E.ress = p.in[1]; E.y = p.out + O_YP; E.stats = (float*)(p.ws + WS_STATS); E.s = so; E.soff = 0;
            pg8::gemm_phase<EpiRes, Deal, false>(lds, g, S, E, nullptr); __syncthreads(); }
#endif
#ifndef NO_CVT
        if (valid_slab(i)) { stage_cvt(p, i, lds); __syncthreads(); }
#endif
#ifndef NO_PREP
        if (valid_slab(i - 2)) { stage_prep(p, i - 2, lds); __syncthreads(); }
#endif
#ifndef NO_MERGE
        if (valid_slab(i - 4)) stage_merge(p, i - 4);
#endif
#ifndef NO_LN
        if (valid_slab(i - 6)) stage_ln(p, i - 6, 0);
#ifndef NO_GLU
        if (valid_slab(i - 8)) stage_glu(p, i - 8);
#endif
        if (valid_slab(i - 10)) stage_ln(p, i - 10, 1);
#endif
        if (p.use_sync && i + 1 < p.i_hi) { cg::this_grid().sync(); }
    }
}

#ifndef MK_LAUNCHES
#define MK_LAUNCHES 1
#endif
extern "C" void kernel_launch(void* const* d_in, const int* in_sizes, int n_in, void* d_out, int out_size, void* d_ws, size_t ws_size, hipStream_t stream) {
    static int grid = 0;
    if (grid == 0) {
        int dev = 0, cus = 0, per_cu = 0;
        hipGetDevice(&dev); hipDeviceGetAttribute(&cus, hipDeviceAttributeMultiprocessorCount, dev);
        if (hipFuncSetAttribute((const void*)mega, hipFuncAttributeMaxDynamicSharedMemorySize, LDS_BYTES) != hipSuccess) fprintf(stderr, "hipFuncSetAttribute failed\n");
        if (hipOccupancyMaxActiveBlocksPerMultiprocessor(&per_cu, (const void*)mega, 512, LDS_BYTES) != hipSuccess || per_cu < 1) { fprintf(stderr, "occupancy query: %d\n", per_cu); per_cu = 1; }
        (void)hipGetLastError();
        grid = cus * 1;
        if (ws_size < WS_END) { fprintf(stderr, "workspace too small: %zu < %zu\n", ws_size, (size_t)WS_END); grid = -1; }
    }
    if (grid < 0) return;
    Params p{};
    for (int i = 0; i < 20; ++i) p.in[i] = (const float*)d_in[i];
    p.out = (float*)d_out; p.ws = (unsigned char*)d_ws;
#if MK_LAUNCHES == 1
    p.i_lo = 0; p.i_hi = NINT; p.use_sync = 1; p.pad = 0;
    void* args[] = {&p};
    hipError_t e = hipLaunchCooperativeKernel((const void*)mega, dim3(grid), dim3(512), args, LDS_BYTES, stream);
    if (e != hipSuccess) fprintf(stderr, "cooperative launch failed: %s (grid %d)\n", hipGetErrorString(e), grid);
#else
    for (int i = 0; i < NINT; ++i) { p.i_lo = i; p.i_hi = i + 1; p.use_sync = 0; p.pad = 0; hipLaunchKernelGGL(mega, dim3(grid), dim3(512), LDS_BYTES, stream, p); }
#endif
}
```

```cpp
#include <hip/hip_runtime.h>
#include <hip/hip_cooperative_groups.h>
#include <cstdio>
namespace cg = cooperative_groups;
__device__ __forceinline__ int opaque_tid() { int t; asm volatile("v_mov_b32 %0, %1" : "=v"(t) : "v"(threadIdx.x)); return t; }
namespace pg8 {
#define PG8_LAS __attribute__((address_space(3)))
typedef unsigned short bf16_t;
typedef short bf16x8 __attribute__((ext_vector_type(8)));
typedef float f32x4 __attribute__((ext_vector_type(4)));
typedef unsigned u32x4 __attribute__((ext_vector_type(4)));
constexpr int BM = 256, BK = 64, HALF = 128, HTB = HALF * BK * 2  , STAGE_BYTES = 8 * HTB, NXCD = 8, WGM = 8;
__host__ __device__ __forceinline__ int lds_byte(int r, int c) { const int st = (r >> 4) * 2 + (c >> 5), rr = r & 15, cc = c & 31, ob = rr * 64 + cc * 2; return st * 1024 + (ob ^ (((ob >> 9) & 1) << 5)); }
__host__ __device__ __forceinline__ void stage_rc(int b, int& R, int& C) { const int st = b / 1024, sb = b % 1024, swz = sb ^ (((sb >> 9) & 1) << 5); R = (st >> 1) * 16 + swz / 64; C = (st & 1) * 32 + (swz % 64) / 2; }
__host__ __device__ __forceinline__ int perm32(int rho) { const int n = rho >> 4, i = rho & 15; return 8 * (i >> 2) + 4 * n + (i & 3); }
struct Unit { int pm, pn, ty; };
struct Gemm { const char* base; long oA0, dA1, dA2, oB0, dB1, dB2; int K;
    __device__ __forceinline__ const char* selA(int ty) const { return base + oA0 + (long)(ty > 0) * dA1 + (long)(ty > 1) * dA2; }
    __device__ __forceinline__ const char* selB(int ty) const { return base + oB0 + (long)(ty > 0) * dB1 + (long)(ty > 1) * dB2; } };
typedef float f32x2c_ __attribute__((ext_vector_type(2))); typedef __bf16 bf16x2c_ __attribute__((ext_vector_type(2)));
__device__ __forceinline__ unsigned cvt_pk_bf16(float lo, float hi) { const f32x2c_ v = {lo, hi}; const bf16x2c_ b = __builtin_convertvector(v, bf16x2c_); return __builtin_bit_cast(unsigned, b); }
typedef float f32x2 __attribute__((ext_vector_type(2)));
template <class Epi, class Sched, bool STAMP = false>
__device__ __forceinline__ void gemm_phase(PG8_LAS unsigned char* lds, const Gemm g, const Sched& S, const Epi& E, unsigned long long* stamps) {
    const int tid = opaque_tid(), wid = __builtin_amdgcn_readfirstlane(tid >> 6), lane = tid & 63, wr = wid >> 2, wc = wid & 3, fr = lane & 15, fq = lane >> 4;
    const int K = g.K, nt = K / BK;
    int ts_lo = 0, ts_hi = 0, nts = 0; const unsigned long long rt_entry = STAMP ? (unsigned long long)wall_clock64() : 0ull;
#define PG8_STAMP() do { if (STAMP && wid == 0 && nts < 64) { const unsigned long long _c = (unsigned long long)clock64(); \
        ts_lo = (lane == nts) ? (int)(unsigned)_c : ts_lo; ts_hi = (lane == nts) ? (int)(unsigned)(_c >> 32) : ts_hi; ++nts; } } while (0)
    PG8_STAMP();
    unsigned voffA[2], voffB[2];
#pragma unroll
    for (int i = 0; i < 2; ++i) { int R, C; stage_rc(tid * 16 + i * 8192, R, C); const int Rb = Epi::PERM ? ((R & ~31) + perm32(R & 31)) : R;
        voffA[i] = (unsigned)(R * K + C) * 2u; voffB[i] = (unsigned)(Rb * K + C) * 2u; }
    const size_t kstep = (size_t)(BK * 2);
    const size_t hstep = (size_t)HALF * K * 2;
    const size_t tstep = 2 * hstep;
    const unsigned ldsw = (unsigned)wid * 1024u;
    const int aoff = lds_byte(wr * 64 + fr, fq * 8), boff = lds_byte(wc * 32 + fr, fq * 8);
#define PG8_SA(b, h) (((b) * 2 + (h)) * HTB)
#define PG8_SB(b, h) ((4 + (b) * 2 + (h)) * HTB)
#define PG8_STAGE(bufoff, gbase, voff) do { _Pragma("unroll") for (int _i = 0; _i < 2; ++_i) \
        __builtin_amdgcn_global_load_lds((const unsigned*)((const char*)(gbase) + (voff)[_i]), (PG8_LAS unsigned*)(lds + (bufoff) + ldsw + _i * 8192), 16, 0, 0); } while (0)
#define PG8_LDA(dst, b, h) do { _Pragma("unroll") for (int m = 0; m < 4; ++m) _Pragma("unroll") for (int k = 0; k < 2; ++k) dst[m][k] = *(const PG8_LAS bf16x8*)(lds + PG8_SA(b, h) + aoff + m * 2048 + k * 1024); } while (0)
#define PG8_LDB(dst, b, h) do { _Pragma("unroll") for (int n = 0; n < 2; ++n) _Pragma("unroll") for (int k = 0; k < 2; ++k) dst[n][k] = *(const PG8_LAS bf16x8*)(lds + PG8_SB(b, h) + boff + n * 2048 + k * 1024); } while (0)
#define PG8_MMA(ai, bj, At, Bt) do { __builtin_amdgcn_s_setprio(1); _Pragma("unroll") for (int m = 0; m < 4; ++m) _Pragma("unroll") for (int n = 0; n < 2; ++n) _Pragma("unroll") for (int k = 0; k < 2; ++k) \
        acc[ai][bj][m][n] = __builtin_amdgcn_mfma_f32_16x16x32_bf16(Bt[n][k], At[m][k], acc[ai][bj][m][n], 0, 0, 0); __builtin_amdgcn_s_setprio(0); } while (0)
#define PG8_WAIT_V(n) asm volatile("s_waitcnt vmcnt(" #n ")" ::: "memory")
#define PG8_WAIT_L(n) asm volatile("s_waitcnt lgkmcnt(" #n ")" ::: "memory")
#define PG8_BAR __builtin_amdgcn_s_barrier()
#define PG8_SCHED __builtin_amdgcn_sched_barrier(0)
    Unit cur, nxt; int ui = 0;
    if (!S.next(0, cur)) return;
    f32x4 acc[2][2][4][2];
#pragma unroll
    for (int a = 0; a < 2; ++a)
#pragma unroll
        for (int b = 0; b < 2; ++b)
#pragma unroll
            for (int m = 0; m < 4; ++m)
#pragma unroll
                for (int n = 0; n < 2; ++n) acc[a][b][m][n] = (f32x4){0.f, 0.f, 0.f, 0.f};
    bf16x8 At[4][2], B0[2][2], B1[2][2];
    const char* cA = g.selA(cur.ty) + (size_t)cur.pm * tstep; const char* cB = g.selB(cur.ty) + (size_t)cur.pn * tstep;
    S.a_ready(cur);
    PG8_STAGE(PG8_SB(0, 0), cB, voffB); PG8_STAGE(PG8_SA(0, 0), cA, voffA); PG8_STAGE(PG8_SB(0, 1), cB + hstep, voffB); PG8_STAGE(PG8_SA(0, 1), cA + hstep, voffA);
    if (wr == 1) PG8_BAR;
    PG8_WAIT_V(4); PG8_BAR;
    PG8_STAGE(PG8_SB(1, 0), cB + kstep, voffB); PG8_STAGE(PG8_SA(1, 0), cA + kstep, voffA); PG8_STAGE(PG8_SB(1, 1), cB + hstep + kstep, voffB);
    PG8_WAIT_V(6); PG8_BAR;
    PG8_STAMP();
    for (;;) {
        const bool has_next = S.next(ui + 1, nxt);
        const char* nA = has_next ? g.selA(nxt.ty) + (size_t)nxt.pm * tstep : cA; const char* nB = has_next ? g.selB(nxt.ty) + (size_t)nxt.pn * tstep : cB;
        for (int t = 0; t < nt; t += 2) {
            const bool last = (t == nt - 2);
            const char* a1 = cA + (size_t)(t + 1) * kstep;
            const char* a2 = last ? nA : cA + (size_t)(t + 2) * kstep; const char* b2 = last ? nB : cB + (size_t)(t + 2) * kstep;
            const char* a3 = a2 + kstep; const char* b3 = b2 + kstep;
            if (last && has_next) S.a_ready(nxt);
            PG8_LDB(B0, 0, 0); PG8_SCHED; PG8_LDA(At, 0, 0); PG8_STAGE(PG8_SA(1, 1), a1 + hstep, voffA);
            PG8_WAIT_L(8); PG8_BAR; PG8_WAIT_L(0); PG8_MMA(0, 0, At, B0); PG8_BAR; PG8_SCHED;
            PG8_LDB(B1, 0, 1); PG8_STAGE(PG8_SB(0, 0), b2, voffB);
            PG8_BAR; PG8_WAIT_L(0); PG8_MMA(0, 1, At, B1); PG8_BAR;
            PG8_LDA(At, 0, 1); PG8_STAGE(PG8_SA(0, 0), a2, voffA);
            PG8_BAR; PG8_WAIT_L(0); PG8_MMA(1, 0, At, B0); PG8_BAR; PG8_SCHED;
            PG8_STAGE(PG8_SB(0, 1), b2 + hstep, voffB);
            PG8_WAIT_V(6); PG8_BAR; PG8_MMA(1, 1, At, B1); PG8_BAR;
            PG8_LDB(B0, 1, 0); PG8_SCHED; PG8_LDA(At, 1, 0); PG8_STAGE(PG8_SA(0, 1), a2 + hstep, voffA);
            PG8_WAIT_L(8); PG8_BAR; PG8_WAIT_L(0); PG8_MMA(0, 0, At, B0); PG8_BAR; PG8_SCHED;
            PG8_LDB(B1, 1, 1); PG8_STAGE(PG8_SB(1, 0), b3, voffB);
            PG8_BAR; PG8_WAIT_L(0); PG8_MMA(0, 1, At, B1); PG8_BAR;
            PG8_LDA(At, 1, 1); PG8_STAGE(PG8_SA(1, 0), a3, voffA);
            PG8_BAR; PG8_WAIT_L(0); PG8_MMA(1, 0, At, B0); PG8_BAR; PG8_SCHED;
            PG8_STAGE(PG8_SB(1, 1), b3 + hstep, voffB);
            PG8_WAIT_V(6); PG8_BAR; PG8_MMA(1, 1, At, B1); PG8_BAR;
        }
        PG8_STAMP();
        if constexpr (!Epi::AFTER_DRAIN) { E(acc, cur, wr, wc, fr, fq); S.done(cur); }
        PG8_STAMP();
        if (!has_next) break;
#pragma unroll
        for (int a = 0; a < 2; ++a)
#pragma unroll
            for (int b = 0; b < 2; ++b)
#pragma unroll
                for (int m = 0; m < 4; ++m)
#pragma unroll
                    for (int n = 0; n < 2; ++n) acc[a][b][m][n] = (f32x4){0.f, 0.f, 0.f, 0.f};
        cur = nxt; cA = nA; cB = nB; ++ui;
    }
    PG8_WAIT_V(0);
    if (wr == 0) PG8_BAR;
    PG8_BAR;
    if constexpr (Epi::AFTER_DRAIN) { E.fused(acc, cur, wr, wc, fr, fq, lds, wid, lane); S.done(cur); }
    PG8_STAMP();
    if (STAMP && wid == 0) { stamps[lane] = lane < nts ? (((unsigned long long)(unsigned)ts_hi << 32) | (unsigned)ts_lo) : 0ull;
        if (lane == 62) stamps[62] = rt_entry; if (lane == 63) stamps[63] = (unsigned long long)wall_clock64(); }
#undef PG8_STAMP
#undef PG8_SA
#undef PG8_SB
#undef PG8_STAGE
#undef PG8_LDA
#undef PG8_LDB
#undef PG8_MMA
#undef PG8_WAIT_V
#undef PG8_WAIT_L
#undef PG8_BAR
#undef PG8_SCHED
}
}

using pg8::bf16_t; using pg8::bf16x8; using pg8::f32x4; using pg8::u32x4; using pg8::Unit; using pg8::Gemm; using pg8::cvt_pk_bf16;
typedef unsigned u32x2 __attribute__((ext_vector_type(2)));
#define LAS __attribute__((address_space(3)))
constexpr int NSLAB = 9, NSTAGE = 11, NINT = NSLAB + NSTAGE - 1;
constexpr int IN_DIM = 9232;
constexpr float ALPHA = 1.189207115002721f;
constexpr int LDS_BYTES = 152 * 1024;
constexpr size_t O_YP = 0, O_PGC = 34078720, O_PS = 34097152, O_PSC = 34359296, O_PFF = 34363392, O_SGC = 34374656, O_SS = 34669568, O_SSC = 38863872, O_SFF = 38929408;
constexpr int R_W = 0, R_QD = 16384, R_KT = 32768, R_QK = 49152, R_U = 57344, R_HDR = 73728, REC_BYTES = 73984;
constexpr size_t A256(size_t x) { return (x + 255) & ~(size_t)255; }
constexpr size_t WS_WIN = 0;
constexpr size_t WS_WO = WS_WIN + (size_t)9216 * 1024 * 2;
constexpr size_t WS_WUP = WS_WO + (size_t)1024 * 1024 * 2;
constexpr size_t WS_WD = WS_WUP + (size_t)5632 * 1024 * 2;
constexpr size_t WS_XB = WS_WD + (size_t)1024 * 2816 * 2;
constexpr size_t SZ_XB = (size_t)4096 * 1024 * 2;
constexpr size_t WS_AB = WS_XB + 2 * SZ_XB;
constexpr size_t WS_QKV = A256(WS_AB + (size_t)33280 * 16 * 4);
constexpr size_t SZ_QKV = (size_t)4096 * 3072 * 2;
constexpr size_t WS_GATE = WS_QKV + 2 * SZ_QKV;
constexpr size_t SZ_G1 = (size_t)4096 * 1024 * 2, SZ_GATE = 3 * SZ_G1;
constexpr size_t WS_REC = WS_GATE + 4 * SZ_GATE;
constexpr size_t SZ_REC = (size_t)512 * REC_BYTES;
constexpr size_t WS_ORAW = WS_REC + 2 * SZ_REC;
constexpr size_t WS_MIX = WS_ORAW + 2 * SZ_G1;
constexpr size_t WS_X1B = WS_MIX + 2 * SZ_G1;
constexpr size_t WS_AV = WS_X1B + 4 * SZ_G1;
constexpr size_t SZ_AV = (size_t)4096 * 5632 * 2;
constexpr size_t WS_H = WS_AV + 2 * SZ_AV;
constexpr size_t SZ_H = (size_t)4096 * 2816 * 2;
constexpr size_t WS_STATS = WS_H + 2 * SZ_H;
constexpr size_t WS_HQ = WS_STATS + (size_t)33280 * 16;
constexpr size_t SZ_HQ = (size_t)2 * 3 * 3072 * 4;
constexpr size_t WS_HS = WS_HQ + 2 * SZ_HQ;
constexpr size_t SZ_HS = (size_t)2 * 2 * 1024 * 4;
constexpr size_t WS_HF = WS_HS + 2 * SZ_HS;
constexpr size_t SZ_HF = (size_t)2 * 2 * 2816 * 4;
constexpr size_t WS_BAR = A256(WS_HF + 2 * SZ_HF);
constexpr size_t WS_PRE1 = WS_BAR + 16384;
constexpr size_t WS_PRE2 = WS_PRE1 + 2 * SZ_G1;
constexpr size_t WS_PRE2B = WS_PRE2 + 2 * SZ_G1;
constexpr size_t WS_WD2 = WS_PRE2B + 2 * SZ_G1;
constexpr size_t WS_END = WS_WD2 + (size_t)2 * 1024 * 1408 * 2;
constexpr int SPLIT_FROM = 5;

struct Params { const float* in[20]; float* out; unsigned char* ws; int i_lo, i_hi, use_sync, pad; };

__device__ __forceinline__ float bf2f(unsigned short b) { return __uint_as_float((unsigned)b << 16); }
__device__ __forceinline__ float bflo(unsigned w) { return __uint_as_float(w << 16); }
__device__ __forceinline__ float bfhi(unsigned w) { return __uint_as_float(w & 0xffff0000u); }
__device__ __forceinline__ unsigned short f2bf(float f) { return (unsigned short)(cvt_pk_bf16(f, 0.f) & 0xffffu); }
__device__ __forceinline__ float sigmoidf_(float x) { return __builtin_amdgcn_rcpf(1.0f + __expf(-x)); }
__device__ __forceinline__ float gelu_f(float v) {
    const float av = fabsf(v), t = __builtin_amdgcn_rcpf(av * 0.2316418882f + 1.0f);
    float q = t * 0.5307027145f + (-0.7265760135f); q = q * t + 0.7107068705f; q = q * t + (-0.142248368f); q = q * t + 0.127414796f; q = q * t;
    const float e = __builtin_amdgcn_exp2f(v * v * (-0.72134752044f)), m = v * (q * e);
    return v < 0.f ? m : v - m; }
__device__ __forceinline__ int slab_rows(int s) { return s < 8 ? 4096 : 512; }
__device__ __forceinline__ int slab_panels(int s) { return s < 8 ? 16 : 2; }
__device__ __forceinline__ int grow_of(int s, int lr) { return s < 8 ? ((lr >> 11) * 16384 + s * 2048 + (lr & 2047)) : (32768 + lr); }
__device__ __forceinline__ const float* xrow(const Params& p, int grow) { return grow < 32768 ? p.in[0] + (size_t)grow * 1024 : p.in[1] + (size_t)(grow - 32768) * 1024; }
__device__ __forceinline__ bool valid_slab(int s) { return s >= 0 && s < NSLAB; }

struct Deal {
    int w, G, nd, ns, cs, n1, nu, no, p1, pu, po;
    __device__ __forceinline__ int cand(int i) const { const int busy = w < nd ? 3 : (w >= G - ns ? cs : 0), r = busy + i;
        const int before = r * G - nd * (r < 3 ? r : 3) - ns * (r < cs ? r : cs), rank = w - (r < 3 ? (w < nd ? w : nd) : 0); return before + rank; }
    __device__ __forceinline__ static void map16(int j, int N, int& pm, int& pn) { const int x = j & 7, t = j >> 3; pm = 4 * (x & 3) + (t & 3); pn = (x >> 2) * (N >> 1) + (t >> 2); }
    __device__ __forceinline__ bool next(int i, Unit& u) const { const int q = cand(i); if (q >= n1 + nu + no) return false;
        if (q < n1) { u.ty = 0; if (p1 == 16) map16(q, 36, u.pm, u.pn); else { u.pm = q % p1; u.pn = q / p1; } }
        else if (q < n1 + nu) { const int j = q - n1; u.ty = 1; if (pu == 16) map16(j, 22, u.pm, u.pn); else { u.pm = j % pu; u.pn = j / pu; } }
        else { const int j = q - n1 - nu; u.ty = 2; if (po == 16) map16(j, 4, u.pm, u.pn); else { u.pm = j % po; u.pn = j / po; } }
        return true; }
    __device__ __forceinline__ void a_ready(const Unit&) const {}
    __device__ __forceinline__ void done(const Unit&) const {}
};
struct DealDown {
    int w, G, n, npm, split;
    __device__ __forceinline__ bool next(int i, Unit& u) const { const int j = w + i * G; if (j >= n || (n <= G && i > 0)) return false; const int t = split ? (j >> 1) : j; u.pm = t % npm; u.pn = t / npm; u.ty = split ? (j & 1) : 0; return true; }
    __device__ __forceinline__ void a_ready(const Unit&) const {}
    __device__ __forceinline__ void done(const Unit&) const {}
};

struct EpiIn {
    static constexpr bool PERM = true, AFTER_DRAIN = false;
    bf16_t* qkv; bf16_t* gate; const float* gnorm;
    __device__ __forceinline__ void operator()(const f32x4 (&acc)[2][2][4][2], const Unit& u, int wr, int wc, int fr, int fq) const {
        const int row0 = u.pm * 256 + wr * 64 + fr;
        if (u.pn < 12) {
#pragma unroll
            for (int ai = 0; ai < 2; ++ai)
#pragma unroll
                for (int m = 0; m < 4; ++m) { bf16_t* rowp = qkv + (size_t)(row0 + ai * 128 + m * 16) * 3072 + u.pn * 256 + wc * 32 + 8 * fq;
#pragma unroll
                    for (int bj = 0; bj < 2; ++bj) { const f32x4 v0 = acc[ai][bj][m][0], v1 = acc[ai][bj][m][1]; u32x4 w;
                        w.x = cvt_pk_bf16(v0[0], v0[1]); w.y = cvt_pk_bf16(v0[2], v0[3]); w.z = cvt_pk_bf16(v1[0], v1[1]); w.w = cvt_pk_bf16(v1[2], v1[3]);
                        *(u32x4*)(rowp + bj * 128) = w; } }
        } else {
            const int type = (u.pn - 12) >> 3, j = (u.pn - 12) & 7, ch = j * 128 + wc * 32 + 8 * fq;
            bf16_t* base = gate + (size_t)type * 4096 * 1024 + ch;
            float gn[8];
#pragma unroll
            for (int k = 0; k < 8; ++k) gn[k] = (type == 0) ? gnorm[(ch + k) & 127] : 1.0f;
#pragma unroll
            for (int ai = 0; ai < 2; ++ai)
#pragma unroll
                for (int m = 0; m < 4; ++m) { float o[8];
#pragma unroll
                    for (int n = 0; n < 2; ++n)
#pragma unroll
                        for (int k = 0; k < 4; ++k) { const float X = acc[ai][0][m][n][k], Y = acc[ai][1][m][n][k]; float r;
                            if (type == 0) r = sigmoidf_(Y) * X * sigmoidf_(X) * gn[n * 4 + k]; else if (type == 1) r = sigmoidf_(Y) * X; else r = X * Y;
                            o[n * 4 + k] = r; }
                    u32x4 w; w.x = cvt_pk_bf16(o[0], o[1]); w.y = cvt_pk_bf16(o[2], o[3]); w.z = cvt_pk_bf16(o[4], o[5]); w.w = cvt_pk_bf16(o[6], o[7]);
                    __builtin_nontemporal_store(w, (u32x4*)(base + (size_t)(row0 + ai * 128 + m * 16) * 1024)); }
        }
    }
};
struct EpiUp {
    static constexpr bool PERM = true, AFTER_DRAIN = false;
    bf16_t* av;
    __device__ __forceinline__ void operator()(const f32x4 (&acc)[2][2][4][2], const Unit& u, int wr, int wc, int fr, int fq) const {
        const int row0 = u.pm * 256 + wr * 64 + fr;
#pragma unroll
        for (int ai = 0; ai < 2; ++ai)
#pragma unroll
            for (int m = 0; m < 4; ++m) { bf16_t* rowp = av + (size_t)(row0 + ai * 128 + m * 16) * 5632 + u.pn * 256 + wc * 32 + 8 * fq;
#pragma unroll
                for (int bj = 0; bj < 2; ++bj) { const f32x4 v0 = acc[ai][bj][m][0], v1 = acc[ai][bj][m][1]; u32x4 w;
                    w.x = cvt_pk_bf16(v0[0], v0[1]); w.y = cvt_pk_bf16(v0[2], v0[3]); w.z = cvt_pk_bf16(v1[0], v1[1]); w.w = cvt_pk_bf16(v1[2], v1[3]);
                    *(u32x4*)(rowp + bj * 128) = w; } }
    }
};
struct EpiRes {
    static constexpr bool PERM = true, AFTER_DRAIN = false;
    const float* resp; const float* ress; const bf16_t* resb; bf16_t* pre; bf16_t* pre2b; float* y; float* stats; int s, soff, mode;
    __device__ __forceinline__ void operator()(const f32x4 (&acc)[2][2][4][2], const Unit& u, int wr, int wc, int fr, int fq) const {
        const int col0 = u.pn * 256 + wc * 32 + 8 * fq;
#pragma unroll
        for (int ai = 0; ai < 2; ++ai)
#pragma unroll
            for (int m = 0; m < 4; ++m) {
                const int lr = u.pm * 256 + ai * 128 + wr * 64 + m * 16 + fr, grow = grow_of(s, lr);
                float sm = 0.f, sq = 0.f;
                if (mode == 1 && u.ty == 1) {
                    bf16_t* op = pre2b + (size_t)lr * 1024 + col0;
#pragma unroll
                    for (int bj = 0; bj < 2; ++bj) { const f32x4 v0 = acc[ai][bj][m][0], v1 = acc[ai][bj][m][1]; u32x4 w; w.x = cvt_pk_bf16(v0[0], v0[1]); w.y = cvt_pk_bf16(v0[2], v0[3]); w.z = cvt_pk_bf16(v1[0], v1[1]); w.w = cvt_pk_bf16(v1[2], v1[3]); *(u32x4*)(op + bj * 128) = w; }
                } else if (mode == 0) {
                    const float* rp = (grow < 32768 ? resp + (size_t)grow * 1024 : ress + (size_t)(grow - 32768) * 1024) + col0; bf16_t* op = pre + (size_t)lr * 1024 + col0;
#pragma unroll
                    for (int bj = 0; bj < 2; ++bj) { const f32x4 r0 = __builtin_nontemporal_load((const f32x4*)(rp + bj * 128)), r1 = __builtin_nontemporal_load((const f32x4*)(rp + bj * 128 + 4)); const f32x4 v0 = r0 * ALPHA + acc[ai][bj][m][0], v1 = r1 * ALPHA + acc[ai][bj][m][1];
                        u32x4 w; w.x = cvt_pk_bf16(v0[0], v0[1]); w.y = cvt_pk_bf16(v0[2], v0[3]); w.z = cvt_pk_bf16(v1[0], v1[1]); w.w = cvt_pk_bf16(v1[2], v1[3]); *(u32x4*)(op + bj * 128) = w;
                        sm += (v0[0] + v0[1]) + (v0[2] + v0[3]) + (v1[0] + v1[1]) + (v1[2] + v1[3]);
                        sq += (v0[0] * v0[0] + v0[1] * v0[1]) + (v0[2] * v0[2] + v0[3] * v0[3]) + (v1[0] * v1[0] + v1[1] * v1[1]) + (v1[2] * v1[2] + v1[3] * v1[3]); }
                } else {
                    const bf16_t* rp = resb + (size_t)lr * 1024 + col0; bf16_t* op = pre + (size_t)lr * 1024 + col0;
#pragma unroll
                    for (int bj = 0; bj < 2; ++bj) { const u32x4 rw = *(const u32x4*)(rp + bj * 128);
                        const f32x4 r0 = {bflo(rw.x), bfhi(rw.x), bflo(rw.y), bfhi(rw.y)}, r1 = {bflo(rw.z), bfhi(rw.z), bflo(rw.w), bfhi(rw.w)};
                        const f32x4 v0 = r0 * ALPHA + acc[ai][bj][m][0], v1 = r1 * ALPHA + acc[ai][bj][m][1];
                        u32x4 w; w.x = cvt_pk_bf16(v0[0], v0[1]); w.y = cvt_pk_bf16(v0[2], v0[3]); w.z = cvt_pk_bf16(v1[0], v1[1]); w.w = cvt_pk_bf16(v1[2], v1[3]); *(u32x4*)(op + bj * 128) = w;
                        sm += (v0[0] + v0[1]) + (v0[2] + v0[3]) + (v1[0] + v1[1]) + (v1[2] + v1[3]);
                        sq += (v0[0] * v0[0] + v0[1] * v0[1]) + (v0[2] * v0[2] + v0[3] * v0[3]) + (v1[0] * v1[0] + v1[1] * v1[1]) + (v1[2] * v1[2] + v1[3] * v1[3]); }
                }
                sm += __shfl_xor(sm, 16); sm += __shfl_xor(sm, 32); sq += __shfl_xor(sq, 16); sq += __shfl_xor(sq, 32);
                if (fq == 0 && soff >= 0) { atomicAdd(stats + (size_t)grow * 4 + soff, sm); atomicAdd(stats + (size_t)grow * 4 + soff + 1, sq); }
            }
    }
};
struct EpiMulti {
    static constexpr bool PERM = true, AFTER_DRAIN = false;
    EpiIn e0; EpiUp e1; EpiRes e2;
    __device__ __forceinline__ void operator()(const f32x4 (&acc)[2][2][4][2], const Unit& u, int wr, int wc, int fr, int fq) const {
        if (u.ty == 0) e0(acc, u, wr, wc, fr, fq); else if (u.ty == 1) e1(acc, u, wr, wc, fr, fq); else e2(acc, u, wr, wc, fr, fq); }
};

__device__ __forceinline__ int src_col_in(int np) {
    const int pn = np >> 8; if (pn < 12) return np;
    const int within = np & 255, half = within >> 7, cl = within & 127, type = (pn - 12) >> 3, j = (pn - 12) & 7;
    const int base = type == 0 ? (half ? 7184 : 3072) : (type == 1 ? (half ? 8208 : 4112) : (half ? 6160 : 5136));
    return base + j * 128 + cl;
}
__device__ void stage_wconv(const Params& p, LAS unsigned char* lds, int t_lo, int t_hi) {
    LAS float* t = (LAS float*)lds;
    const int tid = opaque_tid();
    for (int ti = t_lo + blockIdx.x; ti < t_hi; ti += gridDim.x) {
        const float* W; bf16_t* D; int N, K, tk, tn, which;
        if (ti < 2304) { which = 0; W = p.in[6]; D = (bf16_t*)(p.ws + WS_WIN); N = IN_DIM; K = 1024; tk = ti / 144; tn = ti % 144; }
        else if (ti < 2560) { const int q = ti - 2304; which = 1; W = p.in[12]; D = (bf16_t*)(p.ws + WS_WO); N = 1024; K = 1024; tk = q / 16; tn = q % 16; }
        else if (ti < 3968) { const int q = ti - 2560; which = 2; W = p.in[15]; D = (bf16_t*)(p.ws + WS_WUP); N = 5632; K = 1024; tk = q / 88; tn = q % 88; }
        else { const int q = ti - 3968; which = 3; W = p.in[17]; D = (bf16_t*)(p.ws + WS_WD); N = 1024; K = 2816; tk = q / 16; tn = q % 16; }
        const int c = tid & 63, r8 = tid >> 6;
        const int np = tn * 64 + c, sc = which == 0 ? src_col_in(np) : np;
#pragma unroll
        for (int i = 0; i < 8; ++i) { const int r = r8 + 8 * i; t[r * 65 + c] = W[(size_t)(tk * 64 + r) * N + sc]; }
        __syncthreads();
#pragma unroll
        for (int i = 0; i < 8; ++i) { const int rr = r8 + 8 * i; D[(size_t)(tn * 64 + rr) * K + tk * 64 + c] = f2bf(t[c * 65 + rr]); }
        if (which == 3) { bf16_t* D2 = (bf16_t*)(p.ws + WS_WD2) + (size_t)(tk >= 22) * 1024 * 1408 + (size_t)(tn * 64) * 1408 + (tk >= 22 ? tk - 22 : tk) * 64 + c;
#pragma unroll
            for (int i = 0; i < 8; ++i) { const int rr = r8 + 8 * i; D2[(size_t)rr * 1408] = f2bf(t[c * 65 + rr]); } }
        __syncthreads();
    }
}

__device__ void stage_cvt(const Params& p, int s, LAS unsigned char* lds, int vid, int V) {
    LAS float* sW = (LAS float*)lds;
    const int tid = opaque_tid(), wid = tid >> 6, lane = tid & 63;
    for (int idx = tid; idx < 4096; idx += 512) { const int k = idx >> 2, q = idx & 3; const f32x4 wv4 = *(const f32x4*)(p.in[6] + (size_t)k * IN_DIM + 4096 + q * 4);
#pragma unroll
        for (int j = 0; j < 4; ++j) sW[(q * 4 + j) * 1024 + k] = wv4[j]; }
    __syncthreads();
    bf16_t* xb = (bf16_t*)(p.ws + WS_XB + (size_t)(s & 1) * SZ_XB);
    float* ab = (float*)(p.ws + WS_AB); float* stats = (float*)(p.ws + WS_STATS);
    const int rows = slab_rows(s);
    for (int lr = (vid * 8 + wid) * 2; lr < rows; lr += V * 16) {
        const int grow0 = grow_of(s, lr), grow1 = grow_of(s, lr + 1); const float* xr0 = xrow(p, grow0); const float* xr1 = xrow(p, grow1);
        f32x4 xa[4], xc[4];
#pragma unroll
        for (int i = 0; i < 4; ++i) { xa[i] = __builtin_nontemporal_load((const f32x4*)(xr0 + lane * 4 + 256 * i)); xc[i] = __builtin_nontemporal_load((const f32x4*)(xr1 + lane * 4 + 256 * i)); }
#pragma unroll
        for (int i = 0; i < 4; ++i) { u32x2 w; w.x = cvt_pk_bf16(xa[i][0], xa[i][1]); w.y = cvt_pk_bf16(xa[i][2], xa[i][3]); *(u32x2*)(xb + (size_t)lr * 1024 + lane * 4 + 256 * i) = w;
            w.x = cvt_pk_bf16(xc[i][0], xc[i][1]); w.y = cvt_pk_bf16(xc[i][2], xc[i][3]); *(u32x2*)(xb + (size_t)(lr + 1) * 1024 + lane * 4 + 256 * i) = w; }
        float a0[16], a1[16];
#pragma unroll
        for (int o = 0; o < 16; ++o) { float s0 = 0.f, s1 = 0.f;
#pragma unroll
            for (int i = 0; i < 4; ++i) { const f32x4 wv = *(const LAS f32x4*)(sW + o * 1024 + lane * 4 + 256 * i);
                s0 += xa[i][0] * wv[0] + xa[i][1] * wv[1] + xa[i][2] * wv[2] + xa[i][3] * wv[3]; s1 += xc[i][0] * wv[0] + xc[i][1] * wv[1] + xc[i][2] * wv[2] + xc[i][3] * wv[3]; }
            a0[o] = s0; a1[o] = s1; if ((o & 3) == 3) __builtin_amdgcn_sched_barrier(0); }
#pragma unroll
        for (int o = 0; o < 8; ++o) { const bool hi = lane & 32; const float k0 = hi ? a0[o + 8] : a0[o], s0 = hi ? a0[o] : a0[o + 8], k1 = hi ? a1[o + 8] : a1[o], s1 = hi ? a1[o] : a1[o + 8];
            a0[o] = k0 + __shfl_xor(s0, 32); a1[o] = k1 + __shfl_xor(s1, 32); }
#pragma unroll
        for (int o = 0; o < 4; ++o) { const bool hi = lane & 16; const float k0 = hi ? a0[o + 4] : a0[o], s0 = hi ? a0[o] : a0[o + 4], k1 = hi ? a1[o + 4] : a1[o], s1 = hi ? a1[o] : a1[o + 4];
            a0[o] = k0 + __shfl_xor(s0, 16); a1[o] = k1 + __shfl_xor(s1, 16); }
#pragma unroll
        for (int o = 0; o < 2; ++o) { const bool hi = lane & 8; const float k0 = hi ? a0[o + 2] : a0[o], s0 = hi ? a0[o] : a0[o + 2], k1 = hi ? a1[o + 2] : a1[o], s1 = hi ? a1[o] : a1[o + 2];
            a0[o] = k0 + __shfl_xor(s0, 8); a1[o] = k1 + __shfl_xor(s1, 8); }
        { const bool hi = lane & 4; const float k0 = hi ? a0[1] : a0[0], s0 = hi ? a0[0] : a0[1], k1 = hi ? a1[1] : a1[0], s1 = hi ? a1[0] : a1[1];
            a0[0] = k0 + __shfl_xor(s0, 4); a1[0] = k1 + __shfl_xor(s1, 4); }
        a0[0] += __shfl_xor(a0[0], 1); a0[0] += __shfl_xor(a0[0], 2); a1[0] += __shfl_xor(a1[0], 1); a1[0] += __shfl_xor(a1[0], 2);
        if ((lane & 3) == 0) { const int o = ((lane >> 5) & 1) * 8 + ((lane >> 4) & 1) * 4 + ((lane >> 3) & 1) * 2 + ((lane >> 2) & 1); ab[(size_t)grow0 * 16 + o] = a0[0]; ab[(size_t)grow1 * 16 + o] = a1[0]; }
        if (lane < 4) { stats[(size_t)grow0 * 4 + lane] = 0.f; stats[(size_t)grow1 * 4 + lane] = 0.f; }
    }
}

constexpr int P_G = 0, P_BETA = 256, P_EG = 512, P_ET = 768, P_KB = 1024, P_QB = 18432, P_RT = 35840, P_ABF = 69632, P_ADIAG = 78336, P_TB = 82432;
constexpr int P_OW = 1024  , P_OU = 19456, P_OQD = 86016, P_OKT = 104448, P_OQK = 122880;
__device__ __forceinline__ int pslot(int chunk) { return (chunk + (chunk >> 3)) * 16; }
__device__ __forceinline__ bf16x8 mk8(unsigned a, unsigned b, unsigned c, unsigned d) { u32x4 v = {a, b, c, d}; return __builtin_bit_cast(bf16x8, v); }
__device__ void prep_unit(const Params& p, int s, int idx, LAS unsigned char* lds) {
    const int tid = opaque_tid(), wid = tid >> 6, lane = tid & 63;
    const bool sample = (s == 8);
    int h, lr0, grow0, ntok, recidx, hb  ; bool first, last;
    if (!sample) { const int b = idx >> 8, rem = idx & 255, c = rem >> 3; h = rem & 7; lr0 = b * 2048 + c * 64; grow0 = b * 16384 + s * 2048 + c * 64; ntok = 64; recidx = (b * 8 + h) * 32 + c; hb = b; first = (c == 0); last = (c == 31); }
    else { const int seq = idx >> 3; h = idx & 7; lr0 = seq * 16; grow0 = 32768 + seq * 16; ntok = 16; recidx = idx; hb = seq; first = true; last = true; }
    LAS float* sG = (LAS float*)(lds + P_G); LAS float* sBeta = (LAS float*)(lds + P_BETA); LAS float* sEG = (LAS float*)(lds + P_EG); LAS float* sET = (LAS float*)(lds + P_ET);
    unsigned char* rec = p.ws + WS_REC + (size_t)(s & 1) * SZ_REC + (size_t)recidx * REC_BYTES;
    const bf16_t* qkv = (const bf16_t*)(p.ws + WS_QKV + (size_t)(s & 1) * SZ_QKV);
    if (wid == 0) {
        const int t = lane; const bool v = t < ntok; const int gr = grow0 + (v ? t : 0);
        const float* ab = (const float*)(p.ws + WS_AB) + (size_t)gr * 16;
        const float bl = ab[h], al = ab[8 + h] + p.in[9][h];
        const float sp = al > 20.f ? al : log1pf(__expf(al));
        float g = v ? -__expf(p.in[8][h]) * sp : 0.f; const float beta = v ? sigmoidf_(bl) : 0.f;
#pragma unroll
        for (int d = 1; d < 64; d <<= 1) { const float o = __shfl_up(g, d); if (lane >= d) g += o; }
        const float gl = __shfl(g, 63);
        sG[t] = g; sBeta[t] = beta; sEG[t] = __expf(g); sET[t] = __expf(gl - g);
        if (lane == 0) *(float*)(rec + R_HDR) = __expf(gl);
    }
    __syncthreads();
    const float* cw = p.in[7];
#pragma unroll
    for (int it = 0; it < 3; ++it) {
        const int i = it * 512 + tid, o = i & 15, rest = i >> 4, tensor = rest % 3, tp = rest / 3, t0 = 2 * tp;
        const int cb = tensor * 1024 + h * 128 + o * 8;
        float x[5][8];
#pragma unroll
        for (int r = 0; r < 5; ++r) { const int t = t0 - 3 + r;
            if (t >= 0 || !first) { const u32x4 w = *(const u32x4*)(qkv + (size_t)(lr0 + t) * 3072 + cb);
                x[r][0] = bflo(w.x); x[r][1] = bfhi(w.x); x[r][2] = bflo(w.y); x[r][3] = bfhi(w.y); x[r][4] = bflo(w.z); x[r][5] = bfhi(w.z); x[r][6] = bflo(w.w); x[r][7] = bfhi(w.w); }
            else if (sample) { const float* hp = p.in[2] + ((size_t)hb * 3 + (3 + t)) * 3072 + cb;
#pragma unroll
                for (int k = 0; k < 8; ++k) x[r][k] = hp[k]; }
            else if (s == 0) {
#pragma unroll
                for (int k = 0; k < 8; ++k) x[r][k] = 0.f; }
            else { const float* hp = (const float*)(p.ws + WS_HQ + (size_t)((s - 1) & 1) * SZ_HQ) + ((size_t)hb * 3 + (3 + t)) * 3072 + cb;
#pragma unroll
                for (int k = 0; k < 8; ++k) x[r][k] = hp[k]; } }
        if (last && t0 + 1 == ntok - 1) {
#pragma unroll
            for (int r = 0; r < 3; ++r) {
                float* d1 = sample ? p.out + O_SGC + ((size_t)hb * 3 + r) * 3072 + cb : (float*)(p.ws + WS_HQ + (size_t)(s & 1) * SZ_HQ) + ((size_t)hb * 3 + r) * 3072 + cb;
#pragma unroll
                for (int k = 0; k < 8; ++k) d1[k] = x[2 + r][k];
                if (!sample && s == 7) { float* d2 = p.out + O_PGC + ((size_t)hb * 3 + r) * 3072 + cb;
#pragma unroll
                    for (int k = 0; k < 8; ++k) d2[k] = x[2 + r][k]; } } }
        float y0[8], y1[8], ss0 = 0.f, ss1 = 0.f;
#pragma unroll
        for (int k = 0; k < 8; ++k) { const float w0 = cw[cb + k], w1 = cw[3072 + cb + k], w2 = cw[6144 + cb + k], w3 = cw[9216 + cb + k];
            float a = w0 * x[0][k] + w1 * x[1][k] + w2 * x[2][k] + w3 * x[3][k]; float b = w0 * x[1][k] + w1 * x[2][k] + w2 * x[3][k] + w3 * x[4][k];
            a = a * sigmoidf_(a); b = b * sigmoidf_(b); y0[k] = a; y1[k] = b; ss0 += a * a; ss1 += b * b; }
#pragma unroll
        for (int d = 1; d < 16; d <<= 1) { ss0 += __shfl_xor(ss0, d); ss1 += __shfl_xor(ss1, d); }
        const int t1 = t0 + 1; const bool v0 = t0 < ntok, v1 = t1 < ntok;
        float m0, m1;
        if (tensor == 0) { m0 = rsqrtf(ss0 + 1e-6f) * 0.08838834764831845f; m1 = rsqrtf(ss1 + 1e-6f) * 0.08838834764831845f; }
        else if (tensor == 1) { m0 = rsqrtf(ss0 + 1e-6f); m1 = rsqrtf(ss1 + 1e-6f); }
        else { m0 = 1.f; m1 = 1.f; }
#pragma unroll
        for (int k = 0; k < 8; ++k) { y0[k] = v0 ? y0[k] * m0 : 0.f; y1[k] = v1 ? y1[k] * m1 : 0.f; }
        const float b0 = sBeta[t0], b1 = sBeta[t1], eg0 = sEG[t0], eg1 = sEG[t1], et0 = sET[t0], et1 = sET[t1];
        if (tensor == 0) {
            u32x4 w; w.x = cvt_pk_bf16(y0[0], y0[1]); w.y = cvt_pk_bf16(y0[2], y0[3]); w.z = cvt_pk_bf16(y0[4], y0[5]); w.w = cvt_pk_bf16(y0[6], y0[7]);
            *(LAS u32x4*)(lds + P_QB + t0 * 272 + o * 16) = w;
            w.x = cvt_pk_bf16(y1[0], y1[1]); w.y = cvt_pk_bf16(y1[2], y1[3]); w.z = cvt_pk_bf16(y1[4], y1[5]); w.w = cvt_pk_bf16(y1[6], y1[7]);
            *(LAS u32x4*)(lds + P_QB + t1 * 272 + o * 16) = w;
            const int kb = o >> 2, oo = o & 3, half = oo >> 1, g0 = (oo & 1) * 2;
#pragma unroll
            for (int tt = 0; tt < 2; ++tt) { const int t = t0 + tt; const float e = tt ? eg1 : eg0; const float* yy = tt ? y1 : y0; const int mt = t >> 4, m = t & 15;
                const int ck = (mt * 4 + kb) * 64 + g0 * 16 + m;
                u32x2 a; a.x = cvt_pk_bf16(yy[0] * e, yy[1] * e); a.y = cvt_pk_bf16(yy[2] * e, yy[3] * e); *(LAS u32x2*)(lds + P_OQD + pslot(ck) + half * 8) = a;
                a.x = cvt_pk_bf16(yy[4] * e, yy[5] * e); a.y = cvt_pk_bf16(yy[6] * e, yy[7] * e); *(LAS u32x2*)(lds + P_OQD + pslot(ck + 16) + half * 8) = a; }
        } else if (tensor == 1) {
            u32x4 w; w.x = cvt_pk_bf16(y0[0], y0[1]); w.y = cvt_pk_bf16(y0[2], y0[3]); w.z = cvt_pk_bf16(y0[4], y0[5]); w.w = cvt_pk_bf16(y0[6], y0[7]);
            *(LAS u32x4*)(lds + P_KB + t0 * 272 + o * 16) = w;
            w.x = cvt_pk_bf16(y1[0], y1[1]); w.y = cvt_pk_bf16(y1[2], y1[3]); w.z = cvt_pk_bf16(y1[4], y1[5]); w.w = cvt_pk_bf16(y1[6], y1[7]);
            *(LAS u32x4*)(lds + P_KB + t1 * 272 + o * 16) = w;
            const int dt = o >> 1, kb = t0 >> 5, r = t0 & 31, half = r >> 4, rr = r & 15, gp = rr >> 2, ep = half * 4 + (rr & 3);
#pragma unroll
            for (int k = 0; k < 8; ++k) { const int m = (o & 1) * 8 + k;
                *(LAS unsigned*)(lds + P_RT + (128 + o * 8 + k) * 132 + t0 * 2) = cvt_pk_bf16(y0[k] * b0 * eg0, y1[k] * b1 * eg1);
                *(LAS unsigned*)(lds + P_OKT + pslot((dt * 2 + kb) * 64 + gp * 16 + m) + ep * 2) = cvt_pk_bf16(y0[k] * et0, y1[k] * et1); }
        } else {
#pragma unroll
            for (int k = 0; k < 8; ++k) *(LAS unsigned*)(lds + P_RT + (o * 8 + k) * 132 + t0 * 2) = cvt_pk_bf16(y0[k] * b0, y1[k] * b1);
        }
    }
    __syncthreads();
    const int n = lane & 15, g = lane >> 4;
    {
        const int itile = wid >> 1;
        bf16x8 ak[4], aq[4];
#pragma unroll
        for (int kb = 0; kb < 4; ++kb) { ak[kb] = *(const LAS bf16x8*)(lds + P_KB + (itile * 16 + n) * 272 + kb * 64 + g * 16); aq[kb] = *(const LAS bf16x8*)(lds + P_QB + (itile * 16 + n) * 272 + kb * 64 + g * 16); }
#pragma unroll
        for (int jj = 0; jj < 2; ++jj) { const int jt = (wid & 1) * 2 + jj;
            f32x4 ckk = {0.f, 0.f, 0.f, 0.f}, cqk = {0.f, 0.f, 0.f, 0.f};
#pragma unroll
            for (int kb = 0; kb < 4; ++kb) { const bf16x8 bk = *(const LAS bf16x8*)(lds + P_KB + (jt * 16 + n) * 272 + kb * 64 + g * 16);
                ckk = __builtin_amdgcn_mfma_f32_16x16x32_bf16(ak[kb], bk, ckk, 0, 0, 0); cqk = __builtin_amdgcn_mfma_f32_16x16x32_bf16(aq[kb], bk, cqk, 0, 0, 0); }
            const int j = jt * 16 + n; const float Gj = sG[j];
#pragma unroll
            for (int e = 0; e < 4; ++e) { const int i = itile * 16 + 4 * g + e; const float dd = fminf(sG[i] - Gj, 0.f), ex = __expf(dd);
                const float av = (j < i) ? sBeta[i] * ckk[e] * ex : 0.f, qv = (j <= i) ? cqk[e] * ex : 0.f;
                *(LAS bf16_t*)(lds + P_ABF + i * 136 + j * 2) = f2bf(-av);
                if (itile == jt) *(LAS float*)(lds + P_ADIAG + ((itile * 16 + 4 * g + e) * 16 + n) * 4) = av;
                const int kb2 = jt >> 1, half = jt & 1, gp = n >> 2, ep = half * 4 + (n & 3), m = 4 * g + e;
                *(LAS bf16_t*)(lds + P_OQK + pslot((itile * 2 + kb2) * 64 + gp * 16 + m) + ep * 2) = f2bf(qv); }
        }
    }
    __syncthreads();
    if (wid == 0) {
        const int blk = lane >> 4, c = lane & 15; const LAS float* A = (const LAS float*)(lds + P_ADIAG) + blk * 256;
        float T[16];
#pragma unroll
        for (int r = 0; r < 16; ++r) { float a = (r == c) ? 1.f : 0.f;
#pragma unroll
            for (int jx = 0; jx < r; ++jx) a -= A[r * 16 + jx] * T[jx];
            T[r] = a; }
#pragma unroll
        for (int r = 0; r < 16; ++r) *(LAS bf16_t*)(lds + P_TB + (blk * 16 + r) * 40 + c * 2) = f2bf(T[r]);
    }
    __syncthreads();
    {
        bf16x8 Xop[2][2];
#pragma unroll
        for (int a = 0; a < 2; ++a)
#pragma unroll
            for (int b = 0; b < 2; ++b) Xop[a][b] = mk8(0u, 0u, 0u, 0u);
        unsigned xw[2][2][4];
#pragma unroll
        for (int a = 0; a < 2; ++a)
#pragma unroll
            for (int b = 0; b < 2; ++b)
#pragma unroll
                for (int c = 0; c < 4; ++c) xw[a][b][c] = 0u;
#pragma unroll
        for (int blk = 0; blk < 4; ++blk) {
            f32x4 acc[2];
#pragma unroll
            for (int ct = 0; ct < 2; ++ct) { const int f = 32 * wid + 16 * ct + n; const LAS unsigned* rp = (const LAS unsigned*)(lds + P_RT + f * 132 + 32 * blk + 8 * g);
                const unsigned r0 = rp[0], r1 = rp[1]; acc[ct] = (f32x4){bflo(r0), bfhi(r0), bflo(r1), bfhi(r1)}; }
            if (blk >= 1) { const LAS unsigned char* ap = lds + P_ABF + (blk * 16 + n) * 136 + 8 * g; const u32x2 a0 = *(const LAS u32x2*)ap, a1 = *(const LAS u32x2*)(ap + 32);
                const bf16x8 A = mk8(a0.x, a0.y, a1.x, a1.y);
#pragma unroll
                for (int ct = 0; ct < 2; ++ct) acc[ct] = __builtin_amdgcn_mfma_f32_16x16x32_bf16(A, mk8(xw[0][ct][0], xw[0][ct][1], xw[0][ct][2], xw[0][ct][3]), acc[ct], 0, 0, 0); }
            if (blk == 3) { const LAS unsigned char* ap = lds + P_ABF + (blk * 16 + n) * 136 + 64 + 8 * g; const u32x2 a0 = *(const LAS u32x2*)ap, a1 = *(const LAS u32x2*)(ap + 32);
                const bf16x8 A = mk8(a0.x, a0.y, a1.x, a1.y);
#pragma unroll
                for (int ct = 0; ct < 2; ++ct) acc[ct] = __builtin_amdgcn_mfma_f32_16x16x32_bf16(A, mk8(xw[1][ct][0], xw[1][ct][1], xw[1][ct][2], xw[1][ct][3]), acc[ct], 0, 0, 0); }
            const u32x2 tv = *(const LAS u32x2*)(lds + P_TB + (blk * 16 + n) * 40 + 8 * g);
            const bf16x8 Top = mk8(tv.x, tv.y, 0u, 0u);
#pragma unroll
            for (int ct = 0; ct < 2; ++ct) {
                const bf16x8 Yop = mk8(cvt_pk_bf16(acc[ct][0], acc[ct][1]), cvt_pk_bf16(acc[ct][2], acc[ct][3]), 0u, 0u);
                f32x4 x = {0.f, 0.f, 0.f, 0.f}; x = __builtin_amdgcn_mfma_f32_16x16x32_bf16(Top, Yop, x, 0, 0, 0);
                const unsigned p0 = cvt_pk_bf16(x[0], x[1]), p1 = cvt_pk_bf16(x[2], x[3]);
                xw[blk >> 1][ct][(blk & 1) * 2] = p0; xw[blk >> 1][ct][(blk & 1) * 2 + 1] = p1;
                if (wid < 4) { const int wv = 2 * wid + ct; u32x2 st; st.x = p0; st.y = p1; *(LAS u32x2*)(lds + P_OU + ((wv * 4 + blk) * 64 + lane) * 8) = st; }
                else { const int kbp = wid - 4, gp = n >> 2, ep = ct * 4 + (n & 3);
#pragma unroll
                    for (int e = 0; e < 4; ++e) { const int mp = 4 * g + e; *(LAS bf16_t*)(lds + P_OW + pslot((blk * 4 + kbp) * 64 + gp * 16 + mp) + ep * 2) = f2bf(-x[e]); } }
            }
        }
        (void)Xop;
    }
    __syncthreads();
#pragma unroll
    for (int i = 0; i < 9; ++i) { const int c = i * 512 + tid;
        int off; if (i < 2) off = P_OW + pslot(c); else if (i < 4) off = P_OQD + pslot(c - 1024); else if (i < 6) off = P_OKT + pslot(c - 2048); else if (i < 7) off = P_OQK + pslot(c - 3072); else off = P_OU + (c - 3584) * 16;
        *(u32x4*)(rec + (size_t)c * 16) = *(const LAS u32x4*)(lds + off); }
    __syncthreads();
}
__device__ void stage_prep(const Params& p, int s, LAS unsigned char* lds, int vid, int V) {
    const int nu = s < 8 ? 512 : 256;
    for (int idx = vid; idx < nu; idx += V) prep_unit(p, s, idx, lds);
}

__device__ void scan_chain(const Params& p, int s, int chain, LAS unsigned char* lds) {
    const int tid = opaque_tid(), wv = tid >> 6, lane = tid & 63, n = lane & 15, g = lane >> 4;
    const bool sample = (s == 8);
    int h, lr0, nch, ntok; const unsigned char* rec; const float* Sin; float* Sout;
    if (!sample) { const int b = chain >> 3; h = chain & 7; lr0 = b * 2048; nch = 32; ntok = 64; rec = p.ws + WS_REC + (size_t)(s & 1) * SZ_REC + (size_t)chain * 32 * REC_BYTES;
        Sout = p.out + O_PS + (size_t)chain * 16384; Sin = s == 0 ? nullptr : Sout; }
    else { const int seq = chain >> 3; h = chain & 7; lr0 = seq * 16; nch = 1; ntok = 16; rec = p.ws + WS_REC + (size_t)(s & 1) * SZ_REC + (size_t)chain * REC_BYTES;
        Sin = p.in[3] + (size_t)chain * 16384; Sout = p.out + O_SS + (size_t)chain * 16384; }
    bf16_t* orow = (bf16_t*)(p.ws + WS_ORAW + (size_t)(s & 1) * SZ_G1) + (size_t)(lr0 + lane) * 1024 + h * 128 + wv * 16;
    f32x4 S[8];
#pragma unroll
    for (int dt = 0; dt < 8; ++dt) S[dt] = (f32x4){0.f, 0.f, 0.f, 0.f};
    if (Sin) {
#pragma unroll
        for (int i = 0; i < 8; ++i) *(LAS u32x4*)(lds + (i * 512 + tid) * 16) = *(const u32x4*)((const unsigned char*)Sin + (size_t)(i * 512 + tid) * 16);
        __syncthreads();
        const LAS float* sp = (const LAS float*)lds + (4 * g) * 128 + wv * 16 + n;
#pragma unroll
        for (int dt = 0; dt < 8; ++dt)
#pragma unroll
            for (int e = 0; e < 4; ++e) S[dt][e] = sp[(dt * 16 + e) * 128];
        __syncthreads();
    }
    u32x4 pre[9];
#pragma unroll
    for (int i = 0; i < 9; ++i) pre[i] = *(const u32x4*)(rec + (size_t)(i * 512 + tid) * 16);
#pragma unroll
    for (int i = 0; i < 9; ++i) *(LAS u32x4*)(lds + (i * 512 + tid) * 16) = pre[i];
    __syncthreads();
#pragma unroll 1
    for (int c = 0; c < nch; ++c) {
        const unsigned char* rc = rec + (size_t)c * REC_BYTES;
        const bool more = c + 1 < nch;
        if (more) {
#pragma unroll
            for (int i = 0; i < 9; ++i) pre[i] = *(const u32x4*)(rc + REC_BYTES + (size_t)(i * 512 + tid) * 16); }
        const float gamma = *(const float*)(rc + R_HDR);
        const LAS unsigned char* cur = lds + (c & 1) * 73728;
        bf16x8 Sop[4];
#pragma unroll
        for (int kb = 0; kb < 4; ++kb) Sop[kb] = mk8(cvt_pk_bf16(S[2 * kb][0], S[2 * kb][1]), cvt_pk_bf16(S[2 * kb][2], S[2 * kb][3]), cvt_pk_bf16(S[2 * kb + 1][0], S[2 * kb + 1][1]), cvt_pk_bf16(S[2 * kb + 1][2], S[2 * kb + 1][3]));
        f32x4 vn[4], oa[4];
#pragma unroll
        for (int mt = 0; mt < 4; ++mt) { const u32x2 uu = *(const LAS u32x2*)(cur + R_U + ((wv * 4 + mt) * 64 + lane) * 8);
            f32x4 a = {bflo(uu.x), bfhi(uu.x), bflo(uu.y), bfhi(uu.y)}; f32x4 o = {0.f, 0.f, 0.f, 0.f};
#pragma unroll
            for (int kb = 0; kb < 4; ++kb) { const bf16x8 wf = *(const LAS bf16x8*)(cur + R_W + ((mt * 4 + kb) * 64 + lane) * 16); const bf16x8 qf = *(const LAS bf16x8*)(cur + R_QD + ((mt * 4 + kb) * 64 + lane) * 16);
                a = __builtin_amdgcn_mfma_f32_16x16x32_bf16(wf, Sop[kb], a, 0, 0, 0); o = __builtin_amdgcn_mfma_f32_16x16x32_bf16(qf, Sop[kb], o, 0, 0, 0); }
            vn[mt] = a; oa[mt] = o; __builtin_amdgcn_sched_barrier(0); }
        bf16x8 Vop[2];
#pragma unroll
        for (int kb = 0; kb < 2; ++kb) Vop[kb] = mk8(cvt_pk_bf16(vn[2 * kb][0], vn[2 * kb][1]), cvt_pk_bf16(vn[2 * kb][2], vn[2 * kb][3]), cvt_pk_bf16(vn[2 * kb + 1][0], vn[2 * kb + 1][1]), cvt_pk_bf16(vn[2 * kb + 1][2], vn[2 * kb + 1][3]));
#pragma unroll
        for (int mt = 0; mt < 4; ++mt) {
#pragma unroll
            for (int kb = 0; kb < 2; ++kb) { const bf16x8 qk = *(const LAS bf16x8*)(cur + R_QK + ((mt * 2 + kb) * 64 + lane) * 16); oa[mt] = __builtin_amdgcn_mfma_f32_16x16x32_bf16(qk, Vop[kb], oa[mt], 0, 0, 0); }
            { LAS unsigned char* wreg = (LAS unsigned char*)cur + R_U + wv * 2048 + (mt * 16 + 4 * g) * 32 + n * 2;
#pragma unroll
              for (int e = 0; e < 4; ++e) *(LAS bf16_t*)(wreg + e * 32) = f2bf(oa[mt][e]); }
            __builtin_amdgcn_sched_barrier(0); }
        { const LAS unsigned char* wreg = cur + R_U + wv * 2048 + lane * 32; const u32x4 o0 = *(const LAS u32x4*)wreg, o1 = *(const LAS u32x4*)(wreg + 16);
          if (lane < ntok) { bf16_t* op = orow + (size_t)c * 64 * 1024; *(u32x4*)op = o0; *(u32x4*)(op + 8) = o1; } }
#pragma unroll
        for (int dt = 0; dt < 8; ++dt) { S[dt] *= gamma;
#pragma unroll
            for (int kb = 0; kb < 2; ++kb) { const bf16x8 kf = *(const LAS bf16x8*)(cur + R_KT + ((dt * 2 + kb) * 64 + lane) * 16); S[dt] = __builtin_amdgcn_mfma_f32_16x16x32_bf16(kf, Vop[kb], S[dt], 0, 0, 0); } if (dt & 1) __builtin_amdgcn_sched_barrier(0); }
        if (more) {
#pragma unroll
            for (int i = 0; i < 9; ++i) *(LAS u32x4*)(lds + ((c + 1) & 1) * 73728 + (i * 512 + tid) * 16) = pre[i]; }
        __syncthreads();
    }
    {
        LAS float* sp = (LAS float*)lds + (4 * g) * 128 + wv * 16 + n;
#pragma unroll
        for (int dt = 0; dt < 8; ++dt)
#pragma unroll
            for (int e = 0; e < 4; ++e) sp[(dt * 16 + e) * 128] = S[dt][e];
        __syncthreads();
#pragma unroll
        for (int i = 0; i < 8; ++i) *(u32x4*)((unsigned char*)Sout + (size_t)(i * 512 + tid) * 16) = *(const LAS u32x4*)(lds + (i * 512 + tid) * 16);
    }
}
__device__ void stage_scan(const Params& p, int s, LAS unsigned char* lds) {
    const int G = gridDim.x;
    if (s < 8) { const int j = G - 1 - (int)blockIdx.x; for (int ch = j; ch < 16; ch += G) { scan_chain(p, s, ch, lds); __syncthreads(); } }
    else { for (int ch = blockIdx.x; ch < 256; ch += G) { scan_chain(p, s, ch, lds); __syncthreads(); } }
}

__device__ void stage_merge(const Params& p, int s, int vid, int V) {
    const int tid = opaque_tid(), wid = tid >> 6, lane = tid & 63;
    const bool sample = (s == 8); const int rows = slab_rows(s);
    const bf16_t* oraw = (const bf16_t*)(p.ws + WS_ORAW + (size_t)(s & 1) * SZ_G1);
    const bf16_t* gE = (const bf16_t*)(p.ws + WS_GATE + (size_t)(s & 3) * SZ_GATE); const bf16_t* gR = gE + (size_t)4096 * 1024; const bf16_t* gP = gR + (size_t)4096 * 1024;
    bf16_t* mix = (bf16_t*)(p.ws + WS_MIX + (size_t)(s & 1) * SZ_G1);
    const float* scw = p.in[11];
    const int nitem = (rows >> 2) * 2;
    for (int it = vid * 8 + wid; it < nitem; it += V * 8) {
        const int lr0 = (it >> 1) * 4, ch = ((it & 1) * 64 + lane) * 8;
        const int hb = sample ? (lr0 >> 4) : (lr0 >> 11), tl0 = sample ? (lr0 & 15) : (lr0 & 2047), tlast = sample ? 15 : 2047;
        float w0[8], w1[8], w2[8], pm2[8], pm1[8];
#pragma unroll
        for (int k = 0; k < 8; ++k) { w0[k] = scw[ch + k]; w1[k] = scw[1024 + ch + k]; w2[k] = scw[2048 + ch + k]; }
        if (tl0 > 0) { const u32x4 u0 = *(const u32x4*)(gP + (size_t)(lr0 - 2) * 1024 + ch), u1 = *(const u32x4*)(gP + (size_t)(lr0 - 1) * 1024 + ch);
            pm2[0] = bflo(u0.x); pm2[1] = bfhi(u0.x); pm2[2] = bflo(u0.y); pm2[3] = bfhi(u0.y); pm2[4] = bflo(u0.z); pm2[5] = bfhi(u0.z); pm2[6] = bflo(u0.w); pm2[7] = bfhi(u0.w);
            pm1[0] = bflo(u1.x); pm1[1] = bfhi(u1.x); pm1[2] = bflo(u1.y); pm1[3] = bfhi(u1.y); pm1[4] = bflo(u1.z); pm1[5] = bfhi(u1.z); pm1[6] = bflo(u1.w); pm1[7] = bfhi(u1.w); }
        else { const float* hp = sample ? p.in[4] + (size_t)hb * 2 * 1024 + ch : (s == 0 ? nullptr : (const float*)(p.ws + WS_HS + (size_t)((s - 1) & 1) * SZ_HS) + (size_t)hb * 2 * 1024 + ch);
#pragma unroll
            for (int k = 0; k < 8; ++k) { pm2[k] = hp ? hp[k] : 0.f; pm1[k] = hp ? hp[1024 + k] : 0.f; } }
#pragma unroll
        for (int r = 0; r < 4; ++r) { const int lr = lr0 + r;
            const u32x4 ow = *(const u32x4*)(oraw + (size_t)lr * 1024 + ch);
            const float o[8] = {bflo(ow.x), bfhi(ow.x), bflo(ow.y), bfhi(ow.y), bflo(ow.z), bfhi(ow.z), bflo(ow.w), bfhi(ow.w)};
            float ss = 0.f;
#pragma unroll
            for (int k = 0; k < 8; ++k) ss += o[k] * o[k];
#pragma unroll
            for (int d = 1; d < 16; d <<= 1) ss += __shfl_xor(ss, d);
            const float rstd = rsqrtf(ss * (1.0f / 128.0f) + 1e-6f);
            const u32x4 ew = __builtin_nontemporal_load((const u32x4*)(gE + (size_t)lr * 1024 + ch)), rw = __builtin_nontemporal_load((const u32x4*)(gR + (size_t)lr * 1024 + ch)), pw = *(const u32x4*)(gP + (size_t)lr * 1024 + ch);
            const float E[8] = {bflo(ew.x), bfhi(ew.x), bflo(ew.y), bfhi(ew.y), bflo(ew.z), bfhi(ew.z), bflo(ew.w), bfhi(ew.w)};
            const float R[8] = {bflo(rw.x), bfhi(rw.x), bflo(rw.y), bfhi(rw.y), bflo(rw.z), bfhi(rw.z), bflo(rw.w), bfhi(rw.w)};
            const float P[8] = {bflo(pw.x), bfhi(pw.x), bflo(pw.y), bfhi(pw.y), bflo(pw.z), bfhi(pw.z), bflo(pw.w), bfhi(pw.w)};
            float m[8];
#pragma unroll
            for (int k = 0; k < 8; ++k) { const float c3 = w0[k] * pm2[k] + w1[k] * pm1[k] + w2[k] * P[k]; m[k] = o[k] * rstd * E[k] + R[k] * c3; pm2[k] = pm1[k]; pm1[k] = P[k]; }
            u32x4 w; w.x = cvt_pk_bf16(m[0], m[1]); w.y = cvt_pk_bf16(m[2], m[3]); w.z = cvt_pk_bf16(m[4], m[5]); w.w = cvt_pk_bf16(m[6], m[7]);
            *(u32x4*)(mix + (size_t)lr * 1024 + ch) = w; }
        if (tl0 + 3 == tlast) {
            float* d1 = sample ? p.out + O_SSC + (size_t)hb * 2 * 1024 + ch : (float*)(p.ws + WS_HS + (size_t)(s & 1) * SZ_HS) + (size_t)hb * 2 * 1024 + ch;
#pragma unroll
            for (int k = 0; k < 8; ++k) { d1[k] = pm2[k]; d1[1024 + k] = pm1[k]; }
            if (!sample && s == 7) { float* d2 = p.out + O_PSC + (size_t)hb * 2 * 1024 + ch;
#pragma unroll
                for (int k = 0; k < 8; ++k) { d2[k] = pm2[k]; d2[1024 + k] = pm1[k]; } } }
    }
}

__device__ void stage_ln(const Params& p, int s, int which, int vid, int V) {
    const int tid = opaque_tid(), wid = tid >> 6, lane = tid & 63; const int rows = slab_rows(s);
    const float* gam = p.in[which ? 18 : 13]; const float* bet = p.in[which ? 19 : 14];
    const float* stats = (const float*)(p.ws + WS_STATS); bf16_t* x1b = (bf16_t*)(p.ws + WS_X1B + (size_t)(s & 3) * SZ_G1);
    const bf16_t* pre1 = (const bf16_t*)(p.ws + (which ? WS_PRE2 : WS_PRE1) + (size_t)(s & 1) * SZ_G1);
    for (int lr = vid * 8 + wid; lr < rows; lr += V * 8) {
        const int grow = grow_of(s, lr); float* yp = p.out + O_YP + (size_t)grow * 1024;
        f32x4 v[4];
#pragma unroll
        for (int i = 0; i < 4; ++i) { const u32x2 q = __builtin_nontemporal_load((const u32x2*)(pre1 + (size_t)lr * 1024 + lane * 4 + 256 * i)); v[i] = (f32x4){bflo(q.x), bfhi(q.x), bflo(q.y), bfhi(q.y)}; }
        float mu, rstd;
        if (which && s >= SPLIT_FROM) {
            const bf16_t* p2 = (const bf16_t*)(p.ws + WS_PRE2B + (size_t)(s & 1) * SZ_G1) + (size_t)lr * 1024; float sm = 0.f;
#pragma unroll
            for (int i = 0; i < 4; ++i) { const u32x2 q = *(const u32x2*)(p2 + lane * 4 + 256 * i); v[i] += (f32x4){bflo(q.x), bfhi(q.x), bflo(q.y), bfhi(q.y)}; sm += (v[i][0] + v[i][1]) + (v[i][2] + v[i][3]); }
#pragma unroll
            for (int d = 32; d >= 1; d >>= 1) sm += __shfl_xor(sm, d);
            mu = sm * (1.0f / 1024.0f); float sq = 0.f;
#pragma unroll
            for (int i = 0; i < 4; ++i) { const f32x4 dv = v[i] - mu; sq += (dv[0] * dv[0] + dv[1] * dv[1]) + (dv[2] * dv[2] + dv[3] * dv[3]); }
#pragma unroll
            for (int d = 32; d >= 1; d >>= 1) sq += __shfl_xor(sq, d);
            rstd = rsqrtf(sq * (1.0f / 1024.0f) + 1e-5f);
        } else {
            const float sm = stats[(size_t)grow * 4 + which * 2], sq = stats[(size_t)grow * 4 + which * 2 + 1];
            mu = sm * (1.0f / 1024.0f); const float var = fmaxf(sq * (1.0f / 1024.0f) - mu * mu, 0.f); rstd = rsqrtf(var + 1e-5f);
        }
#pragma unroll
        for (int i = 0; i < 4; ++i) { const int c = lane * 4 + 256 * i; const f32x4 gg = *(const f32x4*)(gam + c), bb = *(const f32x4*)(bet + c);
            const f32x4 o = (v[i] - mu) * rstd * gg + bb;
            if (which) __builtin_nontemporal_store(o, (f32x4*)(yp + c)); else { u32x2 w; w.x = cvt_pk_bf16(o[0], o[1]); w.y = cvt_pk_bf16(o[2], o[3]); *(u32x2*)(x1b + (size_t)lr * 1024 + c) = w; } }
    }
}

__device__ void stage_glu(const Params& p, int s, int vid, int V) {
    const bool sample = (s == 8); const int rows = slab_rows(s);
    const bf16_t* av = (const bf16_t*)(p.ws + WS_AV + (size_t)(s & 1) * SZ_AV); bf16_t* hh = (bf16_t*)(p.ws + WS_H + (size_t)(s & 1) * SZ_H);
    const float* fw = p.in[16];
    const int total = (rows >> 3) * 352;
    const int tid = opaque_tid();
    for (int it = vid * 512 + tid; it < total; it += V * 512) {
        const int blk = it / 352, oc = it - blk * 352, ch = oc * 8, lr0 = blk * 8;
        const int hb = sample ? (lr0 >> 4) : (lr0 >> 11), tl0 = sample ? (lr0 & 15) : (lr0 & 2047), tlast = sample ? 15 : 2047;
        float w0[8], w1[8], w2[8], am2[8], am1[8];
        { const f32x4 q0 = *(const f32x4*)(fw + ch), q1 = *(const f32x4*)(fw + ch + 4), q2 = *(const f32x4*)(fw + 2816 + ch), q3 = *(const f32x4*)(fw + 2816 + ch + 4), q4 = *(const f32x4*)(fw + 5632 + ch), q5 = *(const f32x4*)(fw + 5632 + ch + 4);
#pragma unroll
          for (int k = 0; k < 4; ++k) { w0[k] = q0[k]; w0[4 + k] = q1[k]; w1[k] = q2[k]; w1[4 + k] = q3[k]; w2[k] = q4[k]; w2[4 + k] = q5[k]; } }
        if (tl0 > 0) { const u32x4 u0 = *(const u32x4*)(av + (size_t)(lr0 - 2) * 5632 + ch), u1 = *(const u32x4*)(av + (size_t)(lr0 - 1) * 5632 + ch);
            am2[0] = bflo(u0.x); am2[1] = bfhi(u0.x); am2[2] = bflo(u0.y); am2[3] = bfhi(u0.y); am2[4] = bflo(u0.z); am2[5] = bfhi(u0.z); am2[6] = bflo(u0.w); am2[7] = bfhi(u0.w);
            am1[0] = bflo(u1.x); am1[1] = bfhi(u1.x); am1[2] = bflo(u1.y); am1[3] = bfhi(u1.y); am1[4] = bflo(u1.z); am1[5] = bfhi(u1.z); am1[6] = bflo(u1.w); am1[7] = bfhi(u1.w); }
        else { const float* hp = sample ? p.in[5] + (size_t)hb * 2 * 2816 + ch : (s == 0 ? nullptr : (const float*)(p.ws + WS_HF + (size_t)((s - 1) & 1) * SZ_HF) + (size_t)hb * 2 * 2816 + ch);
#pragma unroll
            for (int k = 0; k < 8; ++k) { am2[k] = hp ? hp[k] : 0.f; am1[k] = hp ? hp[2816 + k] : 0.f; } }
#pragma unroll
        for (int r = 0; r < 8; ++r) {
            const u32x4 aw = *(const u32x4*)(av + (size_t)(lr0 + r) * 5632 + ch), vw = *(const u32x4*)(av + (size_t)(lr0 + r) * 5632 + 2816 + ch);
            const float a[8] = {bflo(aw.x), bfhi(aw.x), bflo(aw.y), bfhi(aw.y), bflo(aw.z), bfhi(aw.z), bflo(aw.w), bfhi(aw.w)};
            const float v[8] = {bflo(vw.x), bfhi(vw.x), bflo(vw.y), bfhi(vw.y), bflo(vw.z), bfhi(vw.z), bflo(vw.w), bfhi(vw.w)};
            float o[8];
#pragma unroll
            for (int k = 0; k < 8; ++k) { const float c3 = w0[k] * am2[k] + w1[k] * am1[k] + w2[k] * a[k]; o[k] = gelu_f(c3) * v[k]; am2[k] = am1[k]; am1[k] = a[k]; }
            u32x4 w; w.x = cvt_pk_bf16(o[0], o[1]); w.y = cvt_pk_bf16(o[2], o[3]); w.z = cvt_pk_bf16(o[4], o[5]); w.w = cvt_pk_bf16(o[6], o[7]);
            if (s >= SPLIT_FROM) *(u32x4*)(hh + (size_t)(ch >= 1408) * 4096 * 1408 + (size_t)(lr0 + r) * 1408 + (ch >= 1408 ? ch - 1408 : ch)) = w;
            else *(u32x4*)(hh + (size_t)(lr0 + r) * 2816 + ch) = w;
        }
        if (tl0 + 7 == tlast) {
            float* d1 = sample ? p.out + O_SFF + (size_t)hb * 2 * 2816 + ch : (float*)(p.ws + WS_HF + (size_t)(s & 1) * SZ_HF) + (size_t)hb * 2 * 2816 + ch;
#pragma unroll
            for (int k = 0; k < 8; ++k) { d1[k] = am2[k]; d1[2816 + k] = am1[k]; }
            if (!sample && s == 7) { float* d2 = p.out + O_PFF + (size_t)hb * 2 * 2816 + ch;
#pragma unroll
                for (int k = 0; k < 8; ++k) { d2[k] = am2[k]; d2[2816 + k] = am1[k]; } } }
    }
}

#define XB_TMO      128
#define XB_XCNT(j)  (256  + 64 * (j))
#define XB_XSUB(j)  (1280 + 64 * (j))
#define XB_XGEN(j)  (2304 + 64 * (j))
#define XB_TOP      3328
#define XB_TOPGEN   3392
#define XCD_BAR_WORDS 3456
#define XB_SPIN_CAP (1u << 22)
__device__ __forceinline__ unsigned xb_ld(unsigned* p)              { return __hip_atomic_load(p, __ATOMIC_RELAXED, __HIP_MEMORY_SCOPE_AGENT); }
__device__ __forceinline__ unsigned xb_add(unsigned* p, unsigned v) { return __hip_atomic_fetch_add(p, v, __ATOMIC_RELAXED, __HIP_MEMORY_SCOPE_AGENT); }
__device__ __forceinline__ unsigned xb_xcc_id() { return (unsigned)__builtin_amdgcn_s_getreg((3 << 11) | 20) & 0xFu; }
#define XB_SPIN(cond, bar) do { unsigned _sp = 0; while (cond) { __builtin_amdgcn_s_sleep(1); \
    if ((++_sp & 255u) == 0u) { if (xb_ld(&(bar)[XB_TMO])) break; if (_sp > XB_SPIN_CAP) { atomicAdd(&(bar)[XB_TMO], 1u); break; } } } } while (0)
struct XcdBarrier { unsigned* bar; unsigned x; volatile LAS unsigned* st; };
__device__ __forceinline__ XcdBarrier xcd_barrier_post(unsigned* bar, volatile LAS unsigned* st) {
    XcdBarrier b; b.bar = bar; b.x = xb_xcc_id(); b.st = st;
    if (threadIdx.x == 0) (void)xb_add(&bar[XB_XCNT(b.x)], 1u);
    return b;
}
__device__ __forceinline__ void xcd_barrier_complete(unsigned* bar, unsigned x, unsigned& nloc, unsigned& nx) {
    const unsigned G = gridDim.x * gridDim.y * gridDim.z;
    unsigned sum, cnt, mine, sp = 0u;
    for (;;) {
        sum = 0u; cnt = 0u; mine = 0u;
#pragma unroll
        for (unsigned j = 0; j < 16; ++j) { const unsigned c = xb_ld(&bar[XB_XCNT(j)]); sum += c; cnt += (c > 0u) ? 1u : 0u; mine = (j == x) ? c : mine; }
        if (sum == G) break;
        __builtin_amdgcn_s_sleep(1);
        if ((++sp & 255u) == 0u) { if (xb_ld(&bar[XB_TMO])) break; if (sp > XB_SPIN_CAP) { atomicAdd(&bar[XB_TMO], 1u); break; } }
    }
    nloc = mine > 0u ? mine : 1u; nx = cnt > 0u ? cnt : 1u;
}
__device__ __forceinline__ void xcd_barrier(const XcdBarrier& b) {
    asm volatile("s_waitcnt vmcnt(0)" ::: "memory");
    __syncthreads();
    if (threadIdx.x == 0) {
        unsigned* bar = b.bar;
        __builtin_amdgcn_s_waitcnt(0);
        unsigned nloc = b.st[0], nx = b.st[1];
        if (nloc == 0u) { xcd_barrier_complete(bar, b.x, nloc, nx); b.st[0] = nloc; b.st[1] = nx; }
        const unsigned old = xb_add(&bar[XB_XSUB(b.x)], 1u);
        const unsigned gen = old / nloc;
        if (old + 1u == (gen + 1u) * nloc) {
            __builtin_amdgcn_fence(__ATOMIC_RELEASE, "agent");
            asm volatile("s_waitcnt vmcnt(0)" ::: "memory");
            const unsigned og = xb_add(&bar[XB_TOP], 1u);
            const unsigned tg = og / nx;
            if (og + 1u == (tg + 1u) * nx) xb_add(&bar[XB_TOPGEN], 1u);
            else XB_SPIN(xb_ld(&bar[XB_TOPGEN]) == tg, bar);
            __builtin_amdgcn_fence(__ATOMIC_ACQUIRE, "agent");
            xb_add(&bar[XB_XGEN(b.x)], 1u);
            asm volatile("s_waitcnt vmcnt(0)" ::: "memory");
        } else {
            XB_SPIN(xb_ld(&bar[XB_XGEN(b.x)]) == gen, bar);
            __builtin_amdgcn_fence(__ATOMIC_ACQUIRE, "agent");
            asm volatile("s_waitcnt vmcnt(0)" ::: "memory");
        }
    }
    __syncthreads();
}

extern "C" __global__ void __launch_bounds__(512) mega(Params p) {
    extern __shared__ __attribute__((aligned(16))) unsigned char smem_raw[];
    LAS unsigned char* lds = (LAS unsigned char*)smem_raw;
    const int w = blockIdx.x, G = gridDim.x;
    volatile LAS unsigned* bst = (volatile LAS unsigned*)(lds + LDS_BYTES - 16);
    if (threadIdx.x == 0) { bst[0] = 0u; bst[1] = 0u; }
    __syncthreads();
    XcdBarrier xb; xb.bar = (unsigned*)(p.ws + WS_BAR); xb.x = 0; xb.st = bst;
    if (p.use_sync == 1) xb = xcd_barrier_post((unsigned*)(p.ws + WS_BAR), bst);
    for (int i = p.i_lo; i < p.i_hi; ++i) {
        #ifndef NO_WCONV
        if (i < 3) { stage_wconv(p, lds, i == 0 ? 0 : (i == 1 ? 2304 : 3968), i == 0 ? 2304 : (i == 1 ? 3968 : 4672)); __syncthreads(); }
#endif
        #ifndef NO_SCAN
        { const int s = i - 3; if (valid_slab(s)) { stage_scan(p, s, lds); __syncthreads(); } }
#endif
        const int sd = i - 9, s1 = i - 1, su = i - 7, so = i - 5;
        const int nd = valid_slab(sd) ? slab_panels(sd) * 4 : 0, n1 = valid_slab(s1) ? slab_panels(s1) * 36 : 0, nu = valid_slab(su) ? slab_panels(su) * 22 : 0, no = valid_slab(so) ? slab_panels(so) * 4 : 0;
        const int ns = (valid_slab(i - 3) && i - 3 < 8) ? 16 : 0;
        const int cs = (n1 + nu + no <= 3 * (G - (nd > 0 && sd >= SPLIT_FROM ? 2 * nd : nd) - ns)) ? 3 : 2;
        const bool dsplit = nd > 0 && sd >= SPLIT_FROM; const int ndw = dsplit ? 2 * nd : nd;
        if (nd) { DealDown S; S.w = w; S.G = G; S.n = ndw; S.npm = slab_panels(sd); S.split = dsplit ? 1 : 0;
            Gemm g; g.base = (const char*)p.ws; g.oA0 = (long)(WS_H + (size_t)(sd & 1) * SZ_H); g.dA1 = dsplit ? (long)4096 * 1408 * 2 : 0; g.dA2 = 0; g.oB0 = dsplit ? (long)WS_WD2 : (long)WS_WD; g.dB1 = dsplit ? (long)1024 * 1408 * 2 : 0; g.dB2 = 0; g.K = dsplit ? 1408 : 2816;
            EpiRes E; E.resp = nullptr; E.ress = nullptr; E.resb = (const bf16_t*)(p.ws + WS_X1B + (size_t)(sd & 3) * SZ_G1); E.pre = (bf16_t*)(p.ws + WS_PRE2 + (size_t)(sd & 1) * SZ_G1); E.pre2b = (bf16_t*)(p.ws + WS_PRE2B + (size_t)(sd & 1) * SZ_G1); E.y = p.out + O_YP; E.stats = (float*)(p.ws + WS_STATS); E.s = sd; E.soff = dsplit ? -1 : 2; E.mode = 1;
            pg8::gemm_phase<EpiRes, DealDown, false>(lds, g, S, E, nullptr); __syncthreads(); }
        if (n1 + nu + no) { Deal S; S.w = w; S.G = G; S.nd = ndw; S.ns = ns; S.cs = cs; S.n1 = n1; S.nu = nu; S.no = no; S.p1 = n1 ? slab_panels(s1) : 1; S.pu = nu ? slab_panels(su) : 1; S.po = no ? slab_panels(so) : 1;
            Gemm g; g.base = (const char*)p.ws; g.K = 1024;
            { const long a0 = (long)(WS_XB + (size_t)(s1 & 1) * SZ_XB), a1 = (long)(WS_X1B + (size_t)(su & 3) * SZ_G1), a2 = (long)(WS_MIX + (size_t)(so & 1) * SZ_G1);
              g.oA0 = a0; g.dA1 = a1 - a0; g.dA2 = a2 - a1; g.oB0 = (long)WS_WIN; g.dB1 = (long)WS_WUP - (long)WS_WIN; g.dB2 = (long)WS_WO - (long)WS_WUP; }
            EpiMulti E; E.e0.qkv = (bf16_t*)(p.ws + WS_QKV + (size_t)(s1 & 1) * SZ_QKV); E.e0.gate = (bf16_t*)(p.ws + WS_GATE + (size_t)(s1 & 3) * SZ_GATE); E.e0.gnorm = p.in[10];
            E.e1.av = (bf16_t*)(p.ws + WS_AV + (size_t)(su & 1) * SZ_AV);
            E.e2.resp = p.in[0]; E.e2.ress = p.in[1]; E.e2.resb = nullptr; E.e2.pre = (bf16_t*)(p.ws + WS_PRE1 + (size_t)(so & 1) * SZ_G1); E.e2.pre2b = nullptr; E.e2.y = nullptr; E.e2.stats = (float*)(p.ws + WS_STATS); E.e2.s = so; E.e2.soff = 0; E.e2.mode = 0;
            pg8::gemm_phase<EpiMulti, Deal, false>(lds, g, S, E, nullptr); __syncthreads(); }
        const int Gl = G - ns;
        int V = Gl, vid0 = w < Gl ? w : -1, vid1 = -1;
        { const int T = n1 + nu + no;
          if (ndw > 0 && T <= G - ndw - ns) {
              V = Gl - ndw; vid0 = (w >= ndw && w < Gl) ? w - ndw : -1; }
          else if (T > 0) { int rs = 0, before = 0, cap = 0;
              for (;;) { cap = G - (rs < 3 ? ndw : 0) - (rs < cs ? ns : 0); if (before + cap >= T || cap <= 0) break; before += cap; ++rs; }
              const int cl = T - before;
              const bool part = (w >= ndw || rs >= 3) && w < Gl; const int rank = w - (rs < 3 ? (w < ndw ? w : ndw) : 0);
              const int capl = cap - ((rs >= cs) ? ns : 0);
              if (cl > 0 && cl < capl) { V = Gl + (capl - cl); if (part && rank >= cl) vid1 = Gl + (rank - cl); } } }
        for (int rep_ = 0; rep_ < 2; ++rep_) { const int vid = rep_ ? vid1 : vid0; if (vid < 0) continue;
            if (valid_slab(i)) for (int r_ = 0; r_ < (p.pad & 15); ++r_) { stage_cvt(p, i, lds, vid, V); __syncthreads(); }
            if (valid_slab(i - 2)) for (int r_ = 0; r_ < ((p.pad >> 4) & 15); ++r_) { stage_prep(p, i - 2, lds, vid, V); __syncthreads(); }
            if (valid_slab(i - 4)) for (int r_ = 0; r_ < ((p.pad >> 8) & 15); ++r_) stage_merge(p, i - 4, vid, V);
            if (valid_slab(i - 6)) stage_ln(p, i - 6, 0, vid, V);
            if (valid_slab(i - 8)) for (int r_ = 0; r_ < ((p.pad >> 12) & 15); ++r_) stage_glu(p, i - 8, vid, V);
            if (valid_slab(i - 10)) stage_ln(p, i - 10, 1, vid, V);
        }
        if (i + 1 < p.i_hi) { if (p.use_sync == 1) xcd_barrier(xb); else if (p.use_sync == 2) cg::this_grid().sync(); }
    }
}

#ifndef REPS
#define REPS 0x11111
#endif
#ifndef MK_LAUNCHES
#define MK_LAUNCHES 1
#endif
extern "C" void kernel_launch(void* const* d_in, const int* in_sizes, int n_in, void* d_out, int out_size, void* d_ws, size_t ws_size, hipStream_t stream) {
    static int grid = 0;
    if (grid == 0) {
        int dev = 0, cus = 0, per_cu = 0;
        hipGetDevice(&dev); hipDeviceGetAttribute(&cus, hipDeviceAttributeMultiprocessorCount, dev);
        if (hipFuncSetAttribute((const void*)mega, hipFuncAttributeMaxDynamicSharedMemorySize, LDS_BYTES) != hipSuccess) fprintf(stderr, "hipFuncSetAttribute failed\n");
        if (hipOccupancyMaxActiveBlocksPerMultiprocessor(&per_cu, (const void*)mega, 512, LDS_BYTES) != hipSuccess || per_cu < 1) { fprintf(stderr, "occupancy query: %d\n", per_cu); per_cu = 1; }
        (void)hipGetLastError();
        grid = cus * 1;
        if (ws_size < WS_END) { fprintf(stderr, "workspace too small: %zu < %zu\n", ws_size, (size_t)WS_END); grid = -1; }
    }
    if (grid < 0) return;
    if (hipMemsetAsync((unsigned char*)d_ws + WS_BAR, 0, 16384, stream) != hipSuccess) fprintf(stderr, "memset of barrier words failed\n");
    Params p{};
    for (int i = 0; i < 20; ++i) p.in[i] = (const float*)d_in[i];
    p.out = (float*)d_out; p.ws = (unsigned char*)d_ws;
#if MK_LAUNCHES == 1
    p.i_lo = 0; p.i_hi = NINT; p.use_sync = 1; p.pad = REPS;
    void* args[] = {&p};
    hipError_t e = hipLaunchCooperativeKernel((const void*)mega, dim3(grid), dim3(512), args, LDS_BYTES, stream);
    if (e != hipSuccess) fprintf(stderr, "cooperative launch failed: %s (grid %d)\n", hipGetErrorString(e), grid);
#else
    for (int i = 0; i < NINT; ++i) { p.i_lo = i; p.i_hi = i + 1; p.use_sync = 0; p.pad = 0; hipLaunchKernelGGL(mega, dim3(grid), dim3(512), LDS_BYTES, stream, p); }
#endif
}
```

```cpp
#include <hip/hip_runtime.h>
#include <hip/hip_cooperative_groups.h>
#include <cstdio>
namespace cg = cooperative_groups;
__device__ __forceinline__ int opaque_tid() { int t; asm volatile("v_mov_b32 %0, %1" : "=v"(t) : "v"(threadIdx.x)); return t; }
namespace pg8 {
#define PG8_LAS __attribute__((address_space(3)))
typedef unsigned short bf16_t;
typedef short bf16x8 __attribute__((ext_vector_type(8)));
typedef float f32x4 __attribute__((ext_vector_type(4)));
typedef unsigned u32x4 __attribute__((ext_vector_type(4)));
constexpr int BM = 256, BK = 64, HALF = 128, HTB = HALF * BK * 2  , STAGE_BYTES = 8 * HTB, NXCD = 8, WGM = 8;
__host__ __device__ __forceinline__ int lds_byte(int r, int c) { const int st = (r >> 4) * 2 + (c >> 5), rr = r & 15, cc = c & 31, ob = rr * 64 + cc * 2; return st * 1024 + (ob ^ (((ob >> 9) & 1) << 5)); }
__host__ __device__ __forceinline__ void stage_rc(int b, int& R, int& C) { const int st = b / 1024, sb = b % 1024, swz = sb ^ (((sb >> 9) & 1) << 5); R = (st >> 1) * 16 + swz / 64; C = (st & 1) * 32 + (swz % 64) / 2; }
__host__ __device__ __forceinline__ int perm32(int rho) { const int n = rho >> 4, i = rho & 15; return 8 * (i >> 2) + 4 * n + (i & 3); }
struct Unit { int pm, pn, ty; };
struct Gemm { const char* base; long oA0, dA1, dA2, oB0, dB1, dB2; int K;
    __device__ __forceinline__ const char* selA(int ty) const { return base + oA0 + (long)(ty > 0) * dA1 + (long)(ty > 1) * dA2; }
    __device__ __forceinline__ const char* selB(int ty) const { return base + oB0 + (long)(ty > 0) * dB1 + (long)(ty > 1) * dB2; } };
typedef float f32x2c_ __attribute__((ext_vector_type(2))); typedef __bf16 bf16x2c_ __attribute__((ext_vector_type(2)));
__device__ __forceinline__ unsigned cvt_pk_bf16(float lo, float hi) { const f32x2c_ v = {lo, hi}; const bf16x2c_ b = __builtin_convertvector(v, bf16x2c_); return __builtin_bit_cast(unsigned, b); }
typedef float f32x2 __attribute__((ext_vector_type(2)));
template <class Epi, class Sched, bool STAMP = false>
__device__ __forceinline__ void gemm_phase(PG8_LAS unsigned char* lds, const Gemm g, const Sched& S, const Epi& E, unsigned long long* stamps) {
    const int tid = opaque_tid(), wid = __builtin_amdgcn_readfirstlane(tid >> 6), lane = tid & 63, wr = wid >> 2, wc = wid & 3, fr = lane & 15, fq = lane >> 4;
    const int K = g.K, nt = K / BK;
    int ts_lo = 0, ts_hi = 0, nts = 0; const unsigned long long rt_entry = STAMP ? (unsigned long long)wall_clock64() : 0ull;
#define PG8_STAMP() do { if (STAMP && wid == 0 && nts < 64) { const unsigned long long _c = (unsigned long long)clock64(); \
        ts_lo = (lane == nts) ? (int)(unsigned)_c : ts_lo; ts_hi = (lane == nts) ? (int)(unsigned)(_c >> 32) : ts_hi; ++nts; } } while (0)
    PG8_STAMP();
    unsigned voffA[2], voffB[2];
#pragma unroll
    for (int i = 0; i < 2; ++i) { int R, C; stage_rc(tid * 16 + i * 8192, R, C); const int Rb = Epi::PERM ? ((R & ~31) + perm32(R & 31)) : R;
        voffA[i] = (unsigned)(R * K + C) * 2u; voffB[i] = (unsigned)(Rb * K + C) * 2u; }
    const size_t kstep = (size_t)(BK * 2);
    const size_t hstep = (size_t)HALF * K * 2;
    const size_t tstep = 2 * hstep;
    const unsigned ldsw = (unsigned)wid * 1024u;
    const int aoff = lds_byte(wr * 64 + fr, fq * 8), boff = lds_byte(wc * 32 + fr, fq * 8);
#define PG8_SA(b, h) (((b) * 2 + (h)) * HTB)
#define PG8_SB(b, h) ((4 + (b) * 2 + (h)) * HTB)
#define PG8_STAGE(bufoff, gbase, voff) do { _Pragma("unroll") for (int _i = 0; _i < 2; ++_i) \
        __builtin_amdgcn_global_load_lds((const unsigned*)((const char*)(gbase) + (voff)[_i]), (PG8_LAS unsigned*)(lds + (bufoff) + ldsw + _i * 8192), 16, 0, 0); } while (0)
#define PG8_LDA(dst, b, h) do { _Pragma("unroll") for (int m = 0; m < 4; ++m) _Pragma("unroll") for (int k = 0; k < 2; ++k) dst[m][k] = *(const PG8_LAS bf16x8*)(lds + PG8_SA(b, h) + aoff + m * 2048 + k * 1024); } while (0)
#define PG8_LDB(dst, b, h) do { _Pragma("unroll") for (int n = 0; n < 2; ++n) _Pragma("unroll") for (int k = 0; k < 2; ++k) dst[n][k] = *(const PG8_LAS bf16x8*)(lds + PG8_SB(b, h) + boff + n * 2048 + k * 1024); } while (0)
#define PG8_MMA(ai, bj, At, Bt) do { __builtin_amdgcn_s_setprio(1); _Pragma("unroll") for (int m = 0; m < 4; ++m) _Pragma("unroll") for (int n = 0; n < 2; ++n) _Pragma("unroll") for (int k = 0; k < 2; ++k) \
        acc[ai][bj][m][n] = __builtin_amdgcn_mfma_f32_16x16x32_bf16(Bt[n][k], At[m][k], acc[ai][bj][m][n], 0, 0, 0); __builtin_amdgcn_s_setprio(0); } while (0)
#define PG8_WAIT_V(n) asm volatile("s_waitcnt vmcnt(" #n ")" ::: "memory")
#define PG8_WAIT_L(n) asm volatile("s_waitcnt lgkmcnt(" #n ")" ::: "memory")
#define PG8_BAR __builtin_amdgcn_s_barrier()
#define PG8_SCHED __builtin_amdgcn_sched_barrier(0)
    Unit cur, nxt; int ui = 0;
    if (!S.next(0, cur)) return;
    f32x4 acc[2][2][4][2];
#pragma unroll
    for (int a = 0; a < 2; ++a)
#pragma unroll
        for (int b = 0; b < 2; ++b)
#pragma unroll
            for (int m = 0; m < 4; ++m)
#pragma unroll
                for (int n = 0; n < 2; ++n) acc[a][b][m][n] = (f32x4){0.f, 0.f, 0.f, 0.f};
    bf16x8 At[4][2], B0[2][2], B1[2][2];
    const char* cA = g.selA(cur.ty) + (size_t)cur.pm * tstep; const char* cB = g.selB(cur.ty) + (size_t)cur.pn * tstep;
    S.a_ready(cur);
    PG8_STAGE(PG8_SB(0, 0), cB, voffB); PG8_STAGE(PG8_SA(0, 0), cA, voffA); PG8_STAGE(PG8_SB(0, 1), cB + hstep, voffB); PG8_STAGE(PG8_SA(0, 1), cA + hstep, voffA);
    if (wr == 1) PG8_BAR;
    PG8_WAIT_V(4); PG8_BAR;
    PG8_STAGE(PG8_SB(1, 0), cB + kstep, voffB); PG8_STAGE(PG8_SA(1, 0), cA + kstep, voffA); PG8_STAGE(PG8_SB(1, 1), cB + hstep + kstep, voffB);
    PG8_WAIT_V(6); PG8_BAR;
    PG8_STAMP();
    for (;;) {
        const bool has_next = S.next(ui + 1, nxt);
        const char* nA = has_next ? g.selA(nxt.ty) + (size_t)nxt.pm * tstep : cA; const char* nB = has_next ? g.selB(nxt.ty) + (size_t)nxt.pn * tstep : cB;
        for (int t = 0; t < nt; t += 2) {
            const bool last = (t == nt - 2);
            const char* a1 = cA + (size_t)(t + 1) * kstep;
            const char* a2 = last ? nA : cA + (size_t)(t + 2) * kstep; const char* b2 = last ? nB : cB + (size_t)(t + 2) * kstep;
            const char* a3 = a2 + kstep; const char* b3 = b2 + kstep;
            if (last && has_next) S.a_ready(nxt);
            PG8_LDB(B0, 0, 0); PG8_SCHED; PG8_LDA(At, 0, 0); PG8_STAGE(PG8_SA(1, 1), a1 + hstep, voffA);
            PG8_WAIT_L(8); PG8_BAR; PG8_WAIT_L(0); PG8_MMA(0, 0, At, B0); PG8_BAR; PG8_SCHED;
            PG8_LDB(B1, 0, 1); PG8_STAGE(PG8_SB(0, 0), b2, voffB);
            PG8_BAR; PG8_WAIT_L(0); PG8_MMA(0, 1, At, B1); PG8_BAR;
            PG8_LDA(At, 0, 1); PG8_STAGE(PG8_SA(0, 0), a2, voffA);
            PG8_BAR; PG8_WAIT_L(0); PG8_MMA(1, 0, At, B0); PG8_BAR; PG8_SCHED;
            PG8_STAGE(PG8_SB(0, 1), b2 + hstep, voffB);
            PG8_WAIT_V(6); PG8_BAR; PG8_MMA(1, 1, At, B1); PG8_BAR;
            PG8_LDB(B0, 1, 0); PG8_SCHED; PG8_LDA(At, 1, 0); PG8_STAGE(PG8_SA(0, 1), a2 + hstep, voffA);
            PG8_WAIT_L(8); PG8_BAR; PG8_WAIT_L(0); PG8_MMA(0, 0, At, B0); PG8_BAR; PG8_SCHED;
            PG8_LDB(B1, 1, 1); PG8_STAGE(PG8_SB(1, 0), b3, voffB);
            PG8_BAR; PG8_WAIT_L(0); PG8_MMA(0, 1, At, B1); PG8_BAR;
            PG8_LDA(At, 1, 1); PG8_STAGE(PG8_SA(1, 0), a3, voffA);
            PG8_BAR; PG8_WAIT_L(0); PG8_MMA(1, 0, At, B0); PG8_BAR; PG8_SCHED;
            PG8_STAGE(PG8_SB(1, 1), b3 + hstep, voffB);
            PG8_WAIT_V(6); PG8_BAR; PG8_MMA(1, 1, At, B1); PG8_BAR;
        }
        PG8_STAMP();
        if constexpr (!Epi::AFTER_DRAIN) { E(acc, cur, wr, wc, fr, fq); S.done(cur); }
        PG8_STAMP();
        if (!has_next) break;
#pragma unroll
        for (int a = 0; a < 2; ++a)
#pragma unroll
            for (int b = 0; b < 2; ++b)
#pragma unroll
                for (int m = 0; m < 4; ++m)
#pragma unroll
                    for (int n = 0; n < 2; ++n) acc[a][b][m][n] = (f32x4){0.f, 0.f, 0.f, 0.f};
        cur = nxt; cA = nA; cB = nB; ++ui;
    }
    PG8_WAIT_V(0);
    if (wr == 0) PG8_BAR;
    PG8_BAR;
    if constexpr (Epi::AFTER_DRAIN) { E.fused(acc, cur, wr, wc, fr, fq, lds, wid, lane); S.done(cur); }
    PG8_STAMP();
    if (STAMP && wid == 0) { stamps[lane] = lane < nts ? (((unsigned long long)(unsigned)ts_hi << 32) | (unsigned)ts_lo) : 0ull;
        if (lane == 62) stamps[62] = rt_entry; if (lane == 63) stamps[63] = (unsigned long long)wall_clock64(); }
#undef PG8_STAMP
#undef PG8_SA
#undef PG8_SB
#undef PG8_STAGE
#undef PG8_LDA
#undef PG8_LDB
#undef PG8_MMA
#undef PG8_WAIT_V
#undef PG8_WAIT_L
#undef PG8_BAR
#undef PG8_SCHED
}
}

using pg8::bf16_t; using pg8::bf16x8; using pg8::f32x4; using pg8::u32x4; using pg8::Unit; using pg8::Gemm; using pg8::cvt_pk_bf16;
typedef unsigned u32x2 __attribute__((ext_vector_type(2)));
#define LAS __attribute__((address_space(3)))
constexpr int NSLAB = 9, NSTAGE = 11, NINT = NSLAB + NSTAGE - 1;
constexpr int IN_DIM = 9232;
constexpr float ALPHA = 1.189207115002721f;
constexpr int LDS_BYTES = 152 * 1024;
constexpr size_t O_YP = 0, O_PGC = 34078720, O_PS = 34097152, O_PSC = 34359296, O_PFF = 34363392, O_SGC = 34374656, O_SS = 34669568, O_SSC = 38863872, O_SFF = 38929408;
constexpr int R_W = 0, R_QD = 16384, R_KT = 32768, R_QK = 49152, R_U = 57344, R_HDR = 73728, REC_BYTES = 73984;
constexpr size_t A256(size_t x) { return (x + 255) & ~(size_t)255; }
constexpr size_t WS_WIN = 0;
constexpr size_t WS_WO = WS_WIN + (size_t)9216 * 1024 * 2;
constexpr size_t WS_WUP = WS_WO + (size_t)1024 * 1024 * 2;
constexpr size_t WS_WD = WS_WUP + (size_t)5632 * 1024 * 2;
constexpr size_t WS_XB = WS_WD + (size_t)1024 * 2816 * 2;
constexpr size_t SZ_XB = (size_t)4096 * 1024 * 2;
constexpr size_t WS_AB = WS_XB + 2 * SZ_XB;
constexpr size_t WS_QKV = A256(WS_AB + (size_t)33280 * 16 * 4);
constexpr size_t SZ_QKV = (size_t)4096 * 3072 * 2;
constexpr size_t WS_GATE = WS_QKV + 2 * SZ_QKV;
constexpr size_t SZ_G1 = (size_t)4096 * 1024 * 2, SZ_GATE = 3 * SZ_G1;
constexpr size_t WS_REC = WS_GATE + 4 * SZ_GATE;
constexpr size_t SZ_REC = (size_t)512 * REC_BYTES;
constexpr size_t WS_ORAW = WS_REC + 2 * SZ_REC;
constexpr size_t WS_MIX = WS_ORAW + 2 * SZ_G1;
constexpr size_t WS_X1B = WS_MIX + 2 * SZ_G1;
constexpr size_t WS_AV = WS_X1B + 4 * SZ_G1;
constexpr size_t SZ_AV = (size_t)4096 * 5632 * 2;
constexpr size_t WS_H = WS_AV + 2 * SZ_AV;
constexpr size_t SZ_H = (size_t)4096 * 2816 * 2;
constexpr size_t WS_STATS = WS_H + 2 * SZ_H;
constexpr size_t WS_HQ = WS_STATS + (size_t)33280 * 16;
constexpr size_t SZ_HQ = (size_t)2 * 3 * 3072 * 4;
constexpr size_t WS_HS = WS_HQ + 2 * SZ_HQ;
constexpr size_t SZ_HS = (size_t)2 * 2 * 1024 * 4;
constexpr size_t WS_HF = WS_HS + 2 * SZ_HS;
constexpr size_t SZ_HF = (size_t)2 * 2 * 2816 * 4;
constexpr size_t WS_BAR = A256(WS_HF + 2 * SZ_HF);
constexpr size_t WS_PRE1 = WS_BAR + 16384;
constexpr size_t WS_PRE2 = WS_PRE1 + 2 * SZ_G1;
constexpr size_t WS_PRE2B = WS_PRE2 + 2 * SZ_G1;
constexpr size_t WS_WD2 = WS_PRE2B + 2 * SZ_G1;
constexpr size_t WS_END = WS_WD2 + (size_t)2 * 1024 * 1408 * 2;
constexpr int SPLIT_FROM = 5;

struct Params { const float* in[20]; float* out; unsigned char* ws; int i_lo, i_hi, use_sync, pad; };

__device__ __forceinline__ float bf2f(unsigned short b) { return __uint_as_float((unsigned)b << 16); }
__device__ __forceinline__ float bflo(unsigned w) { return __uint_as_float(w << 16); }
__device__ __forceinline__ float bfhi(unsigned w) { return __uint_as_float(w & 0xffff0000u); }
__device__ __forceinline__ unsigned short f2bf(float f) { return (unsigned short)(cvt_pk_bf16(f, 0.f) & 0xffffu); }
__device__ __forceinline__ float sigmoidf_(float x) { return __builtin_amdgcn_rcpf(1.0f + __expf(-x)); }
__device__ __forceinline__ float gelu_f(float v) {
    const float av = fabsf(v), t = __builtin_amdgcn_rcpf(av * 0.2316418882f + 1.0f);
    float q = t * 0.5307027145f + (-0.7265760135f); q = q * t + 0.7107068705f; q = q * t + (-0.142248368f); q = q * t + 0.127414796f; q = q * t;
    const float e = __builtin_amdgcn_exp2f(v * v * (-0.72134752044f)), m = v * (q * e);
    return v < 0.f ? m : v - m; }
typedef float f32x2_ __attribute__((ext_vector_type(2)));
__device__ __forceinline__ f32x2_ gelu_pk(f32x2_ v) {
    const f32x2_ av = __builtin_elementwise_abs(v), d = av * 0.2316418882f + 1.0f;
    f32x2_ t; t.x = __builtin_amdgcn_rcpf(d.x); t.y = __builtin_amdgcn_rcpf(d.y);
    f32x2_ q = t * 0.5307027145f + (-0.7265760135f); q = q * t + 0.7107068705f; q = q * t + (-0.142248368f); q = q * t + 0.127414796f; q = q * t;
    const f32x2_ s = (v * v) * (-0.72134752044f);
    f32x2_ e; e.x = __builtin_amdgcn_exp2f(s.x); e.y = __builtin_amdgcn_exp2f(s.y);
    const f32x2_ m = v * (q * e), r = v - m;
    f32x2_ o; o.x = v.x < 0.f ? m.x : r.x; o.y = v.y < 0.f ? m.y : r.y; return o;
}
__device__ __forceinline__ int slab_rows(int s) { return s < 8 ? 4096 : 512; }
__device__ __forceinline__ int slab_panels(int s) { return s < 8 ? 16 : 2; }
__device__ __forceinline__ int grow_of(int s, int lr) { return s < 8 ? ((lr >> 11) * 16384 + s * 2048 + (lr & 2047)) : (32768 + lr); }
__device__ __forceinline__ const float* xrow(const Params& p, int grow) { return grow < 32768 ? p.in[0] + (size_t)grow * 1024 : p.in[1] + (size_t)(grow - 32768) * 1024; }
__device__ __forceinline__ bool valid_slab(int s) { return s >= 0 && s < NSLAB; }

struct Deal {
    int w, G, nd, ns, cs, n1, nu, no, p1, pu, po;
    __device__ __forceinline__ int cand(int i) const { const int busy = w < nd ? 3 : (w >= G - ns ? cs : 0), r = busy + i;
        const int before = r * G - nd * (r < 3 ? r : 3) - ns * (r < cs ? r : cs), rank = w - (r < 3 ? (w < nd ? w : nd) : 0); return before + rank; }
    __device__ __forceinline__ static void map16(int j, int N, int& pm, int& pn) { const int x = j & 7, t = j >> 3; pm = 4 * (x & 3) + (t & 3); pn = (x >> 2) * (N >> 1) + (t >> 2); }
    __device__ __forceinline__ bool next(int i, Unit& u) const { const int q = cand(i); if (q >= n1 + nu + no) return false;
        if (q < n1) { u.ty = 0; if (p1 == 16) map16(q, 36, u.pm, u.pn); else { u.pm = q % p1; u.pn = q / p1; } }
        else if (q < n1 + nu) { const int j = q - n1; u.ty = 1; if (pu == 16) map16(j, 22, u.pm, u.pn); else { u.pm = j % pu; u.pn = j / pu; } }
        else { const int j = q - n1 - nu; u.ty = 2; if (po == 16) map16(j, 4, u.pm, u.pn); else { u.pm = j % po; u.pn = j / po; } }
        return true; }
    __device__ __forceinline__ void a_ready(const Unit&) const {}
    __device__ __forceinline__ void done(const Unit&) const {}
};
struct DealDown {
    int w, G, n, npm, split;
    __device__ __forceinline__ bool next(int i, Unit& u) const { const int j = w + i * G; if (j >= n || (n <= G && i > 0)) return false; const int t = split ? (j >> 1) : j; u.pm = t % npm; u.pn = t / npm; u.ty = split ? (j & 1) : 0; return true; }
    __device__ __forceinline__ void a_ready(const Unit&) const {}
    __device__ __forceinline__ void done(const Unit&) const {}
};

struct EpiIn {
    static constexpr bool PERM = true, AFTER_DRAIN = false;
    bf16_t* qkv; bf16_t* gate; const float* gnorm;
    __device__ __forceinline__ void operator()(const f32x4 (&acc)[2][2][4][2], const Unit& u, int wr, int wc, int fr, int fq) const {
        const int row0 = u.pm * 256 + wr * 64 + fr;
        if (u.pn < 12) {
#pragma unroll
            for (int ai = 0; ai < 2; ++ai)
#pragma unroll
                for (int m = 0; m < 4; ++m) { bf16_t* rowp = qkv + (size_t)(row0 + ai * 128 + m * 16) * 3072 + u.pn * 256 + wc * 32 + 8 * fq;
#pragma unroll
                    for (int bj = 0; bj < 2; ++bj) { const f32x4 v0 = acc[ai][bj][m][0], v1 = acc[ai][bj][m][1]; u32x4 w;
                        w.x = cvt_pk_bf16(v0[0], v0[1]); w.y = cvt_pk_bf16(v0[2], v0[3]); w.z = cvt_pk_bf16(v1[0], v1[1]); w.w = cvt_pk_bf16(v1[2], v1[3]);
                        *(u32x4*)(rowp + bj * 128) = w; } }
        } else {
            const int type = (u.pn - 12) >> 3, j = (u.pn - 12) & 7, ch = j * 128 + wc * 32 + 8 * fq;
            bf16_t* base = gate + (size_t)type * 4096 * 1024 + ch;
            float gn[8];
#pragma unroll
            for (int k = 0; k < 8; ++k) gn[k] = (type == 0) ? gnorm[(ch + k) & 127] : 1.0f;
#pragma unroll
            for (int ai = 0; ai < 2; ++ai)
#pragma unroll
                for (int m = 0; m < 4; ++m) { float o[8];
#pragma unroll
                    for (int n = 0; n < 2; ++n)
#pragma unroll
                        for (int k = 0; k < 4; k += 2) { const f32x2_ X = {acc[ai][0][m][n][k], acc[ai][0][m][n][k + 1]}, Y = {acc[ai][1][m][n][k], acc[ai][1][m][n][k + 1]}; f32x2_ r;
                            if (type == 2) r = X * Y;
                            else { f32x2_ ey; ey.x = __expf(-Y.x); ey.y = __expf(-Y.y);
                                if (type == 0) { f32x2_ ex; ex.x = __expf(-X.x); ex.y = __expf(-X.y); const f32x2_ den = (ey + 1.0f) * (ex + 1.0f); f32x2_ rc; rc.x = __builtin_amdgcn_rcpf(den.x); rc.y = __builtin_amdgcn_rcpf(den.y);
                                    r = X * rc * (f32x2_){gn[n * 4 + k], gn[n * 4 + k + 1]}; }
                                else { const f32x2_ den = ey + 1.0f; f32x2_ rc; rc.x = __builtin_amdgcn_rcpf(den.x); rc.y = __builtin_amdgcn_rcpf(den.y); r = X * rc; } }
                            o[n * 4 + k] = r.x; o[n * 4 + k + 1] = r.y; }
                    u32x4 w; w.x = cvt_pk_bf16(o[0], o[1]); w.y = cvt_pk_bf16(o[2], o[3]); w.z = cvt_pk_bf16(o[4], o[5]); w.w = cvt_pk_bf16(o[6], o[7]);
                    __builtin_nontemporal_store(w, (u32x4*)(base + (size_t)(row0 + ai * 128 + m * 16) * 1024)); }
        }
    }
};
struct EpiUp {
    static constexpr bool PERM = true, AFTER_DRAIN = false;
    bf16_t* av;
    __device__ __forceinline__ void operator()(const f32x4 (&acc)[2][2][4][2], const Unit& u, int wr, int wc, int fr, int fq) const {
        const int row0 = u.pm * 256 + wr * 64 + fr;
#pragma unroll
        for (int ai = 0; ai < 2; ++ai)
#pragma unroll
            for (int m = 0; m < 4; ++m) { bf16_t* rowp = av + (size_t)(row0 + ai * 128 + m * 16) * 5632 + u.pn * 256 + wc * 32 + 8 * fq;
#pragma unroll
                for (int bj = 0; bj < 2; ++bj) { const f32x4 v0 = acc[ai][bj][m][0], v1 = acc[ai][bj][m][1]; u32x4 w;
                    w.x = cvt_pk_bf16(v0[0], v0[1]); w.y = cvt_pk_bf16(v0[2], v0[3]); w.z = cvt_pk_bf16(v1[0], v1[1]); w.w = cvt_pk_bf16(v1[2], v1[3]);
                    *(u32x4*)(rowp + bj * 128) = w; } }
    }
};
struct EpiRes {
    static constexpr bool PERM = true, AFTER_DRAIN = false;
    const float* resp; const float* ress; const bf16_t* resb; bf16_t* pre; bf16_t* pre2b; float* y; float* stats; int s, soff, mode;
    __device__ __forceinline__ void operator()(const f32x4 (&acc)[2][2][4][2], const Unit& u, int wr, int wc, int fr, int fq) const {
        const int col0 = u.pn * 256 + wc * 32 + 8 * fq;
#pragma unroll
        for (int ai = 0; ai < 2; ++ai)
#pragma unroll
            for (int m = 0; m < 4; ++m) {
                const int lr = u.pm * 256 + ai * 128 + wr * 64 + m * 16 + fr, grow = grow_of(s, lr);
                float sm = 0.f, sq = 0.f;
                if (mode == 1 && u.ty == 1) {
                    bf16_t* op = pre2b + (size_t)lr * 1024 + col0;
#pragma unroll
                    for (int bj = 0; bj < 2; ++bj) { const f32x4 v0 = acc[ai][bj][m][0], v1 = acc[ai][bj][m][1]; u32x4 w; w.x = cvt_pk_bf16(v0[0], v0[1]); w.y = cvt_pk_bf16(v0[2], v0[3]); w.z = cvt_pk_bf16(v1[0], v1[1]); w.w = cvt_pk_bf16(v1[2], v1[3]); *(u32x4*)(op + bj * 128) = w; }
                } else if (mode == 0) {
                    const float* rp = (grow < 32768 ? resp + (size_t)grow * 1024 : ress + (size_t)(grow - 32768) * 1024) + col0; bf16_t* op = pre + (size_t)lr * 1024 + col0;
#pragma unroll
                    for (int bj = 0; bj < 2; ++bj) { const f32x4 r0 = __builtin_nontemporal_load((const f32x4*)(rp + bj * 128)), r1 = __builtin_nontemporal_load((const f32x4*)(rp + bj * 128 + 4)); const f32x4 v0 = r0 * ALPHA + acc[ai][bj][m][0], v1 = r1 * ALPHA + acc[ai][bj][m][1];
                        u32x4 w; w.x = cvt_pk_bf16(v0[0], v0[1]); w.y = cvt_pk_bf16(v0[2], v0[3]); w.z = cvt_pk_bf16(v1[0], v1[1]); w.w = cvt_pk_bf16(v1[2], v1[3]); *(u32x4*)(op + bj * 128) = w;
                        sm += (v0[0] + v0[1]) + (v0[2] + v0[3]) + (v1[0] + v1[1]) + (v1[2] + v1[3]);
                        sq += (v0[0] * v0[0] + v0[1] * v0[1]) + (v0[2] * v0[2] + v0[3] * v0[3]) + (v1[0] * v1[0] + v1[1] * v1[1]) + (v1[2] * v1[2] + v1[3] * v1[3]); }
                } else {
                    const bf16_t* rp = resb + (size_t)lr * 1024 + col0; bf16_t* op = pre + (size_t)lr * 1024 + col0;
#pragma unroll
                    for (int bj = 0; bj < 2; ++bj) { const u32x4 rw = *(const u32x4*)(rp + bj * 128);
                        const f32x4 r0 = {bflo(rw.x), bfhi(rw.x), bflo(rw.y), bfhi(rw.y)}, r1 = {bflo(rw.z), bfhi(rw.z), bflo(rw.w), bfhi(rw.w)};
                        const f32x4 v0 = r0 * ALPHA + acc[ai][bj][m][0], v1 = r1 * ALPHA + acc[ai][bj][m][1];
                        u32x4 w; w.x = cvt_pk_bf16(v0[0], v0[1]); w.y = cvt_pk_bf16(v0[2], v0[3]); w.z = cvt_pk_bf16(v1[0], v1[1]); w.w = cvt_pk_bf16(v1[2], v1[3]); *(u32x4*)(op + bj * 128) = w;
                        sm += (v0[0] + v0[1]) + (v0[2] + v0[3]) + (v1[0] + v1[1]) + (v1[2] + v1[3]);
                        sq += (v0[0] * v0[0] + v0[1] * v0[1]) + (v0[2] * v0[2] + v0[3] * v0[3]) + (v1[0] * v1[0] + v1[1] * v1[1]) + (v1[2] * v1[2] + v1[3] * v1[3]); }
                }
                sm += __shfl_xor(sm, 16); sm += __shfl_xor(sm, 32); sq += __shfl_xor(sq, 16); sq += __shfl_xor(sq, 32);
                if (fq == 0 && soff >= 0) { atomicAdd(stats + (size_t)grow * 4 + soff, sm); atomicAdd(stats + (size_t)grow * 4 + soff + 1, sq); }
            }
    }
};
struct EpiMulti {
    static constexpr bool PERM = true, AFTER_DRAIN = false;
    EpiIn e0; EpiUp e1; EpiRes e2;
    __device__ __forceinline__ void operator()(const f32x4 (&acc)[2][2][4][2], const Unit& u, int wr, int wc, int fr, int fq) const {
        if (u.ty == 0) e0(acc, u, wr, wc, fr, fq); else if (u.ty == 1) e1(acc, u, wr, wc, fr, fq); else e2(acc, u, wr, wc, fr, fq); }
};

__device__ __forceinline__ int src_col_in(int np) {
    const int pn = np >> 8; if (pn < 12) return np;
    const int within = np & 255, half = within >> 7, cl = within & 127, type = (pn - 12) >> 3, j = (pn - 12) & 7;
    const int base = type == 0 ? (half ? 7184 : 3072) : (type == 1 ? (half ? 8208 : 4112) : (half ? 6160 : 5136));
    return base + j * 128 + cl;
}
__device__ void stage_wconv(const Params& p, LAS unsigned char* lds, int t_lo, int t_hi) {
    LAS float* t = (LAS float*)lds;
    const int tid = opaque_tid();
    for (int ti = t_lo + blockIdx.x; ti < t_hi; ti += gridDim.x) {
        const float* W; bf16_t* D; int N, K, tk, tn, which;
        if (ti < 2304) { which = 0; W = p.in[6]; D = (bf16_t*)(p.ws + WS_WIN); N = IN_DIM; K = 1024; tk = ti / 144; tn = ti % 144; }
        else if (ti < 2560) { const int q = ti - 2304; which = 1; W = p.in[12]; D = (bf16_t*)(p.ws + WS_WO); N = 1024; K = 1024; tk = q / 16; tn = q % 16; }
        else if (ti < 3968) { const int q = ti - 2560; which = 2; W = p.in[15]; D = (bf16_t*)(p.ws + WS_WUP); N = 5632; K = 1024; tk = q / 88; tn = q % 88; }
        else { const int q = ti - 3968; which = 3; W = p.in[17]; D = (bf16_t*)(p.ws + WS_WD); N = 1024; K = 2816; tk = q / 16; tn = q % 16; }
        const int c = tid & 63, r8 = tid >> 6;
        const int np = tn * 64 + c, sc = which == 0 ? src_col_in(np) : np;
#pragma unroll
        for (int i = 0; i < 8; ++i) { const int r = r8 + 8 * i; t[r * 65 + c] = W[(size_t)(tk * 64 + r) * N + sc]; }
        __syncthreads();
#pragma unroll
        for (int i = 0; i < 8; ++i) { const int rr = r8 + 8 * i; D[(size_t)(tn * 64 + rr) * K + tk * 64 + c] = f2bf(t[c * 65 + rr]); }
        if (which == 3) { bf16_t* D2 = (bf16_t*)(p.ws + WS_WD2) + (size_t)(tk >= 22) * 1024 * 1408 + (size_t)(tn * 64) * 1408 + (tk >= 22 ? tk - 22 : tk) * 64 + c;
#pragma unroll
            for (int i = 0; i < 8; ++i) { const int rr = r8 + 8 * i; D2[(size_t)rr * 1408] = f2bf(t[c * 65 + rr]); } }
        __syncthreads();
    }
}

__device__ void stage_cvt(const Params& p, int s, LAS unsigned char* lds, int vid, int V) {
    LAS float* sW = (LAS float*)lds;
    const int tid = opaque_tid(), wid = tid >> 6, lane = tid & 63;
    for (int idx = tid; idx < 4096; idx += 512) { const int k = idx >> 2, q = idx & 3; const f32x4 wv4 = *(const f32x4*)(p.in[6] + (size_t)k * IN_DIM + 4096 + q * 4);
#pragma unroll
        for (int j = 0; j < 4; ++j) sW[(q * 4 + j) * 1024 + k] = wv4[j]; }
    __syncthreads();
    bf16_t* xb = (bf16_t*)(p.ws + WS_XB + (size_t)(s & 1) * SZ_XB);
    float* ab = (float*)(p.ws + WS_AB); float* stats = (float*)(p.ws + WS_STATS);
    const int rows = slab_rows(s);
    for (int lr = (vid * 8 + wid) * 2; lr < rows; lr += V * 16) {
        const int grow0 = grow_of(s, lr), grow1 = grow_of(s, lr + 1); const float* xr0 = xrow(p, grow0); const float* xr1 = xrow(p, grow1);
        f32x4 xa[4], xc[4];
#pragma unroll
        for (int i = 0; i < 4; ++i) { xa[i] = __builtin_nontemporal_load((const f32x4*)(xr0 + lane * 4 + 256 * i)); xc[i] = __builtin_nontemporal_load((const f32x4*)(xr1 + lane * 4 + 256 * i)); }
#pragma unroll
        for (int i = 0; i < 4; ++i) { u32x2 w; w.x = cvt_pk_bf16(xa[i][0], xa[i][1]); w.y = cvt_pk_bf16(xa[i][2], xa[i][3]); *(u32x2*)(xb + (size_t)lr * 1024 + lane * 4 + 256 * i) = w;
            w.x = cvt_pk_bf16(xc[i][0], xc[i][1]); w.y = cvt_pk_bf16(xc[i][2], xc[i][3]); *(u32x2*)(xb + (size_t)(lr + 1) * 1024 + lane * 4 + 256 * i) = w; }
        float a0[16], a1[16];
#pragma unroll
        for (int o = 0; o < 16; ++o) { f32x4 s0 = {0.f, 0.f, 0.f, 0.f}, s1 = {0.f, 0.f, 0.f, 0.f};
#pragma unroll
            for (int i = 0; i < 4; ++i) { const f32x4 wv = *(const LAS f32x4*)(sW + o * 1024 + lane * 4 + 256 * i); s0 += xa[i] * wv; s1 += xc[i] * wv; }
            a0[o] = (s0[0] + s0[1]) + (s0[2] + s0[3]); a1[o] = (s1[0] + s1[1]) + (s1[2] + s1[3]); if ((o & 3) == 3) __builtin_amdgcn_sched_barrier(0); }
#pragma unroll
        for (int o = 0; o < 8; ++o) { const bool hi = lane & 32; const float k0 = hi ? a0[o + 8] : a0[o], s0 = hi ? a0[o] : a0[o + 8], k1 = hi ? a1[o + 8] : a1[o], s1 = hi ? a1[o] : a1[o + 8];
            a0[o] = k0 + __shfl_xor(s0, 32); a1[o] = k1 + __shfl_xor(s1, 32); }
#pragma unroll
        for (int o = 0; o < 4; ++o) { const bool hi = lane & 16; const float k0 = hi ? a0[o + 4] : a0[o], s0 = hi ? a0[o] : a0[o + 4], k1 = hi ? a1[o + 4] : a1[o], s1 = hi ? a1[o] : a1[o + 4];
            a0[o] = k0 + __shfl_xor(s0, 16); a1[o] = k1 + __shfl_xor(s1, 16); }
#pragma unroll
        for (int o = 0; o < 2; ++o) { const bool hi = lane & 8; const float k0 = hi ? a0[o + 2] : a0[o], s0 = hi ? a0[o] : a0[o + 2], k1 = hi ? a1[o + 2] : a1[o], s1 = hi ? a1[o] : a1[o + 2];
            a0[o] = k0 + __shfl_xor(s0, 8); a1[o] = k1 + __shfl_xor(s1, 8); }
        { const bool hi = lane & 4; const float k0 = hi ? a0[1] : a0[0], s0 = hi ? a0[0] : a0[1], k1 = hi ? a1[1] : a1[0], s1 = hi ? a1[0] : a1[1];
            a0[0] = k0 + __shfl_xor(s0, 4); a1[0] = k1 + __shfl_xor(s1, 4); }
        a0[0] += __shfl_xor(a0[0], 1); a0[0] += __shfl_xor(a0[0], 2); a1[0] += __shfl_xor(a1[0], 1); a1[0] += __shfl_xor(a1[0], 2);
        if ((lane & 3) == 0) { const int o = ((lane >> 5) & 1) * 8 + ((lane >> 4) & 1) * 4 + ((lane >> 3) & 1) * 2 + ((lane >> 2) & 1); ab[(size_t)grow0 * 16 + o] = a0[0]; ab[(size_t)grow1 * 16 + o] = a1[0]; }
        if (lane < 4) { stats[(size_t)grow0 * 4 + lane] = 0.f; stats[(size_t)grow1 * 4 + lane] = 0.f; }
    }
}

constexpr int P_G = 0, P_BETA = 256, P_EG = 512, P_ET = 768, P_KB = 1024, P_QB = 18432, P_RT = 35840, P_ABF = 69632, P_ADIAG = 78336, P_TB = 82432;
constexpr int P_OW = 1024  , P_OU = 19456, P_OQD = 86016, P_OKT = 104448, P_OQK = 122880;
__device__ __forceinline__ int pslot(int chunk) { return (chunk + (chunk >> 3)) * 16; }
__device__ __forceinline__ bf16x8 mk8(unsigned a, unsigned b, unsigned c, unsigned d) { u32x4 v = {a, b, c, d}; return __builtin_bit_cast(bf16x8, v); }
__device__ void prep_unit(const Params& p, int s, int idx, LAS unsigned char* lds) {
    const int tid = opaque_tid(), wid = tid >> 6, lane = tid & 63;
    const bool sample = (s == 8);
    int h, lr0, grow0, ntok, recidx, hb  ; bool first, last;
    if (!sample) { const int b = idx >> 8, rem = idx & 255, c = rem >> 3; h = rem & 7; lr0 = b * 2048 + c * 64; grow0 = b * 16384 + s * 2048 + c * 64; ntok = 64; recidx = (b * 8 + h) * 32 + c; hb = b; first = (c == 0); last = (c == 31); }
    else { const int seq = idx >> 3; h = idx & 7; lr0 = seq * 16; grow0 = 32768 + seq * 16; ntok = 16; recidx = idx; hb = seq; first = true; last = true; }
    LAS float* sG = (LAS float*)(lds + P_G); LAS float* sBeta = (LAS float*)(lds + P_BETA); LAS float* sEG = (LAS float*)(lds + P_EG); LAS float* sET = (LAS float*)(lds + P_ET);
    unsigned char* rec = p.ws + WS_REC + (size_t)(s & 1) * SZ_REC + (size_t)recidx * REC_BYTES;
    const bf16_t* qkv = (const bf16_t*)(p.ws + WS_QKV + (size_t)(s & 1) * SZ_QKV);
    if (wid == 0) {
        const int t = lane; const bool v = t < ntok; const int gr = grow0 + (v ? t : 0);
        const float* ab = (const float*)(p.ws + WS_AB) + (size_t)gr * 16;
        const float bl = ab[h], al = ab[8 + h] + p.in[9][h];
        const float sp = al > 20.f ? al : log1pf(__expf(al));
        float g = v ? -__expf(p.in[8][h]) * sp : 0.f; const float beta = v ? sigmoidf_(bl) : 0.f;
#pragma unroll
        for (int d = 1; d < 64; d <<= 1) { const float o = __shfl_up(g, d); if (lane >= d) g += o; }
        const float gl = __shfl(g, 63);
        sG[t] = g; sBeta[t] = beta; sEG[t] = __expf(g); sET[t] = __expf(gl - g);
        if (lane == 0) *(float*)(rec + R_HDR) = __expf(gl);
    }
    __syncthreads();
    const float* cw = p.in[7];
#pragma unroll
    for (int it = 0; it < 3; ++it) {
        const int i = it * 512 + tid, o = i & 15, rest = i >> 4, tensor = rest % 3, tp = rest / 3, t0 = 2 * tp;
        const int cb = tensor * 1024 + h * 128 + o * 8;
        float x[5][8];
#pragma unroll
        for (int r = 0; r < 5; ++r) { const int t = t0 - 3 + r;
            if (t >= 0 || !first) { const u32x4 w = *(const u32x4*)(qkv + (size_t)(lr0 + t) * 3072 + cb);
                x[r][0] = bflo(w.x); x[r][1] = bfhi(w.x); x[r][2] = bflo(w.y); x[r][3] = bfhi(w.y); x[r][4] = bflo(w.z); x[r][5] = bfhi(w.z); x[r][6] = bflo(w.w); x[r][7] = bfhi(w.w); }
            else if (sample) { const float* hp = p.in[2] + ((size_t)hb * 3 + (3 + t)) * 3072 + cb;
#pragma unroll
                for (int k = 0; k < 8; ++k) x[r][k] = hp[k]; }
            else if (s == 0) {
#pragma unroll
                for (int k = 0; k < 8; ++k) x[r][k] = 0.f; }
            else { const float* hp = (const float*)(p.ws + WS_HQ + (size_t)((s - 1) & 1) * SZ_HQ) + ((size_t)hb * 3 + (3 + t)) * 3072 + cb;
#pragma unroll
                for (int k = 0; k < 8; ++k) x[r][k] = hp[k]; } }
        if (last && t0 + 1 == ntok - 1) {
#pragma unroll
            for (int r = 0; r < 3; ++r) {
                float* d1 = sample ? p.out + O_SGC + ((size_t)hb * 3 + r) * 3072 + cb : (float*)(p.ws + WS_HQ + (size_t)(s & 1) * SZ_HQ) + ((size_t)hb * 3 + r) * 3072 + cb;
#pragma unroll
                for (int k = 0; k < 8; ++k) d1[k] = x[2 + r][k];
                if (!sample && s == 7) { float* d2 = p.out + O_PGC + ((size_t)hb * 3 + r) * 3072 + cb;
#pragma unroll
                    for (int k = 0; k < 8; ++k) d2[k] = x[2 + r][k]; } } }
        f32x2_ yk[8]; f32x2_ ssv = {0.f, 0.f};
#pragma unroll
        for (int k = 0; k < 8; ++k) { const float w0 = cw[cb + k], w1 = cw[3072 + cb + k], w2 = cw[6144 + cb + k], w3 = cw[9216 + cb + k];
            f32x2_ ab = (f32x2_){x[0][k], x[1][k]} * w0 + (f32x2_){x[1][k], x[2][k]} * w1 + (f32x2_){x[2][k], x[3][k]} * w2 + (f32x2_){x[3][k], x[4][k]} * w3;
            f32x2_ ex; ex.x = __expf(-ab.x); ex.y = __expf(-ab.y); const f32x2_ den = ex + 1.0f; f32x2_ rc; rc.x = __builtin_amdgcn_rcpf(den.x); rc.y = __builtin_amdgcn_rcpf(den.y);
            ab = ab * rc; yk[k] = ab; ssv += ab * ab; }
        float ss0 = ssv.x, ss1 = ssv.y;
#pragma unroll
        for (int d = 1; d < 16; d <<= 1) { ss0 += __shfl_xor(ss0, d); ss1 += __shfl_xor(ss1, d); }
        const int t1 = t0 + 1; const bool v0 = t0 < ntok, v1 = t1 < ntok;
        f32x2_ mm;
        if (tensor == 0) { mm.x = rsqrtf(ss0 + 1e-6f) * 0.08838834764831845f; mm.y = rsqrtf(ss1 + 1e-6f) * 0.08838834764831845f; }
        else if (tensor == 1) { mm.x = rsqrtf(ss0 + 1e-6f); mm.y = rsqrtf(ss1 + 1e-6f); }
        else { mm.x = 1.f; mm.y = 1.f; }
        float y0[8], y1[8];
#pragma unroll
        for (int k = 0; k < 8; ++k) { f32x2_ q = yk[k] * mm; q.x = v0 ? q.x : 0.f; q.y = v1 ? q.y : 0.f; yk[k] = q; y0[k] = q.x; y1[k] = q.y; }
        const float b0 = sBeta[t0], b1 = sBeta[t1], eg0 = sEG[t0], eg1 = sEG[t1], et0 = sET[t0], et1 = sET[t1];
        const f32x2_ egv = {eg0, eg1}, etv = {et0, et1}, bv = {b0, b1}, begv = bv * egv;
        if (tensor == 0) {
            u32x4 w; w.x = cvt_pk_bf16(y0[0], y0[1]); w.y = cvt_pk_bf16(y0[2], y0[3]); w.z = cvt_pk_bf16(y0[4], y0[5]); w.w = cvt_pk_bf16(y0[6], y0[7]);
            *(LAS u32x4*)(lds + P_QB + t0 * 272 + o * 16) = w;
            w.x = cvt_pk_bf16(y1[0], y1[1]); w.y = cvt_pk_bf16(y1[2], y1[3]); w.z = cvt_pk_bf16(y1[4], y1[5]); w.w = cvt_pk_bf16(y1[6], y1[7]);
            *(LAS u32x4*)(lds + P_QB + t1 * 272 + o * 16) = w;
            const int kb = o >> 2, oo = o & 3, half = oo >> 1, g0 = (oo & 1) * 2;
#pragma unroll
            for (int tt = 0; tt < 2; ++tt) { const int t = t0 + tt; const float e = tt ? eg1 : eg0; const float* yy = tt ? y1 : y0; const int mt = t >> 4, m = t & 15;
                const int ck = (mt * 4 + kb) * 64 + g0 * 16 + m;
                u32x2 a; a.x = cvt_pk_bf16(yy[0] * e, yy[1] * e); a.y = cvt_pk_bf16(yy[2] * e, yy[3] * e); *(LAS u32x2*)(lds + P_OQD + pslot(ck) + half * 8) = a;
                a.x = cvt_pk_bf16(yy[4] * e, yy[5] * e); a.y = cvt_pk_bf16(yy[6] * e, yy[7] * e); *(LAS u32x2*)(lds + P_OQD + pslot(ck + 16) + half * 8) = a; }
        } else if (tensor == 1) {
            u32x4 w; w.x = cvt_pk_bf16(y0[0], y0[1]); w.y = cvt_pk_bf16(y0[2], y0[3]); w.z = cvt_pk_bf16(y0[4], y0[5]); w.w = cvt_pk_bf16(y0[6], y0[7]);
            *(LAS u32x4*)(lds + P_KB + t0 * 272 + o * 16) = w;
            w.x = cvt_pk_bf16(y1[0], y1[1]); w.y = cvt_pk_bf16(y1[2], y1[3]); w.z = cvt_pk_bf16(y1[4], y1[5]); w.w = cvt_pk_bf16(y1[6], y1[7]);
            *(LAS u32x4*)(lds + P_KB + t1 * 272 + o * 16) = w;
            const int dt = o >> 1, kb = t0 >> 5, r = t0 & 31, half = r >> 4, rr = r & 15, gp = rr >> 2, ep = half * 4 + (rr & 3);
#pragma unroll
            for (int k = 0; k < 8; ++k) { const int m = (o & 1) * 8 + k;
                const f32x2_ r1 = yk[k] * begv, r2 = yk[k] * etv;
                *(LAS unsigned*)(lds + P_RT + (128 + o * 8 + k) * 132 + t0 * 2) = cvt_pk_bf16(r1.x, r1.y);
                *(LAS unsigned*)(lds + P_OKT + pslot((dt * 2 + kb) * 64 + gp * 16 + m) + ep * 2) = cvt_pk_bf16(r2.x, r2.y); }
        } else {
#pragma unroll
            for (int k = 0; k < 8; ++k) { const f32x2_ r1 = yk[k] * bv; *(LAS unsigned*)(lds + P_RT + (o * 8 + k) * 132 + t0 * 2) = cvt_pk_bf16(r1.x, r1.y); }
        }
    }
    __syncthreads();
    const int n = lane & 15, g = lane >> 4;
    {
        const int itile = wid >> 1;
        bf16x8 ak[4], aq[4];
#pragma unroll
        for (int kb = 0; kb < 4; ++kb) { ak[kb] = *(const LAS bf16x8*)(lds + P_KB + (itile * 16 + n) * 272 + kb * 64 + g * 16); aq[kb] = *(const LAS bf16x8*)(lds + P_QB + (itile * 16 + n) * 272 + kb * 64 + g * 16); }
#pragma unroll
        for (int jj = 0; jj < 2; ++jj) { const int jt = (wid & 1) * 2 + jj;
            f32x4 ckk = {0.f, 0.f, 0.f, 0.f}, cqk = {0.f, 0.f, 0.f, 0.f};
#pragma unroll
            for (int kb = 0; kb < 4; ++kb) { const bf16x8 bk = *(const LAS bf16x8*)(lds + P_KB + (jt * 16 + n) * 272 + kb * 64 + g * 16);
                ckk = __builtin_amdgcn_mfma_f32_16x16x32_bf16(ak[kb], bk, ckk, 0, 0, 0); cqk = __builtin_amdgcn_mfma_f32_16x16x32_bf16(aq[kb], bk, cqk, 0, 0, 0); }
            const int j = jt * 16 + n; const float Gj = sG[j];
#pragma unroll
            for (int e = 0; e < 4; ++e) { const int i = itile * 16 + 4 * g + e; const float dd = fminf(sG[i] - Gj, 0.f), ex = __expf(dd);
                const float av = (j < i) ? sBeta[i] * ckk[e] * ex : 0.f, qv = (j <= i) ? cqk[e] * ex : 0.f;
                *(LAS bf16_t*)(lds + P_ABF + i * 136 + j * 2) = f2bf(-av);
                if (itile == jt) *(LAS float*)(lds + P_ADIAG + ((itile * 16 + 4 * g + e) * 16 + n) * 4) = av;
                const int kb2 = jt >> 1, half = jt & 1, gp = n >> 2, ep = half * 4 + (n & 3), m = 4 * g + e;
                *(LAS bf16_t*)(lds + P_OQK + pslot((itile * 2 + kb2) * 64 + gp * 16 + m) + ep * 2) = f2bf(qv); }
        }
    }
    __syncthreads();
    if (wid == 0) {
        const int blk = lane >> 4, c = lane & 15; const LAS float* A = (const LAS float*)(lds + P_ADIAG) + blk * 256;
        float T[16];
#pragma unroll
        for (int r = 0; r < 16; ++r) { float a = (r == c) ? 1.f : 0.f;
#pragma unroll
            for (int jx = 0; jx < r; ++jx) a -= A[r * 16 + jx] * T[jx];
            T[r] = a; }
#pragma unroll
        for (int r = 0; r < 16; ++r) *(LAS bf16_t*)(lds + P_TB + (blk * 16 + r) * 40 + c * 2) = f2bf(T[r]);
    }
    __syncthreads();
    {
        bf16x8 Xop[2][2];
#pragma unroll
        for (int a = 0; a < 2; ++a)
#pragma unroll
            for (int b = 0; b < 2; ++b) Xop[a][b] = mk8(0u, 0u, 0u, 0u);
        unsigned xw[2][2][4];
#pragma unroll
        for (int a = 0; a < 2; ++a)
#pragma unroll
            for (int b = 0; b < 2; ++b)
#pragma unroll
                for (int c = 0; c < 4; ++c) xw[a][b][c] = 0u;
#pragma unroll
        for (int blk = 0; blk < 4; ++blk) {
            f32x4 acc[2];
#pragma unroll
            for (int ct = 0; ct < 2; ++ct) { const int f = 32 * wid + 16 * ct + n; const LAS unsigned* rp = (const LAS unsigned*)(lds + P_RT + f * 132 + 32 * blk + 8 * g);
                const unsigned r0 = rp[0], r1 = rp[1]; acc[ct] = (f32x4){bflo(r0), bfhi(r0), bflo(r1), bfhi(r1)}; }
            if (blk >= 1) { const LAS unsigned char* ap = lds + P_ABF + (blk * 16 + n) * 136 + 8 * g; const u32x2 a0 = *(const LAS u32x2*)ap, a1 = *(const LAS u32x2*)(ap + 32);
                const bf16x8 A = mk8(a0.x, a0.y, a1.x, a1.y);
#pragma unroll
                for (int ct = 0; ct < 2; ++ct) acc[ct] = __builtin_amdgcn_mfma_f32_16x16x32_bf16(A, mk8(xw[0][ct][0], xw[0][ct][1], xw[0][ct][2], xw[0][ct][3]), acc[ct], 0, 0, 0); }
            if (blk == 3) { const LAS unsigned char* ap = lds + P_ABF + (blk * 16 + n) * 136 + 64 + 8 * g; const u32x2 a0 = *(const LAS u32x2*)ap, a1 = *(const LAS u32x2*)(ap + 32);
                const bf16x8 A = mk8(a0.x, a0.y, a1.x, a1.y);
#pragma unroll
                for (int ct = 0; ct < 2; ++ct) acc[ct] = __builtin_amdgcn_mfma_f32_16x16x32_bf16(A, mk8(xw[1][ct][0], xw[1][ct][1], xw[1][ct][2], xw[1][ct][3]), acc[ct], 0, 0, 0); }
            const u32x2 tv = *(const LAS u32x2*)(lds + P_TB + (blk * 16 + n) * 40 + 8 * g);
            const bf16x8 Top = mk8(tv.x, tv.y, 0u, 0u);
#pragma unroll
            for (int ct = 0; ct < 2; ++ct) {
                const bf16x8 Yop = mk8(cvt_pk_bf16(acc[ct][0], acc[ct][1]), cvt_pk_bf16(acc[ct][2], acc[ct][3]), 0u, 0u);
                f32x4 x = {0.f, 0.f, 0.f, 0.f}; x = __builtin_amdgcn_mfma_f32_16x16x32_bf16(Top, Yop, x, 0, 0, 0);
                const unsigned p0 = cvt_pk_bf16(x[0], x[1]), p1 = cvt_pk_bf16(x[2], x[3]);
                xw[blk >> 1][ct][(blk & 1) * 2] = p0; xw[blk >> 1][ct][(blk & 1) * 2 + 1] = p1;
                if (wid < 4) { const int wv = 2 * wid + ct; u32x2 st; st.x = p0; st.y = p1; *(LAS u32x2*)(lds + P_OU + ((wv * 4 + blk) * 64 + lane) * 8) = st; }
                else { const int kbp = wid - 4, gp = n >> 2, ep = ct * 4 + (n & 3);
#pragma unroll
                    for (int e = 0; e < 4; ++e) { const int mp = 4 * g + e; *(LAS bf16_t*)(lds + P_OW + pslot((blk * 4 + kbp) * 64 + gp * 16 + mp) + ep * 2) = f2bf(-x[e]); } }
            }
        }
        (void)Xop;
    }
    __syncthreads();
#pragma unroll
    for (int i = 0; i < 9; ++i) { const int c = i * 512 + tid;
        int off; if (i < 2) off = P_OW + pslot(c); else if (i < 4) off = P_OQD + pslot(c - 1024); else if (i < 6) off = P_OKT + pslot(c - 2048); else if (i < 7) off = P_OQK + pslot(c - 3072); else off = P_OU + (c - 3584) * 16;
        *(u32x4*)(rec + (size_t)c * 16) = *(const LAS u32x4*)(lds + off); }
    __syncthreads();
}
__device__ void stage_prep(const Params& p, int s, LAS unsigned char* lds, int vid, int V) {
    const int nu = s < 8 ? 512 : 256;
    for (int idx = vid; idx < nu; idx += V) prep_unit(p, s, idx, lds);
}

__device__ void scan_chain(const Params& p, int s, int chain, LAS unsigned char* lds) {
    const int tid = opaque_tid(), wv = tid >> 6, lane = tid & 63, n = lane & 15, g = lane >> 4;
    const bool sample = (s == 8);
    int h, lr0, nch, ntok; const unsigned char* rec; const float* Sin; float* Sout;
    if (!sample) { const int b = chain >> 3; h = chain & 7; lr0 = b * 2048; nch = 32; ntok = 64; rec = p.ws + WS_REC + (size_t)(s & 1) * SZ_REC + (size_t)chain * 32 * REC_BYTES;
        Sout = p.out + O_PS + (size_t)chain * 16384; Sin = s == 0 ? nullptr : Sout; }
    else { const int seq = chain >> 3; h = chain & 7; lr0 = seq * 16; nch = 1; ntok = 16; rec = p.ws + WS_REC + (size_t)(s & 1) * SZ_REC + (size_t)chain * REC_BYTES;
        Sin = p.in[3] + (size_t)chain * 16384; Sout = p.out + O_SS + (size_t)chain * 16384; }
    bf16_t* orow = (bf16_t*)(p.ws + WS_ORAW + (size_t)(s & 1) * SZ_G1) + (size_t)(lr0 + lane) * 1024 + h * 128 + wv * 16;
    f32x4 S[8];
#pragma unroll
    for (int dt = 0; dt < 8; ++dt) S[dt] = (f32x4){0.f, 0.f, 0.f, 0.f};
    if (Sin) {
#pragma unroll
        for (int i = 0; i < 8; ++i) *(LAS u32x4*)(lds + (i * 512 + tid) * 16) = *(const u32x4*)((const unsigned char*)Sin + (size_t)(i * 512 + tid) * 16);
        __syncthreads();
        const LAS float* sp = (const LAS float*)lds + (4 * g) * 128 + wv * 16 + n;
#pragma unroll
        for (int dt = 0; dt < 8; ++dt)
#pragma unroll
            for (int e = 0; e < 4; ++e) S[dt][e] = sp[(dt * 16 + e) * 128];
        __syncthreads();
    }
    u32x4 pre[9];
#pragma unroll
    for (int i = 0; i < 9; ++i) pre[i] = *(const u32x4*)(rec + (size_t)(i * 512 + tid) * 16);
#pragma unroll
    for (int i = 0; i < 9; ++i) *(LAS u32x4*)(lds + (i * 512 + tid) * 16) = pre[i];
    __syncthreads();
#pragma unroll 1
    for (int c = 0; c < nch; ++c) {
        const unsigned char* rc = rec + (size_t)c * REC_BYTES;
        const bool more = c + 1 < nch;
        if (more) {
#pragma unroll
            for (int i = 0; i < 9; ++i) pre[i] = *(const u32x4*)(rc + REC_BYTES + (size_t)(i * 512 + tid) * 16); }
        const float gamma = *(const float*)(rc + R_HDR);
        const LAS unsigned char* cur = lds + (c & 1) * 73728;
        bf16x8 Sop[4];
#pragma unroll
        for (int kb = 0; kb < 4; ++kb) Sop[kb] = mk8(cvt_pk_bf16(S[2 * kb][0], S[2 * kb][1]), cvt_pk_bf16(S[2 * kb][2], S[2 * kb][3]), cvt_pk_bf16(S[2 * kb + 1][0], S[2 * kb + 1][1]), cvt_pk_bf16(S[2 * kb + 1][2], S[2 * kb + 1][3]));
        f32x4 vn[4], oa[4];
#pragma unroll
        for (int mt = 0; mt < 4; ++mt) { const u32x2 uu = *(const LAS u32x2*)(cur + R_U + ((wv * 4 + mt) * 64 + lane) * 8);
            f32x4 a = {bflo(uu.x), bfhi(uu.x), bflo(uu.y), bfhi(uu.y)}; f32x4 o = {0.f, 0.f, 0.f, 0.f};
#pragma unroll
            for (int kb = 0; kb < 4; ++kb) { const bf16x8 wf = *(const LAS bf16x8*)(cur + R_W + ((mt * 4 + kb) * 64 + lane) * 16); const bf16x8 qf = *(const LAS bf16x8*)(cur + R_QD + ((mt * 4 + kb) * 64 + lane) * 16);
                a = __builtin_amdgcn_mfma_f32_16x16x32_bf16(wf, Sop[kb], a, 0, 0, 0); o = __builtin_amdgcn_mfma_f32_16x16x32_bf16(qf, Sop[kb], o, 0, 0, 0); }
            vn[mt] = a; oa[mt] = o; __builtin_amdgcn_sched_barrier(0); }
        bf16x8 Vop[2];
#pragma unroll
        for (int kb = 0; kb < 2; ++kb) Vop[kb] = mk8(cvt_pk_bf16(vn[2 * kb][0], vn[2 * kb][1]), cvt_pk_bf16(vn[2 * kb][2], vn[2 * kb][3]), cvt_pk_bf16(vn[2 * kb + 1][0], vn[2 * kb + 1][1]), cvt_pk_bf16(vn[2 * kb + 1][2], vn[2 * kb + 1][3]));
#pragma unroll
        for (int mt = 0; mt < 4; ++mt) {
#pragma unroll
            for (int kb = 0; kb < 2; ++kb) { const bf16x8 qk = *(const LAS bf16x8*)(cur + R_QK + ((mt * 2 + kb) * 64 + lane) * 16); oa[mt] = __builtin_amdgcn_mfma_f32_16x16x32_bf16(qk, Vop[kb], oa[mt], 0, 0, 0); }
            { LAS unsigned char* wreg = (LAS unsigned char*)cur + R_U + wv * 2048 + (mt * 16 + 4 * g) * 32 + n * 2;
#pragma unroll
              for (int e = 0; e < 4; ++e) *(LAS bf16_t*)(wreg + e * 32) = f2bf(oa[mt][e]); }
            __builtin_amdgcn_sched_barrier(0); }
        { const LAS unsigned char* wreg = cur + R_U + wv * 2048 + lane * 32; const u32x4 o0 = *(const LAS u32x4*)wreg, o1 = *(const LAS u32x4*)(wreg + 16);
          if (lane < ntok) { bf16_t* op = orow + (size_t)c * 64 * 1024; *(u32x4*)op = o0; *(u32x4*)(op + 8) = o1; } }
#pragma unroll
        for (int dt = 0; dt < 8; ++dt) { S[dt] *= gamma;
#pragma unroll
            for (int kb = 0; kb < 2; ++kb) { const bf16x8 kf = *(const LAS bf16x8*)(cur + R_KT + ((dt * 2 + kb) * 64 + lane) * 16); S[dt] = __builtin_amdgcn_mfma_f32_16x16x32_bf16(kf, Vop[kb], S[dt], 0, 0, 0); } if (dt & 1) __builtin_amdgcn_sched_barrier(0); }
        if (more) {
#pragma unroll
            for (int i = 0; i < 9; ++i) *(LAS u32x4*)(lds + ((c + 1) & 1) * 73728 + (i * 512 + tid) * 16) = pre[i]; }
        __syncthreads();
    }
    {
        LAS float* sp = (LAS float*)lds + (4 * g) * 128 + wv * 16 + n;
#pragma unroll
        for (int dt = 0; dt < 8; ++dt)
#pragma unroll
            for (int e = 0; e < 4; ++e) sp[(dt * 16 + e) * 128] = S[dt][e];
        __syncthreads();
#pragma unroll
        for (int i = 0; i < 8; ++i) *(u32x4*)((unsigned char*)Sout + (size_t)(i * 512 + tid) * 16) = *(const LAS u32x4*)(lds + (i * 512 + tid) * 16);
    }
}
__device__ void stage_scan(const Params& p, int s, LAS unsigned char* lds) {
    const int G = gridDim.x;
    if (s < 8) { const int j = G - 1 - (int)blockIdx.x; for (int ch = j; ch < 16; ch += G) { scan_chain(p, s, ch, lds); __syncthreads(); } }
    else { for (int ch = blockIdx.x; ch < 256; ch += G) { scan_chain(p, s, ch, lds); __syncthreads(); } }
}

__device__ void stage_merge(const Params& p, int s, int vid, int V) {
    const int tid = opaque_tid(), wid = tid >> 6, lane = tid & 63;
    const bool sample = (s == 8); const int rows = slab_rows(s);
    const bf16_t* oraw = (const bf16_t*)(p.ws + WS_ORAW + (size_t)(s & 1) * SZ_G1);
    const bf16_t* gE = (const bf16_t*)(p.ws + WS_GATE + (size_t)(s & 3) * SZ_GATE); const bf16_t* gR = gE + (size_t)4096 * 1024; const bf16_t* gP = gR + (size_t)4096 * 1024;
    bf16_t* mix = (bf16_t*)(p.ws + WS_MIX + (size_t)(s & 1) * SZ_G1);
    const float* scw = p.in[11];
    const int nitem = (rows >> 2) * 2;
    for (int it = vid * 8 + wid; it < nitem; it += V * 8) {
        const int lr0 = (it >> 1) * 4, ch = ((it & 1) * 64 + lane) * 8;
        const int hb = sample ? (lr0 >> 4) : (lr0 >> 11), tl0 = sample ? (lr0 & 15) : (lr0 & 2047), tlast = sample ? 15 : 2047;
        float w0[8], w1[8], w2[8], pm2[8], pm1[8];
#pragma unroll
        for (int k = 0; k < 8; ++k) { w0[k] = scw[ch + k]; w1[k] = scw[1024 + ch + k]; w2[k] = scw[2048 + ch + k]; }
        if (tl0 > 0) { const u32x4 u0 = *(const u32x4*)(gP + (size_t)(lr0 - 2) * 1024 + ch), u1 = *(const u32x4*)(gP + (size_t)(lr0 - 1) * 1024 + ch);
            pm2[0] = bflo(u0.x); pm2[1] = bfhi(u0.x); pm2[2] = bflo(u0.y); pm2[3] = bfhi(u0.y); pm2[4] = bflo(u0.z); pm2[5] = bfhi(u0.z); pm2[6] = bflo(u0.w); pm2[7] = bfhi(u0.w);
            pm1[0] = bflo(u1.x); pm1[1] = bfhi(u1.x); pm1[2] = bflo(u1.y); pm1[3] = bfhi(u1.y); pm1[4] = bflo(u1.z); pm1[5] = bfhi(u1.z); pm1[6] = bflo(u1.w); pm1[7] = bfhi(u1.w); }
        else { const float* hp = sample ? p.in[4] + (size_t)hb * 2 * 1024 + ch : (s == 0 ? nullptr : (const float*)(p.ws + WS_HS + (size_t)((s - 1) & 1) * SZ_HS) + (size_t)hb * 2 * 1024 + ch);
#pragma unroll
            for (int k = 0; k < 8; ++k) { pm2[k] = hp ? hp[k] : 0.f; pm1[k] = hp ? hp[1024 + k] : 0.f; } }
#pragma unroll
        for (int r = 0; r < 4; ++r) { const int lr = lr0 + r;
            const u32x4 ow = *(const u32x4*)(oraw + (size_t)lr * 1024 + ch);
            const float o[8] = {bflo(ow.x), bfhi(ow.x), bflo(ow.y), bfhi(ow.y), bflo(ow.z), bfhi(ow.z), bflo(ow.w), bfhi(ow.w)};
            float ss = 0.f;
#pragma unroll
            for (int k = 0; k < 8; ++k) ss += o[k] * o[k];
#pragma unroll
            for (int d = 1; d < 16; d <<= 1) ss += __shfl_xor(ss, d);
            const float rstd = rsqrtf(ss * (1.0f / 128.0f) + 1e-6f);
            const u32x4 ew = __builtin_nontemporal_load((const u32x4*)(gE + (size_t)lr * 1024 + ch)), rw = __builtin_nontemporal_load((const u32x4*)(gR + (size_t)lr * 1024 + ch)), pw = *(const u32x4*)(gP + (size_t)lr * 1024 + ch);
            const float E[8] = {bflo(ew.x), bfhi(ew.x), bflo(ew.y), bfhi(ew.y), bflo(ew.z), bfhi(ew.z), bflo(ew.w), bfhi(ew.w)};
            const float R[8] = {bflo(rw.x), bfhi(rw.x), bflo(rw.y), bfhi(rw.y), bflo(rw.z), bfhi(rw.z), bflo(rw.w), bfhi(rw.w)};
            const float P[8] = {bflo(pw.x), bfhi(pw.x), bflo(pw.y), bfhi(pw.y), bflo(pw.z), bfhi(pw.z), bflo(pw.w), bfhi(pw.w)};
            float m[8];
#pragma unroll
            for (int k = 0; k < 8; k += 2) { const f32x2_ c3 = (f32x2_){w0[k], w0[k + 1]} * (f32x2_){pm2[k], pm2[k + 1]} + (f32x2_){w1[k], w1[k + 1]} * (f32x2_){pm1[k], pm1[k + 1]} + (f32x2_){w2[k], w2[k + 1]} * (f32x2_){P[k], P[k + 1]};
                const f32x2_ mm = (f32x2_){o[k], o[k + 1]} * rstd * (f32x2_){E[k], E[k + 1]} + (f32x2_){R[k], R[k + 1]} * c3; m[k] = mm.x; m[k + 1] = mm.y; pm2[k] = pm1[k]; pm2[k + 1] = pm1[k + 1]; pm1[k] = P[k]; pm1[k + 1] = P[k + 1]; }
            u32x4 w; w.x = cvt_pk_bf16(m[0], m[1]); w.y = cvt_pk_bf16(m[2], m[3]); w.z = cvt_pk_bf16(m[4], m[5]); w.w = cvt_pk_bf16(m[6], m[7]);
            *(u32x4*)(mix + (size_t)lr * 1024 + ch) = w; }
        if (tl0 + 3 == tlast) {
            float* d1 = sample ? p.out + O_SSC + (size_t)hb * 2 * 1024 + ch : (float*)(p.ws + WS_HS + (size_t)(s & 1) * SZ_HS) + (size_t)hb * 2 * 1024 + ch;
#pragma unroll
            for (int k = 0; k < 8; ++k) { d1[k] = pm2[k]; d1[1024 + k] = pm1[k]; }
            if (!sample && s == 7) { float* d2 = p.out + O_PSC + (size_t)hb * 2 * 1024 + ch;
#pragma unroll
                for (int k = 0; k < 8; ++k) { d2[k] = pm2[k]; d2[1024 + k] = pm1[k]; } } }
    }
}

__device__ void stage_ln(const Params& p, int s, int which, int vid, int V) {
    const int tid = opaque_tid(), wid = tid >> 6, lane = tid & 63; const int rows = slab_rows(s);
    const float* gam = p.in[which ? 18 : 13]; const float* bet = p.in[which ? 19 : 14];
    const float* stats = (const float*)(p.ws + WS_STATS); bf16_t* x1b = (bf16_t*)(p.ws + WS_X1B + (size_t)(s & 3) * SZ_G1);
    const bf16_t* pre1 = (const bf16_t*)(p.ws + (which ? WS_PRE2 : WS_PRE1) + (size_t)(s & 1) * SZ_G1);
    for (int lr = vid * 8 + wid; lr < rows; lr += V * 8) {
        const int grow = grow_of(s, lr); float* yp = p.out + O_YP + (size_t)grow * 1024;
        f32x4 v[4];
#pragma unroll
        for (int i = 0; i < 4; ++i) { const u32x2 q = __builtin_nontemporal_load((const u32x2*)(pre1 + (size_t)lr * 1024 + lane * 4 + 256 * i)); v[i] = (f32x4){bflo(q.x), bfhi(q.x), bflo(q.y), bfhi(q.y)}; }
        float mu, rstd;
        if (which && s >= SPLIT_FROM) {
            const bf16_t* p2 = (const bf16_t*)(p.ws + WS_PRE2B + (size_t)(s & 1) * SZ_G1) + (size_t)lr * 1024; float sm = 0.f;
#pragma unroll
            for (int i = 0; i < 4; ++i) { const u32x2 q = *(const u32x2*)(p2 + lane * 4 + 256 * i); v[i] += (f32x4){bflo(q.x), bfhi(q.x), bflo(q.y), bfhi(q.y)}; sm += (v[i][0] + v[i][1]) + (v[i][2] + v[i][3]); }
#pragma unroll
            for (int d = 32; d >= 1; d >>= 1) sm += __shfl_xor(sm, d);
            mu = sm * (1.0f / 1024.0f); float sq = 0.f;
#pragma unroll
            for (int i = 0; i < 4; ++i) { const f32x4 dv = v[i] - mu; sq += (dv[0] * dv[0] + dv[1] * dv[1]) + (dv[2] * dv[2] + dv[3] * dv[3]); }
#pragma unroll
            for (int d = 32; d >= 1; d >>= 1) sq += __shfl_xor(sq, d);
            rstd = rsqrtf(sq * (1.0f / 1024.0f) + 1e-5f);
        } else {
            const float sm = stats[(size_t)grow * 4 + which * 2], sq = stats[(size_t)grow * 4 + which * 2 + 1];
            mu = sm * (1.0f / 1024.0f); const float var = fmaxf(sq * (1.0f / 1024.0f) - mu * mu, 0.f); rstd = rsqrtf(var + 1e-5f);
        }
#pragma unroll
        for (int i = 0; i < 4; ++i) { const int c = lane * 4 + 256 * i; const f32x4 gg = *(const f32x4*)(gam + c), bb = *(const f32x4*)(bet + c);
            const f32x4 o = (v[i] - mu) * rstd * gg + bb;
            if (which) __builtin_nontemporal_store(o, (f32x4*)(yp + c)); else { u32x2 w; w.x = cvt_pk_bf16(o[0], o[1]); w.y = cvt_pk_bf16(o[2], o[3]); *(u32x2*)(x1b + (size_t)lr * 1024 + c) = w; } }
    }
}

__device__ void stage_glu(const Params& p, int s, int vid, int V) {
    const bool sample = (s == 8); const int rows = slab_rows(s);
    const bf16_t* av = (const bf16_t*)(p.ws + WS_AV + (size_t)(s & 1) * SZ_AV); bf16_t* hh = (bf16_t*)(p.ws + WS_H + (size_t)(s & 1) * SZ_H);
    const float* fw = p.in[16];
    const int total = (rows >> 3) * 352;
    const int tid = opaque_tid();
    for (int it = vid * 512 + tid; it < total; it += V * 512) {
        const int blk = it / 352, oc = it - blk * 352, ch = oc * 8, lr0 = blk * 8;
        const int hb = sample ? (lr0 >> 4) : (lr0 >> 11), tl0 = sample ? (lr0 & 15) : (lr0 & 2047), tlast = sample ? 15 : 2047;
        float w0[8], w1[8], w2[8], am2[8], am1[8];
        { const f32x4 q0 = *(const f32x4*)(fw + ch), q1 = *(const f32x4*)(fw + ch + 4), q2 = *(const f32x4*)(fw + 2816 + ch), q3 = *(const f32x4*)(fw + 2816 + ch + 4), q4 = *(const f32x4*)(fw + 5632 + ch), q5 = *(const f32x4*)(fw + 5632 + ch + 4);
#pragma unroll
          for (int k = 0; k < 4; ++k) { w0[k] = q0[k]; w0[4 + k] = q1[k]; w1[k] = q2[k]; w1[4 + k] = q3[k]; w2[k] = q4[k]; w2[4 + k] = q5[k]; } }
        if (tl0 > 0) { const u32x4 u0 = *(const u32x4*)(av + (size_t)(lr0 - 2) * 5632 + ch), u1 = *(const u32x4*)(av + (size_t)(lr0 - 1) * 5632 + ch);
            am2[0] = bflo(u0.x); am2[1] = bfhi(u0.x); am2[2] = bflo(u0.y); am2[3] = bfhi(u0.y); am2[4] = bflo(u0.z); am2[5] = bfhi(u0.z); am2[6] = bflo(u0.w); am2[7] = bfhi(u0.w);
            am1[0] = bflo(u1.x); am1[1] = bfhi(u1.x); am1[2] = bflo(u1.y); am1[3] = bfhi(u1.y); am1[4] = bflo(u1.z); am1[5] = bfhi(u1.z); am1[6] = bflo(u1.w); am1[7] = bfhi(u1.w); }
        else { const float* hp = sample ? p.in[5] + (size_t)hb * 2 * 2816 + ch : (s == 0 ? nullptr : (const float*)(p.ws + WS_HF + (size_t)((s - 1) & 1) * SZ_HF) + (size_t)hb * 2 * 2816 + ch);
#pragma unroll
            for (int k = 0; k < 8; ++k) { am2[k] = hp ? hp[k] : 0.f; am1[k] = hp ? hp[2816 + k] : 0.f; } }
#pragma unroll
        for (int r = 0; r < 8; ++r) {
            const u32x4 aw = *(const u32x4*)(av + (size_t)(lr0 + r) * 5632 + ch), vw = *(const u32x4*)(av + (size_t)(lr0 + r) * 5632 + 2816 + ch);
            const float a[8] = {bflo(aw.x), bfhi(aw.x), bflo(aw.y), bfhi(aw.y), bflo(aw.z), bfhi(aw.z), bflo(aw.w), bfhi(aw.w)};
            const float v[8] = {bflo(vw.x), bfhi(vw.x), bflo(vw.y), bfhi(vw.y), bflo(vw.z), bfhi(vw.z), bflo(vw.w), bfhi(vw.w)};
            float o[8];
#pragma unroll
            for (int k = 0; k < 8; k += 2) { const f32x2_ c3 = (f32x2_){w0[k], w0[k + 1]} * (f32x2_){am2[k], am2[k + 1]} + (f32x2_){w1[k], w1[k + 1]} * (f32x2_){am1[k], am1[k + 1]} + (f32x2_){w2[k], w2[k + 1]} * (f32x2_){a[k], a[k + 1]};
                const f32x2_ g2 = gelu_pk(c3) * (f32x2_){v[k], v[k + 1]}; o[k] = g2.x; o[k + 1] = g2.y; am2[k] = am1[k]; am2[k + 1] = am1[k + 1]; am1[k] = a[k]; am1[k + 1] = a[k + 1]; }
            u32x4 w; w.x = cvt_pk_bf16(o[0], o[1]); w.y = cvt_pk_bf16(o[2], o[3]); w.z = cvt_pk_bf16(o[4], o[5]); w.w = cvt_pk_bf16(o[6], o[7]);
            if (s >= SPLIT_FROM) *(u32x4*)(hh + (size_t)(ch >= 1408) * 4096 * 1408 + (size_t)(lr0 + r) * 1408 + (ch >= 1408 ? ch - 1408 : ch)) = w;
            else *(u32x4*)(hh + (size_t)(lr0 + r) * 2816 + ch) = w;
        }
        if (tl0 + 7 == tlast) {
            float* d1 = sample ? p.out + O_SFF + (size_t)hb * 2 * 2816 + ch : (float*)(p.ws + WS_HF + (size_t)(s & 1) * SZ_HF) + (size_t)hb * 2 * 2816 + ch;
#pragma unroll
            for (int k = 0; k < 8; ++k) { d1[k] = am2[k]; d1[2816 + k] = am1[k]; }
            if (!sample && s == 7) { float* d2 = p.out + O_PFF + (size_t)hb * 2 * 2816 + ch;
#pragma unroll
                for (int k = 0; k < 8; ++k) { d2[k] = am2[k]; d2[2816 + k] = am1[k]; } } }
    }
}

#define XB_TMO      128
#define XB_XCNT(j)  (256  + 64 * (j))
#define XB_XSUB(j)  (1280 + 64 * (j))
#define XB_XGEN(j)  (2304 + 64 * (j))
#define XB_TOP      3328
#define XB_TOPGEN   3392
#define XCD_BAR_WORDS 3456
#define XB_SPIN_CAP (1u << 22)
__device__ __forceinline__ unsigned xb_ld(unsigned* p)              { return __hip_atomic_load(p, __ATOMIC_RELAXED, __HIP_MEMORY_SCOPE_AGENT); }
__device__ __forceinline__ unsigned xb_add(unsigned* p, unsigned v) { return __hip_atomic_fetch_add(p, v, __ATOMIC_RELAXED, __HIP_MEMORY_SCOPE_AGENT); }
__device__ __forceinline__ unsigned xb_xcc_id() { return (unsigned)__builtin_amdgcn_s_getreg((3 << 11) | 20) & 0xFu; }
#define XB_SPIN(cond, bar) do { unsigned _sp = 0; while (cond) { __builtin_amdgcn_s_sleep(1); \
    if ((++_sp & 255u) == 0u) { if (xb_ld(&(bar)[XB_TMO])) break; if (_sp > XB_SPIN_CAP) { atomicAdd(&(bar)[XB_TMO], 1u); break; } } } } while (0)
struct XcdBarrier { unsigned* bar; unsigned x; volatile LAS unsigned* st; };
__device__ __forceinline__ XcdBarrier xcd_barrier_post(unsigned* bar, volatile LAS unsigned* st) {
    XcdBarrier b; b.bar = bar; b.x = xb_xcc_id(); b.st = st;
    if (threadIdx.x == 0) (void)xb_add(&bar[XB_XCNT(b.x)], 1u);
    return b;
}
__device__ __forceinline__ void xcd_barrier_complete(unsigned* bar, unsigned x, unsigned& nloc, unsigned& nx) {
    const unsigned G = gridDim.x * gridDim.y * gridDim.z;
    unsigned sum, cnt, mine, sp = 0u;
    for (;;) {
        sum = 0u; cnt = 0u; mine = 0u;
#pragma unroll
        for (unsigned j = 0; j < 16; ++j) { const unsigned c = xb_ld(&bar[XB_XCNT(j)]); sum += c; cnt += (c > 0u) ? 1u : 0u; mine = (j == x) ? c : mine; }
        if (sum == G) break;
        __builtin_amdgcn_s_sleep(1);
        if ((++sp & 255u) == 0u) { if (xb_ld(&bar[XB_TMO])) break; if (sp > XB_SPIN_CAP) { atomicAdd(&bar[XB_TMO], 1u); break; } }
    }
    nloc = mine > 0u ? mine : 1u; nx = cnt > 0u ? cnt : 1u;
}
__device__ __forceinline__ void xcd_barrier(const XcdBarrier& b) {
    asm volatile("s_waitcnt vmcnt(0)" ::: "memory");
    __syncthreads();
    if (threadIdx.x == 0) {
        unsigned* bar = b.bar;
        __builtin_amdgcn_s_waitcnt(0);
        unsigned nloc = b.st[0], nx = b.st[1];
        if (nloc == 0u) { xcd_barrier_complete(bar, b.x, nloc, nx); b.st[0] = nloc; b.st[1] = nx; }
        const unsigned old = xb_add(&bar[XB_XSUB(b.x)], 1u);
        const unsigned gen = old / nloc;
        if (old + 1u == (gen + 1u) * nloc) {
            __builtin_amdgcn_fence(__ATOMIC_RELEASE, "agent");
            asm volatile("s_waitcnt vmcnt(0)" ::: "memory");
            const unsigned og = xb_add(&bar[XB_TOP], 1u);
            const unsigned tg = og / nx;
            if (og + 1u == (tg + 1u) * nx) xb_add(&bar[XB_TOPGEN], 1u);
            else XB_SPIN(xb_ld(&bar[XB_TOPGEN]) == tg, bar);
            __builtin_amdgcn_fence(__ATOMIC_ACQUIRE, "agent");
            xb_add(&bar[XB_XGEN(b.x)], 1u);
            asm volatile("s_waitcnt vmcnt(0)" ::: "memory");
        } else {
            XB_SPIN(xb_ld(&bar[XB_XGEN(b.x)]) == gen, bar);
            __builtin_amdgcn_fence(__ATOMIC_ACQUIRE, "agent");
            asm volatile("s_waitcnt vmcnt(0)" ::: "memory");
        }
    }
    __syncthreads();
}

extern "C" __global__ void __launch_bounds__(512) mega(Params p) {
    extern __shared__ __attribute__((aligned(16))) unsigned char smem_raw[];
    LAS unsigned char* lds = (LAS unsigned char*)smem_raw;
    const int w = blockIdx.x, G = gridDim.x;
    volatile LAS unsigned* bst = (volatile LAS unsigned*)(lds + LDS_BYTES - 16);
    if (threadIdx.x == 0) { bst[0] = 0u; bst[1] = 0u; }
    __syncthreads();
    XcdBarrier xb; xb.bar = (unsigned*)(p.ws + WS_BAR); xb.x = 0; xb.st = bst;
    if (p.use_sync == 1) xb = xcd_barrier_post((unsigned*)(p.ws + WS_BAR), bst);
    for (int i = p.i_lo; i < p.i_hi; ++i) {
        #ifndef NO_WCONV
        if (i < 3) { stage_wconv(p, lds, i == 0 ? 0 : (i == 1 ? 2304 : 3968), i == 0 ? 2304 : (i == 1 ? 3968 : 4672)); __syncthreads(); }
#endif
        #ifndef NO_SCAN
        { const int s = i - 3; if (valid_slab(s)) { stage_scan(p, s, lds); __syncthreads(); } }
#endif
        const int sd = i - 9, s1 = i - 1, su = i - 7, so = i - 5;
        const int nd = valid_slab(sd) ? slab_panels(sd) * 4 : 0, n1 = valid_slab(s1) ? slab_panels(s1) * 36 : 0, nu = valid_slab(su) ? slab_panels(su) * 22 : 0, no = valid_slab(so) ? slab_panels(so) * 4 : 0;
        const int ns = (valid_slab(i - 3) && i - 3 < 8) ? 16 : 0;
        const int cs = (n1 + nu + no <= 3 * (G - (nd > 0 && sd >= SPLIT_FROM ? 2 * nd : nd) - ns)) ? 3 : 2;
        const bool dsplit = nd > 0 && sd >= SPLIT_FROM; const int ndw = dsplit ? 2 * nd : nd;
        if (nd) { DealDown S; S.w = w; S.G = G; S.n = ndw; S.npm = slab_panels(sd); S.split = dsplit ? 1 : 0;
            Gemm g; g.base = (const char*)p.ws; g.oA0 = (long)(WS_H + (size_t)(sd & 1) * SZ_H); g.dA1 = dsplit ? (long)4096 * 1408 * 2 : 0; g.dA2 = 0; g.oB0 = dsplit ? (long)WS_WD2 : (long)WS_WD; g.dB1 = dsplit ? (long)1024 * 1408 * 2 : 0; g.dB2 = 0; g.K = dsplit ? 1408 : 2816;
            EpiRes E; E.resp = nullptr; E.ress = nullptr; E.resb = (const bf16_t*)(p.ws + WS_X1B + (size_t)(sd & 3) * SZ_G1); E.pre = (bf16_t*)(p.ws + WS_PRE2 + (size_t)(sd & 1) * SZ_G1); E.pre2b = (bf16_t*)(p.ws + WS_PRE2B + (size_t)(sd & 1) * SZ_G1); E.y = p.out + O_YP; E.stats = (float*)(p.ws + WS_STATS); E.s = sd; E.soff = dsplit ? -1 : 2; E.mode = 1;
            pg8::gemm_phase<EpiRes, DealDown, false>(lds, g, S, E, nullptr); __syncthreads(); }
        if (n1 + nu + no) { Deal S; S.w = w; S.G = G; S.nd = ndw; S.ns = ns; S.cs = cs; S.n1 = n1; S.nu = nu; S.no = no; S.p1 = n1 ? slab_panels(s1) : 1; S.pu = nu ? slab_panels(su) : 1; S.po = no ? slab_panels(so) : 1;
            Gemm g; g.base = (const char*)p.ws; g.K = 1024;
            { const long a0 = (long)(WS_XB + (size_t)(s1 & 1) * SZ_XB), a1 = (long)(WS_X1B + (size_t)(su & 3) * SZ_G1), a2 = (long)(WS_MIX + (size_t)(so & 1) * SZ_G1);
              g.oA0 = a0; g.dA1 = a1 - a0; g.dA2 = a2 - a1; g.oB0 = (long)WS_WIN; g.dB1 = (long)WS_WUP - (long)WS_WIN; g.dB2 = (long)WS_WO - (long)WS_WUP; }
            EpiMulti E; E.e0.qkv = (bf16_t*)(p.ws + WS_QKV + (size_t)(s1 & 1) * SZ_QKV); E.e0.gate = (bf16_t*)(p.ws + WS_GATE + (size_t)(s1 & 3) * SZ_GATE); E.e0.gnorm = p.in[10];
            E.e1.av = (bf16_t*)(p.ws + WS_AV + (size_t)(su & 1) * SZ_AV);
            E.e2.resp = p.in[0]; E.e2.ress = p.in[1]; E.e2.resb = nullptr; E.e2.pre = (bf16_t*)(p.ws + WS_PRE1 + (size_t)(so & 1) * SZ_G1); E.e2.pre2b = nullptr; E.e2.y = nullptr; E.e2.stats = (float*)(p.ws + WS_STATS); E.e2.s = so; E.e2.soff = 0; E.e2.mode = 0;
            pg8::gemm_phase<EpiMulti, Deal, false>(lds, g, S, E, nullptr); __syncthreads(); }
        const int Gl = G - ns;
        int V = Gl, vid0 = w < Gl ? w : -1, vid1 = -1;
        { const int T = n1 + nu + no;
          if (ndw > 0 && T <= G - ndw - ns) {
              V = Gl - ndw; vid0 = (w >= ndw && w < Gl) ? w - ndw : -1; }
          else if (T > 0) { int rs = 0, before = 0, cap = 0;
              for (;;) { cap = G - (rs < 3 ? ndw : 0) - (rs < cs ? ns : 0); if (before + cap >= T || cap <= 0) break; before += cap; ++rs; }
              const int cl = T - before;
              const bool part = (w >= ndw || rs >= 3) && w < Gl; const int rank = w - (rs < 3 ? (w < ndw ? w : ndw) : 0);
              const int capl = cap - ((rs >= cs) ? ns : 0);
              if (cl > 0 && cl < capl) { V = Gl + (capl - cl); if (part && rank >= cl) vid1 = Gl + (rank - cl); } } }
        for (int rep_ = 0; rep_ < 2; ++rep_) { const int vid = rep_ ? vid1 : vid0; if (vid < 0) continue;
            if (valid_slab(i)) for (int r_ = 0; r_ < (p.pad & 15); ++r_) { stage_cvt(p, i, lds, vid, V); __syncthreads(); }
            if (valid_slab(i - 2)) for (int r_ = 0; r_ < ((p.pad >> 4) & 15); ++r_) { stage_prep(p, i - 2, lds, vid, V); __syncthreads(); }
            if (valid_slab(i - 4)) for (int r_ = 0; r_ < ((p.pad >> 8) & 15); ++r_) stage_merge(p, i - 4, vid, V);
            if (valid_slab(i - 6)) stage_ln(p, i - 6, 0, vid, V);
            if (valid_slab(i - 8)) for (int r_ = 0; r_ < ((p.pad >> 12) & 15); ++r_) stage_glu(p, i - 8, vid, V);
            if (valid_slab(i - 10)) stage_ln(p, i - 10, 1, vid, V);
        }
        if (i + 1 < p.i_hi) { if (p.use_sync == 1) xcd_barrier(xb); else if (p.use_sync == 2) cg::this_grid().sync(); }
    }
}

#ifndef REPS
#define REPS 0x11111
#endif
#ifndef MK_LAUNCHES
#define MK_LAUNCHES 1
#endif
extern "C" void kernel_launch(void* const* d_in, const int* in_sizes, int n_in, void* d_out, int out_size, void* d_ws, size_t ws_size, hipStream_t stream) {
    static int grid = 0;
    if (grid == 0) {
        int dev = 0, cus = 0, per_cu = 0;
        hipGetDevice(&dev); hipDeviceGetAttribute(&cus, hipDeviceAttributeMultiprocessorCount, dev);
        if (hipFuncSetAttribute((const void*)mega, hipFuncAttributeMaxDynamicSharedMemorySize, LDS_BYTES) != hipSuccess) fprintf(stderr, "hipFuncSetAttribute failed\n");
        if (hipOccupancyMaxActiveBlocksPerMultiprocessor(&per_cu, (const void*)mega, 512, LDS_BYTES) != hipSuccess || per_cu < 1) { fprintf(stderr, "occupancy query: %d\n", per_cu); per_cu = 1; }
        (void)hipGetLastError();
        grid = cus * 1;
        if (ws_size < WS_END) { fprintf(stderr, "workspace too small: %zu < %zu\n", ws_size, (size_t)WS_END); grid = -1; }
    }
    if (grid < 0) return;
    if (hipMemsetAsync((unsigned char*)d_ws + WS_BAR, 0, 16384, stream) != hipSuccess) fprintf(stderr, "memset of barrier words failed\n");
    Params p{};
    for (int i = 0; i < 20; ++i) p.in[i] = (const float*)d_in[i];
    p.out = (float*)d_out; p.ws = (unsigned char*)d_ws;
#if MK_LAUNCHES == 1
    p.i_lo = 0; p.i_hi = NINT; p.use_sync = 1; p.pad = REPS;
    void* args[] = {&p};
    hipError_t e = hipLaunchCooperativeKernel((const void*)mega, dim3(grid), dim3(512), args, LDS_BYTES, stream);
    if (e != hipSuccess) fprintf(stderr, "cooperative launch failed: %s (grid %d)\n", hipGetErrorString(e), grid);
#else
    for (int i = 0; i < NINT; ++i) { p.i_lo = i; p.i_hi = i + 1; p.use_sync = 0; p.pad = 0; hipLaunchKernelGGL(mega, dim3(grid), dim3(512), LDS_BYTES, stream, p); }
#endif
}
```

```cpp
#include <hip/hip_runtime.h>
#include <hip/hip_cooperative_groups.h>
#include <cstdio>
namespace cg = cooperative_groups;
__device__ __forceinline__ int opaque_tid() { int t; asm volatile("v_mov_b32 %0, %1" : "=v"(t) : "v"(threadIdx.x)); return t; }
namespace pg8 {
#define PG8_LAS __attribute__((address_space(3)))
typedef unsigned short bf16_t;
typedef short bf16x8 __attribute__((ext_vector_type(8)));
typedef float f32x4 __attribute__((ext_vector_type(4)));
typedef unsigned u32x4 __attribute__((ext_vector_type(4)));
constexpr int BM = 256, BK = 64, HALF = 128, HTB = HALF * BK * 2  , STAGE_BYTES = 8 * HTB, NXCD = 8, WGM = 8;
__host__ __device__ __forceinline__ int lds_byte(int r, int c) { const int st = (r >> 4) * 2 + (c >> 5), rr = r & 15, cc = c & 31, ob = rr * 64 + cc * 2; return st * 1024 + (ob ^ (((ob >> 9) & 1) << 5)); }
__host__ __device__ __forceinline__ void stage_rc(int b, int& R, int& C) { const int st = b / 1024, sb = b % 1024, swz = sb ^ (((sb >> 9) & 1) << 5); R = (st >> 1) * 16 + swz / 64; C = (st & 1) * 32 + (swz % 64) / 2; }
__host__ __device__ __forceinline__ int perm32(int rho) { const int n = rho >> 4, i = rho & 15; return 8 * (i >> 2) + 4 * n + (i & 3); }
struct Unit { int pm, pn, ty; };
struct Gemm { const char* base; long oA0, dA1, dA2, oB0, dB1, dB2; int K;
    __device__ __forceinline__ const char* selA(int ty) const { return base + oA0 + (long)(ty > 0) * dA1 + (long)(ty > 1) * dA2; }
    __device__ __forceinline__ const char* selB(int ty) const { return base + oB0 + (long)(ty > 0) * dB1 + (long)(ty > 1) * dB2; } };
typedef float f32x2c_ __attribute__((ext_vector_type(2))); typedef __bf16 bf16x2c_ __attribute__((ext_vector_type(2)));
__device__ __forceinline__ unsigned cvt_pk_bf16(float lo, float hi) { const f32x2c_ v = {lo, hi}; const bf16x2c_ b = __builtin_convertvector(v, bf16x2c_); return __builtin_bit_cast(unsigned, b); }
typedef float f32x2 __attribute__((ext_vector_type(2)));
template <class Epi, class Sched, bool STAMP = false>
__device__ __forceinline__ void gemm_phase(PG8_LAS unsigned char* lds, const Gemm g, const Sched& S, const Epi& E, unsigned long long* stamps) {
    const int tid = opaque_tid(), wid = __builtin_amdgcn_readfirstlane(tid >> 6), lane = tid & 63, wr = wid >> 2, wc = wid & 3, fr = lane & 15, fq = lane >> 4;
    const int K = g.K, nt = K / BK;
    int ts_lo = 0, ts_hi = 0, nts = 0; const unsigned long long rt_entry = STAMP ? (unsigned long long)wall_clock64() : 0ull;
#define PG8_STAMP() do { if (STAMP && wid == 0 && nts < 64) { const unsigned long long _c = (unsigned long long)clock64(); \
        ts_lo = (lane == nts) ? (int)(unsigned)_c : ts_lo; ts_hi = (lane == nts) ? (int)(unsigned)(_c >> 32) : ts_hi; ++nts; } } while (0)
    PG8_STAMP();
    unsigned voffA[2], voffB[2];
#pragma unroll
    for (int i = 0; i < 2; ++i) { int R, C; stage_rc(tid * 16 + i * 8192, R, C); const int Rb = Epi::PERM ? ((R & ~31) + perm32(R & 31)) : R;
        voffA[i] = (unsigned)(R * K + C) * 2u; voffB[i] = (unsigned)(Rb * K + C) * 2u; }
    const size_t kstep = (size_t)(BK * 2);
    const size_t hstep = (size_t)HALF * K * 2;
    const size_t tstep = 2 * hstep;
    const unsigned ldsw = (unsigned)wid * 1024u;
    const int aoff = lds_byte(wr * 64 + fr, fq * 8), boff = lds_byte(wc * 32 + fr, fq * 8);
#define PG8_SA(b, h) (((b) * 2 + (h)) * HTB)
#define PG8_SB(b, h) ((4 + (b) * 2 + (h)) * HTB)
#define PG8_STAGE(bufoff, gbase, voff) do { _Pragma("unroll") for (int _i = 0; _i < 2; ++_i) \
        __builtin_amdgcn_global_load_lds((const unsigned*)((const char*)(gbase) + (voff)[_i]), (PG8_LAS unsigned*)(lds + (bufoff) + ldsw + _i * 8192), 16, 0, 0); } while (0)
#define PG8_LDA(dst, b, h) do { _Pragma("unroll") for (int m = 0; m < 4; ++m) _Pragma("unroll") for (int k = 0; k < 2; ++k) dst[m][k] = *(const PG8_LAS bf16x8*)(lds + PG8_SA(b, h) + aoff + m * 2048 + k * 1024); } while (0)
#define PG8_LDB(dst, b, h) do { _Pragma("unroll") for (int n = 0; n < 2; ++n) _Pragma("unroll") for (int k = 0; k < 2; ++k) dst[n][k] = *(const PG8_LAS bf16x8*)(lds + PG8_SB(b, h) + boff + n * 2048 + k * 1024); } while (0)
#define PG8_MMA(ai, bj, At, Bt) do { __builtin_amdgcn_s_setprio(1); _Pragma("unroll") for (int m = 0; m < 4; ++m) _Pragma("unroll") for (int n = 0; n < 2; ++n) _Pragma("unroll") for (int k = 0; k < 2; ++k) \
        acc[ai][bj][m][n] = __builtin_amdgcn_mfma_f32_16x16x32_bf16(Bt[n][k], At[m][k], acc[ai][bj][m][n], 0, 0, 0); __builtin_amdgcn_s_setprio(0); } while (0)
#define PG8_WAIT_V(n) asm volatile("s_waitcnt vmcnt(" #n ")" ::: "memory")
#define PG8_WAIT_L(n) asm volatile("s_waitcnt lgkmcnt(" #n ")" ::: "memory")
#define PG8_BAR __builtin_amdgcn_s_barrier()
#define PG8_SCHED __builtin_amdgcn_sched_barrier(0)
    Unit cur, nxt; int ui = 0;
    if (!S.next(0, cur)) return;
    f32x4 acc[2][2][4][2];
#pragma unroll
    for (int a = 0; a < 2; ++a)
#pragma unroll
        for (int b = 0; b < 2; ++b)
#pragma unroll
            for (int m = 0; m < 4; ++m)
#pragma unroll
                for (int n = 0; n < 2; ++n) acc[a][b][m][n] = (f32x4){0.f, 0.f, 0.f, 0.f};
    bf16x8 At[4][2], B0[2][2], B1[2][2];
    const char* cA = g.selA(cur.ty) + (size_t)cur.pm * tstep; const char* cB = g.selB(cur.ty) + (size_t)cur.pn * tstep;
    S.a_ready(cur);
    PG8_STAGE(PG8_SB(0, 0), cB, voffB); PG8_STAGE(PG8_SA(0, 0), cA, voffA); PG8_STAGE(PG8_SB(0, 1), cB + hstep, voffB); PG8_STAGE(PG8_SA(0, 1), cA + hstep, voffA);
    if (wr == 1) PG8_BAR;
    PG8_WAIT_V(4); PG8_BAR;
    PG8_STAGE(PG8_SB(1, 0), cB + kstep, voffB); PG8_STAGE(PG8_SA(1, 0), cA + kstep, voffA); PG8_STAGE(PG8_SB(1, 1), cB + hstep + kstep, voffB);
    PG8_WAIT_V(6); PG8_BAR;
    PG8_STAMP();
    for (;;) {
        const bool has_next = S.next(ui + 1, nxt);
        const char* nA = has_next ? g.selA(nxt.ty) + (size_t)nxt.pm * tstep : cA; const char* nB = has_next ? g.selB(nxt.ty) + (size_t)nxt.pn * tstep : cB;
        for (int t = 0; t < nt; t += 2) {
            const bool last = (t == nt - 2);
            const char* a1 = cA + (size_t)(t + 1) * kstep;
            const char* a2 = last ? nA : cA + (size_t)(t + 2) * kstep; const char* b2 = last ? nB : cB + (size_t)(t + 2) * kstep;
            const char* a3 = a2 + kstep; const char* b3 = b2 + kstep;
            if (last && has_next) S.a_ready(nxt);
            PG8_LDB(B0, 0, 0); PG8_SCHED; PG8_LDA(At, 0, 0); PG8_STAGE(PG8_SA(1, 1), a1 + hstep, voffA);
            PG8_WAIT_L(8); PG8_BAR; PG8_WAIT_L(0); PG8_MMA(0, 0, At, B0); PG8_BAR; PG8_SCHED;
            PG8_LDB(B1, 0, 1); PG8_STAGE(PG8_SB(0, 0), b2, voffB);
            PG8_BAR; PG8_WAIT_L(0); PG8_MMA(0, 1, At, B1); PG8_BAR;
            PG8_LDA(At, 0, 1); PG8_STAGE(PG8_SA(0, 0), a2, voffA);
            PG8_BAR; PG8_WAIT_L(0); PG8_MMA(1, 0, At, B0); PG8_BAR; PG8_SCHED;
            PG8_STAGE(PG8_SB(0, 1), b2 + hstep, voffB);
            PG8_WAIT_V(6); PG8_BAR; PG8_MMA(1, 1, At, B1); PG8_BAR;
            PG8_LDB(B0, 1, 0); PG8_SCHED; PG8_LDA(At, 1, 0); PG8_STAGE(PG8_SA(0, 1), a2 + hstep, voffA);
            PG8_WAIT_L(8); PG8_BAR; PG8_WAIT_L(0); PG8_MMA(0, 0, At, B0); PG8_BAR; PG8_SCHED;
            PG8_LDB(B1, 1, 1); PG8_STAGE(PG8_SB(1, 0), b3, voffB);
            PG8_BAR; PG8_WAIT_L(0); PG8_MMA(0, 1, At, B1); PG8_BAR;
            PG8_LDA(At, 1, 1); PG8_STAGE(PG8_SA(1, 0), a3, voffA);
            PG8_BAR; PG8_WAIT_L(0); PG8_MMA(1, 0, At, B0); PG8_BAR; PG8_SCHED;
            PG8_STAGE(PG8_SB(1, 1), b3 + hstep, voffB);
            PG8_WAIT_V(6); PG8_BAR; PG8_MMA(1, 1, At, B1); PG8_BAR;
        }
        PG8_STAMP();
        if constexpr (!Epi::AFTER_DRAIN) { E(acc, cur, wr, wc, fr, fq); S.done(cur); }
        PG8_STAMP();
        if (!has_next) break;
#pragma unroll
        for (int a = 0; a < 2; ++a)
#pragma unroll
            for (int b = 0; b < 2; ++b)
#pragma unroll
                for (int m = 0; m < 4; ++m)
#pragma unroll
                    for (int n = 0; n < 2; ++n) acc[a][b][m][n] = (f32x4){0.f, 0.f, 0.f, 0.f};
        cur = nxt; cA = nA; cB = nB; ++ui;
    }
    PG8_WAIT_V(0);
    if (wr == 0) PG8_BAR;
    PG8_BAR;
    if constexpr (Epi::AFTER_DRAIN) { E.fused(acc, cur, wr, wc, fr, fq, lds, wid, lane); S.done(cur); }
    PG8_STAMP();
    if (STAMP && wid == 0) { stamps[lane] = lane < nts ? (((unsigned long long)(unsigned)ts_hi << 32) | (unsigned)ts_lo) : 0ull;
        if (lane == 62) stamps[62] = rt_entry; if (lane == 63) stamps[63] = (unsigned long long)wall_clock64(); }
#undef PG8_STAMP
#undef PG8_SA
#undef PG8_SB
#undef PG8_STAGE
#undef PG8_LDA
#undef PG8_LDB
#undef PG8_MMA
#undef PG8_WAIT_V
#undef PG8_WAIT_L
#undef PG8_BAR
#undef PG8_SCHED
}
}

using pg8::bf16_t; using pg8::bf16x8; using pg8::f32x4; using pg8::u32x4; using pg8::Unit; using pg8::Gemm; using pg8::cvt_pk_bf16;
typedef unsigned u32x2 __attribute__((ext_vector_type(2)));
#define LAS __attribute__((address_space(3)))
constexpr int NSLAB = 9, NSTAGE = 11, NINT = NSLAB + NSTAGE - 1;
constexpr int IN_DIM = 9232;
constexpr float ALPHA = 1.189207115002721f;
constexpr int LDS_BYTES = 152 * 1024;
constexpr size_t O_YP = 0, O_PGC = 34078720, O_PS = 34097152, O_PSC = 34359296, O_PFF = 34363392, O_SGC = 34374656, O_SS = 34669568, O_SSC = 38863872, O_SFF = 38929408;
constexpr int R_W = 0, R_QD = 16384, R_KT = 32768, R_QK = 49152, R_U = 57344, R_HDR = 73728, REC_BYTES = 73984;
constexpr size_t A256(size_t x) { return (x + 255) & ~(size_t)255; }
constexpr size_t WS_WIN = 0;
constexpr size_t WS_WO = WS_WIN + (size_t)9216 * 1024 * 2;
constexpr size_t WS_WUP = WS_WO + (size_t)1024 * 1024 * 2;
constexpr size_t WS_WD = WS_WUP + (size_t)5632 * 1024 * 2;
constexpr size_t WS_XB = WS_WD + (size_t)1024 * 2816 * 2;
constexpr size_t SZ_XB = (size_t)4096 * 1024 * 2;
constexpr size_t WS_AB = WS_XB + 2 * SZ_XB;
constexpr size_t WS_QKV = A256(WS_AB + (size_t)33280 * 16 * 4);
constexpr size_t SZ_QKV = (size_t)4096 * 3072 * 2;
constexpr size_t WS_GATE = WS_QKV + 2 * SZ_QKV;
constexpr size_t SZ_G1 = (size_t)4096 * 1024 * 2, SZ_GATE = 3 * SZ_G1;
constexpr size_t WS_REC = WS_GATE + 4 * SZ_GATE;
constexpr size_t SZ_REC = (size_t)512 * REC_BYTES;
constexpr size_t WS_ORAW = WS_REC + 2 * SZ_REC;
constexpr size_t WS_MIX = WS_ORAW + 2 * SZ_G1;
constexpr size_t WS_X1B = WS_MIX + 2 * SZ_G1;
constexpr size_t WS_AV = WS_X1B + 4 * SZ_G1;
constexpr size_t SZ_AV = (size_t)4096 * 5632 * 2;
constexpr size_t WS_H = WS_AV + 2 * SZ_AV;
constexpr size_t SZ_H = (size_t)4096 * 2816 * 2;
constexpr size_t WS_STATS = WS_H + 2 * SZ_H;
constexpr size_t WS_HQ = WS_STATS + (size_t)33280 * 16;
constexpr size_t SZ_HQ = (size_t)2 * 3 * 3072 * 4;
constexpr size_t WS_HS = WS_HQ + 2 * SZ_HQ;
constexpr size_t SZ_HS = (size_t)2 * 2 * 1024 * 4;
constexpr size_t WS_HF = WS_HS + 2 * SZ_HS;
constexpr size_t SZ_HF = (size_t)2 * 2 * 2816 * 4;
constexpr size_t WS_BAR = A256(WS_HF + 2 * SZ_HF);
constexpr size_t WS_PRE1 = WS_BAR + 16384;
constexpr size_t WS_PRE2 = WS_PRE1 + 2 * SZ_G1;
constexpr size_t WS_PRE2B = WS_PRE2 + 2 * SZ_G1;
constexpr size_t WS_WD2 = WS_PRE2B + 2 * SZ_G1;
constexpr size_t WS_END = WS_WD2 + (size_t)2 * 1024 * 1408 * 2;
constexpr int SPLIT_FROM = 5;

struct Params { const float* in[20]; float* out; unsigned char* ws; int i_lo, i_hi, use_sync, pad; };

__device__ __forceinline__ float bf2f(unsigned short b) { return __uint_as_float((unsigned)b << 16); }
__device__ __forceinline__ float bflo(unsigned w) { return __uint_as_float(w << 16); }
__device__ __forceinline__ float bfhi(unsigned w) { return __uint_as_float(w & 0xffff0000u); }
__device__ __forceinline__ unsigned short f2bf(float f) { return (unsigned short)(cvt_pk_bf16(f, 0.f) & 0xffffu); }
__device__ __forceinline__ float sigmoidf_(float x) { return __builtin_amdgcn_rcpf(1.0f + __expf(-x)); }
__device__ __forceinline__ float gelu_f(float v) {
    const float av = fabsf(v), t = __builtin_amdgcn_rcpf(av * 0.2316418882f + 1.0f);
    float q = t * 0.5307027145f + (-0.7265760135f); q = q * t + 0.7107068705f; q = q * t + (-0.142248368f); q = q * t + 0.127414796f; q = q * t;
    const float e = __builtin_amdgcn_exp2f(v * v * (-0.72134752044f)), m = v * (q * e);
    return v < 0.f ? m : v - m; }
typedef float f32x2_ __attribute__((ext_vector_type(2)));
__device__ __forceinline__ f32x2_ gelu_pk(f32x2_ v) {
    const f32x2_ av = __builtin_elementwise_abs(v), d = av * 0.2316418882f + 1.0f;
    f32x2_ t; t.x = __builtin_amdgcn_rcpf(d.x); t.y = __builtin_amdgcn_rcpf(d.y);
    f32x2_ q = t * 0.5307027145f + (-0.7265760135f); q = q * t + 0.7107068705f; q = q * t + (-0.142248368f); q = q * t + 0.127414796f; q = q * t;
    const f32x2_ s = (v * v) * (-0.72134752044f);
    f32x2_ e; e.x = __builtin_amdgcn_exp2f(s.x); e.y = __builtin_amdgcn_exp2f(s.y);
    const f32x2_ m = v * (q * e), r = v - m;
    f32x2_ o; o.x = v.x < 0.f ? m.x : r.x; o.y = v.y < 0.f ? m.y : r.y; return o;
}
__device__ __forceinline__ int slab_rows(int s) { return s < 8 ? 4096 : 512; }
__device__ __forceinline__ int slab_panels(int s) { return s < 8 ? 16 : 2; }
__device__ __forceinline__ int grow_of(int s, int lr) { return s < 8 ? ((lr >> 11) * 16384 + s * 2048 + (lr & 2047)) : (32768 + lr); }
__device__ __forceinline__ const float* xrow(const Params& p, int grow) { return grow < 32768 ? p.in[0] + (size_t)grow * 1024 : p.in[1] + (size_t)(grow - 32768) * 1024; }
__device__ __forceinline__ bool valid_slab(int s) { return s >= 0 && s < NSLAB; }

struct Deal {
    int w, G, nd, ns, cs, n1, nu, no, p1, pu, po;
    __device__ __forceinline__ int cand(int i) const { const int busy = w < nd ? 3 : (w >= G - ns ? cs : 0), r = busy + i;
        const int before = r * G - nd * (r < 3 ? r : 3) - ns * (r < cs ? r : cs), rank = w - (r < 3 ? (w < nd ? w : nd) : 0); return before + rank; }
    __device__ __forceinline__ static void map16(int j, int N, int& pm, int& pn) { const int x = j & 7, t = j >> 3; pm = 4 * (x & 3) + (t & 3); pn = (x >> 2) * (N >> 1) + (t >> 2); }
    __device__ __forceinline__ bool next(int i, Unit& u) const { const int q = cand(i); if (q >= n1 + nu + no) return false;
        if (q < n1) { u.ty = 0; if (p1 == 16) map16(q, 36, u.pm, u.pn); else { u.pm = q % p1; u.pn = q / p1; } }
        else if (q < n1 + nu) { const int j = q - n1; u.ty = 1; if (pu == 16) map16(j, 22, u.pm, u.pn); else { u.pm = j % pu; u.pn = j / pu; } }
        else { const int j = q - n1 - nu; u.ty = 2; if (po == 16) map16(j, 4, u.pm, u.pn); else { u.pm = j % po; u.pn = j / po; } }
        return true; }
    __device__ __forceinline__ void a_ready(const Unit&) const {}
    __device__ __forceinline__ void done(const Unit&) const {}
};
struct DealDown {
    int w, G, n, npm, split;
    __device__ __forceinline__ bool next(int i, Unit& u) const { const int j = w + i * G; if (j >= n || (n <= G && i > 0)) return false; const int t = split ? (j >> 1) : j; u.pm = t % npm; u.pn = t / npm; u.ty = split ? (j & 1) : 0; return true; }
    __device__ __forceinline__ void a_ready(const Unit&) const {}
    __device__ __forceinline__ void done(const Unit&) const {}
};

struct EpiIn {
    static constexpr bool PERM = true, AFTER_DRAIN = false;
    bf16_t* qkv; bf16_t* gate; const float* gnorm;
    __device__ __forceinline__ void operator()(const f32x4 (&acc)[2][2][4][2], const Unit& u, int wr, int wc, int fr, int fq) const {
        const int row0 = u.pm * 256 + wr * 64 + fr;
        if (u.pn < 12) {
#pragma unroll
            for (int ai = 0; ai < 2; ++ai)
#pragma unroll
                for (int m = 0; m < 4; ++m) { bf16_t* rowp = qkv + (size_t)(row0 + ai * 128 + m * 16) * 3072 + u.pn * 256 + wc * 32 + 8 * fq;
#pragma unroll
                    for (int bj = 0; bj < 2; ++bj) { const f32x4 v0 = acc[ai][bj][m][0], v1 = acc[ai][bj][m][1]; u32x4 w;
                        w.x = cvt_pk_bf16(v0[0], v0[1]); w.y = cvt_pk_bf16(v0[2], v0[3]); w.z = cvt_pk_bf16(v1[0], v1[1]); w.w = cvt_pk_bf16(v1[2], v1[3]);
                        *(u32x4*)(rowp + bj * 128) = w; } }
        } else {
            const int type = (u.pn - 12) >> 3, j = (u.pn - 12) & 7, ch = j * 128 + wc * 32 + 8 * fq;
            bf16_t* base = gate + (size_t)type * 4096 * 1024 + ch;
            float gn[8];
#pragma unroll
            for (int k = 0; k < 8; ++k) gn[k] = (type == 0) ? gnorm[(ch + k) & 127] : 1.0f;
#pragma unroll
            for (int ai = 0; ai < 2; ++ai)
#pragma unroll
                for (int m = 0; m < 4; ++m) { float o[8];
#pragma unroll
                    for (int n = 0; n < 2; ++n)
#pragma unroll
                        for (int k = 0; k < 4; k += 2) { const f32x2_ X = {acc[ai][0][m][n][k], acc[ai][0][m][n][k + 1]}, Y = {acc[ai][1][m][n][k], acc[ai][1][m][n][k + 1]}; f32x2_ r;
                            if (type == 2) r = X * Y;
                            else { f32x2_ ey; ey.x = __expf(-Y.x); ey.y = __expf(-Y.y);
                                if (type == 0) { f32x2_ ex; ex.x = __expf(-X.x); ex.y = __expf(-X.y); const f32x2_ den = (ey + 1.0f) * (ex + 1.0f); f32x2_ rc; rc.x = __builtin_amdgcn_rcpf(den.x); rc.y = __builtin_amdgcn_rcpf(den.y);
                                    r = X * rc * (f32x2_){gn[n * 4 + k], gn[n * 4 + k + 1]}; }
                                else { const f32x2_ den = ey + 1.0f; f32x2_ rc; rc.x = __builtin_amdgcn_rcpf(den.x); rc.y = __builtin_amdgcn_rcpf(den.y); r = X * rc; } }
                            o[n * 4 + k] = r.x; o[n * 4 + k + 1] = r.y; }
                    u32x4 w; w.x = cvt_pk_bf16(o[0], o[1]); w.y = cvt_pk_bf16(o[2], o[3]); w.z = cvt_pk_bf16(o[4], o[5]); w.w = cvt_pk_bf16(o[6], o[7]);
                    __builtin_nontemporal_store(w, (u32x4*)(base + (size_t)(row0 + ai * 128 + m * 16) * 1024)); }
        }
    }
};
struct EpiUp {
    static constexpr bool PERM = true, AFTER_DRAIN = false;
    bf16_t* av;
    __device__ __forceinline__ void operator()(const f32x4 (&acc)[2][2][4][2], const Unit& u, int wr, int wc, int fr, int fq) const {
        const int row0 = u.pm * 256 + wr * 64 + fr;
#pragma unroll
        for (int ai = 0; ai < 2; ++ai)
#pragma unroll
            for (int m = 0; m < 4; ++m) { bf16_t* rowp = av + (size_t)(row0 + ai * 128 + m * 16) * 5632 + u.pn * 256 + wc * 32 + 8 * fq;
#pragma unroll
                for (int bj = 0; bj < 2; ++bj) { const f32x4 v0 = acc[ai][bj][m][0], v1 = acc[ai][bj][m][1]; u32x4 w;
                    w.x = cvt_pk_bf16(v0[0], v0[1]); w.y = cvt_pk_bf16(v0[2], v0[3]); w.z = cvt_pk_bf16(v1[0], v1[1]); w.w = cvt_pk_bf16(v1[2], v1[3]);
                    *(u32x4*)(rowp + bj * 128) = w; } }
    }
};
struct EpiRes {
    static constexpr bool PERM = true, AFTER_DRAIN = false;
    const float* resp; const float* ress; const bf16_t* resb; bf16_t* pre; bf16_t* pre2b; float* y; float* stats; int s, soff, mode;
    __device__ __forceinline__ void operator()(const f32x4 (&acc)[2][2][4][2], const Unit& u, int wr, int wc, int fr, int fq) const {
        const int col0 = u.pn * 256 + wc * 32 + 8 * fq;
#pragma unroll
        for (int ai = 0; ai < 2; ++ai)
#pragma unroll
            for (int m = 0; m < 4; ++m) {
                const int lr = u.pm * 256 + ai * 128 + wr * 64 + m * 16 + fr, grow = grow_of(s, lr);
                float sm = 0.f, sq = 0.f;
                if (mode == 1 && u.ty == 1) {
                    bf16_t* op = pre2b + (size_t)lr * 1024 + col0;
#pragma unroll
                    for (int bj = 0; bj < 2; ++bj) { const f32x4 v0 = acc[ai][bj][m][0], v1 = acc[ai][bj][m][1]; u32x4 w; w.x = cvt_pk_bf16(v0[0], v0[1]); w.y = cvt_pk_bf16(v0[2], v0[3]); w.z = cvt_pk_bf16(v1[0], v1[1]); w.w = cvt_pk_bf16(v1[2], v1[3]); *(u32x4*)(op + bj * 128) = w; }
                } else if (mode == 0) {
                    const float* rp = (grow < 32768 ? resp + (size_t)grow * 1024 : ress + (size_t)(grow - 32768) * 1024) + col0; bf16_t* op = pre + (size_t)lr * 1024 + col0;
#pragma unroll
                    for (int bj = 0; bj < 2; ++bj) { const f32x4 r0 = __builtin_nontemporal_load((const f32x4*)(rp + bj * 128)), r1 = __builtin_nontemporal_load((const f32x4*)(rp + bj * 128 + 4)); const f32x4 v0 = r0 * ALPHA + acc[ai][bj][m][0], v1 = r1 * ALPHA + acc[ai][bj][m][1];
                        u32x4 w; w.x = cvt_pk_bf16(v0[0], v0[1]); w.y = cvt_pk_bf16(v0[2], v0[3]); w.z = cvt_pk_bf16(v1[0], v1[1]); w.w = cvt_pk_bf16(v1[2], v1[3]); *(u32x4*)(op + bj * 128) = w;
                        sm += (v0[0] + v0[1]) + (v0[2] + v0[3]) + (v1[0] + v1[1]) + (v1[2] + v1[3]);
                        sq += (v0[0] * v0[0] + v0[1] * v0[1]) + (v0[2] * v0[2] + v0[3] * v0[3]) + (v1[0] * v1[0] + v1[1] * v1[1]) + (v1[2] * v1[2] + v1[3] * v1[3]); }
                } else {
                    const bf16_t* rp = resb + (size_t)lr * 1024 + col0; bf16_t* op = pre + (size_t)lr * 1024 + col0;
#pragma unroll
                    for (int bj = 0; bj < 2; ++bj) { const u32x4 rw = *(const u32x4*)(rp + bj * 128);
                        const f32x4 r0 = {bflo(rw.x), bfhi(rw.x), bflo(rw.y), bfhi(rw.y)}, r1 = {bflo(rw.z), bfhi(rw.z), bflo(rw.w), bfhi(rw.w)};
                        const f32x4 v0 = r0 * ALPHA + acc[ai][bj][m][0], v1 = r1 * ALPHA + acc[ai][bj][m][1];
                        u32x4 w; w.x = cvt_pk_bf16(v0[0], v0[1]); w.y = cvt_pk_bf16(v0[2], v0[3]); w.z = cvt_pk_bf16(v1[0], v1[1]); w.w = cvt_pk_bf16(v1[2], v1[3]); *(u32x4*)(op + bj * 128) = w;
                        sm += (v0[0] + v0[1]) + (v0[2] + v0[3]) + (v1[0] + v1[1]) + (v1[2] + v1[3]);
                        sq += (v0[0] * v0[0] + v0[1] * v0[1]) + (v0[2] * v0[2] + v0[3] * v0[3]) + (v1[0] * v1[0] + v1[1] * v1[1]) + (v1[2] * v1[2] + v1[3] * v1[3]); }
                }
                sm += __shfl_xor(sm, 16); sm += __shfl_xor(sm, 32); sq += __shfl_xor(sq, 16); sq += __shfl_xor(sq, 32);
                if (fq == 0 && soff >= 0) { atomicAdd(stats + (size_t)grow * 4 + soff, sm); atomicAdd(stats + (size_t)grow * 4 + soff + 1, sq); }
            }
    }
};
struct EpiMulti {
    static constexpr bool PERM = true, AFTER_DRAIN = false;
    EpiIn e0; EpiUp e1; EpiRes e2;
    __device__ __forceinline__ void operator()(const f32x4 (&acc)[2][2][4][2], const Unit& u, int wr, int wc, int fr, int fq) const {
        if (u.ty == 0) e0(acc, u, wr, wc, fr, fq); else if (u.ty == 1) e1(acc, u, wr, wc, fr, fq); else e2(acc, u, wr, wc, fr, fq); }
};

__device__ __forceinline__ int src_col_in(int np) {
    const int pn = np >> 8; if (pn < 12) return np;
    const int within = np & 255, half = within >> 7, cl = within & 127, type = (pn - 12) >> 3, j = (pn - 12) & 7;
    const int base = type == 0 ? (half ? 7184 : 3072) : (type == 1 ? (half ? 8208 : 4112) : (half ? 6160 : 5136));
    return base + j * 128 + cl;
}
__device__ void stage_wconv(const Params& p, LAS unsigned char* lds, int t_lo, int t_hi) {
    LAS float* t = (LAS float*)lds;
    const int tid = opaque_tid();
    for (int ti = t_lo + blockIdx.x; ti < t_hi; ti += gridDim.x) {
        const float* W; bf16_t* D; int N, K, tk, tn, which;
        if (ti < 2304) { which = 0; W = p.in[6]; D = (bf16_t*)(p.ws + WS_WIN); N = IN_DIM; K = 1024; tk = ti / 144; tn = ti % 144; }
        else if (ti < 2560) { const int q = ti - 2304; which = 1; W = p.in[12]; D = (bf16_t*)(p.ws + WS_WO); N = 1024; K = 1024; tk = q / 16; tn = q % 16; }
        else if (ti < 3968) { const int q = ti - 2560; which = 2; W = p.in[15]; D = (bf16_t*)(p.ws + WS_WUP); N = 5632; K = 1024; tk = q / 88; tn = q % 88; }
        else { const int q = ti - 3968; which = 3; W = p.in[17]; D = (bf16_t*)(p.ws + WS_WD); N = 1024; K = 2816; tk = q / 16; tn = q % 16; }
        const int c = tid & 63, r8 = tid >> 6;
        const int np = tn * 64 + c, sc = which == 0 ? src_col_in(np) : np;
#pragma unroll
        for (int i = 0; i < 8; ++i) { const int r = r8 + 8 * i; t[r * 65 + c] = W[(size_t)(tk * 64 + r) * N + sc]; }
        __syncthreads();
#pragma unroll
        for (int i = 0; i < 8; ++i) { const int rr = r8 + 8 * i; D[(size_t)(tn * 64 + rr) * K + tk * 64 + c] = f2bf(t[c * 65 + rr]); }
        if (which == 3) { bf16_t* D2 = (bf16_t*)(p.ws + WS_WD2) + (size_t)(tk >= 22) * 1024 * 1408 + (size_t)(tn * 64) * 1408 + (tk >= 22 ? tk - 22 : tk) * 64 + c;
#pragma unroll
            for (int i = 0; i < 8; ++i) { const int rr = r8 + 8 * i; D2[(size_t)rr * 1408] = f2bf(t[c * 65 + rr]); } }
        __syncthreads();
    }
}

__device__ void stage_cvt(const Params& p, int s, LAS unsigned char* lds, int vid, int V) {
    LAS float* sW = (LAS float*)lds;
    const int tid = opaque_tid(), wid = tid >> 6, lane = tid & 63;
    for (int idx = tid; idx < 4096; idx += 512) { const int k = idx >> 2, q = idx & 3; const f32x4 wv4 = *(const f32x4*)(p.in[6] + (size_t)k * IN_DIM + 4096 + q * 4);
#pragma unroll
        for (int j = 0; j < 4; ++j) sW[(q * 4 + j) * 1024 + k] = wv4[j]; }
    __syncthreads();
    bf16_t* xb = (bf16_t*)(p.ws + WS_XB + (size_t)(s & 1) * SZ_XB);
    float* ab = (float*)(p.ws + WS_AB); float* stats = (float*)(p.ws + WS_STATS);
    const int rows = slab_rows(s);
    for (int lr = (vid * 8 + wid) * 2; lr < rows; lr += V * 16) {
        const int grow0 = grow_of(s, lr), grow1 = grow_of(s, lr + 1); const float* xr0 = xrow(p, grow0); const float* xr1 = xrow(p, grow1);
        f32x4 xa[4], xc[4];
#pragma unroll
        for (int i = 0; i < 4; ++i) { xa[i] = __builtin_nontemporal_load((const f32x4*)(xr0 + lane * 4 + 256 * i)); xc[i] = __builtin_nontemporal_load((const f32x4*)(xr1 + lane * 4 + 256 * i)); }
#pragma unroll
        for (int i = 0; i < 4; ++i) { u32x2 w; w.x = cvt_pk_bf16(xa[i][0], xa[i][1]); w.y = cvt_pk_bf16(xa[i][2], xa[i][3]); *(u32x2*)(xb + (size_t)lr * 1024 + lane * 4 + 256 * i) = w;
            w.x = cvt_pk_bf16(xc[i][0], xc[i][1]); w.y = cvt_pk_bf16(xc[i][2], xc[i][3]); *(u32x2*)(xb + (size_t)(lr + 1) * 1024 + lane * 4 + 256 * i) = w; }
        float a0[16], a1[16];
#pragma unroll
        for (int o = 0; o < 16; ++o) { f32x4 s0 = {0.f, 0.f, 0.f, 0.f}, s1 = {0.f, 0.f, 0.f, 0.f};
#pragma unroll
            for (int i = 0; i < 4; ++i) { const f32x4 wv = *(const LAS f32x4*)(sW + o * 1024 + lane * 4 + 256 * i); s0 += xa[i] * wv; s1 += xc[i] * wv; }
            a0[o] = (s0[0] + s0[1]) + (s0[2] + s0[3]); a1[o] = (s1[0] + s1[1]) + (s1[2] + s1[3]); if ((o & 3) == 3) __builtin_amdgcn_sched_barrier(0); }
#pragma unroll
        for (int o = 0; o < 8; ++o) { const bool hi = lane & 32; const float k0 = hi ? a0[o + 8] : a0[o], s0 = hi ? a0[o] : a0[o + 8], k1 = hi ? a1[o + 8] : a1[o], s1 = hi ? a1[o] : a1[o + 8];
            a0[o] = k0 + __shfl_xor(s0, 32); a1[o] = k1 + __shfl_xor(s1, 32); }
#pragma unroll
        for (int o = 0; o < 4; ++o) { const bool hi = lane & 16; const float k0 = hi ? a0[o + 4] : a0[o], s0 = hi ? a0[o] : a0[o + 4], k1 = hi ? a1[o + 4] : a1[o], s1 = hi ? a1[o] : a1[o + 4];
            a0[o] = k0 + __shfl_xor(s0, 16); a1[o] = k1 + __shfl_xor(s1, 16); }
#pragma unroll
        for (int o = 0; o < 2; ++o) { const bool hi = lane & 8; const float k0 = hi ? a0[o + 2] : a0[o], s0 = hi ? a0[o] : a0[o + 2], k1 = hi ? a1[o + 2] : a1[o], s1 = hi ? a1[o] : a1[o + 2];
            a0[o] = k0 + __shfl_xor(s0, 8); a1[o] = k1 + __shfl_xor(s1, 8); }
        { const bool hi = lane & 4; const float k0 = hi ? a0[1] : a0[0], s0 = hi ? a0[0] : a0[1], k1 = hi ? a1[1] : a1[0], s1 = hi ? a1[0] : a1[1];
            a0[0] = k0 + __shfl_xor(s0, 4); a1[0] = k1 + __shfl_xor(s1, 4); }
        a0[0] += __shfl_xor(a0[0], 1); a0[0] += __shfl_xor(a0[0], 2); a1[0] += __shfl_xor(a1[0], 1); a1[0] += __shfl_xor(a1[0], 2);
        if ((lane & 3) == 0) { const int o = ((lane >> 5) & 1) * 8 + ((lane >> 4) & 1) * 4 + ((lane >> 3) & 1) * 2 + ((lane >> 2) & 1); ab[(size_t)grow0 * 16 + o] = a0[0]; ab[(size_t)grow1 * 16 + o] = a1[0]; }
        if (lane < 4) { stats[(size_t)grow0 * 4 + lane] = 0.f; stats[(size_t)grow1 * 4 + lane] = 0.f; }
    }
}

constexpr int P_G = 0, P_BETA = 256, P_EG = 512, P_ET = 768, P_KB = 1024, P_QB = 18432, P_RT = 35840, P_ABF = 69632, P_ADIAG = 78336, P_TB = 82432;
constexpr int P_OW = 1024  , P_OU = 19456, P_OQD = 86016, P_OKT = 104448, P_OQK = 122880;
__device__ __forceinline__ int pslot(int chunk) { return (chunk + (chunk >> 3)) * 16; }
__device__ __forceinline__ bf16x8 mk8(unsigned a, unsigned b, unsigned c, unsigned d) { u32x4 v = {a, b, c, d}; return __builtin_bit_cast(bf16x8, v); }
__device__ void prep_unit(const Params& p, int s, int idx, LAS unsigned char* lds) {
    const int tid = opaque_tid(), wid = tid >> 6, lane = tid & 63;
    const bool sample = (s == 8);
    int h, lr0, grow0, ntok, recidx, hb  ; bool first, last;
    if (!sample) { const int b = idx >> 8, rem = idx & 255, c = rem >> 3; h = rem & 7; lr0 = b * 2048 + c * 64; grow0 = b * 16384 + s * 2048 + c * 64; ntok = 64; recidx = (b * 8 + h) * 32 + c; hb = b; first = (c == 0); last = (c == 31); }
    else { const int seq = idx >> 3; h = idx & 7; lr0 = seq * 16; grow0 = 32768 + seq * 16; ntok = 16; recidx = idx; hb = seq; first = true; last = true; }
    LAS float* sG = (LAS float*)(lds + P_G); LAS float* sBeta = (LAS float*)(lds + P_BETA); LAS float* sEG = (LAS float*)(lds + P_EG); LAS float* sET = (LAS float*)(lds + P_ET);
    unsigned char* rec = p.ws + WS_REC + (size_t)(s & 1) * SZ_REC + (size_t)recidx * REC_BYTES;
    const bf16_t* qkv = (const bf16_t*)(p.ws + WS_QKV + (size_t)(s & 1) * SZ_QKV);
    if (wid == 0) {
        const int t = lane; const bool v = t < ntok; const int gr = grow0 + (v ? t : 0);
        const float* ab = (const float*)(p.ws + WS_AB) + (size_t)gr * 16;
        const float bl = ab[h], al = ab[8 + h] + p.in[9][h];
        const float sp = al > 20.f ? al : log1pf(__expf(al));
        float g = v ? -__expf(p.in[8][h]) * sp : 0.f; const float beta = v ? sigmoidf_(bl) : 0.f;
#pragma unroll
        for (int d = 1; d < 64; d <<= 1) { const float o = __shfl_up(g, d); if (lane >= d) g += o; }
        const float gl = __shfl(g, 63);
        sG[t] = g; sBeta[t] = beta; sEG[t] = __expf(g); sET[t] = __expf(gl - g);
        if (lane == 0) *(float*)(rec + R_HDR) = __expf(gl);
    }
    __syncthreads();
    const float* cw = p.in[7];
#pragma unroll
    for (int it = 0; it < 3; ++it) {
        const int i = it * 512 + tid, o = i & 15, rest = i >> 4, tensor = rest % 3, tp = rest / 3, t0 = 2 * tp;
        const int cb = tensor * 1024 + h * 128 + o * 8;
        float x[5][8];
#pragma unroll
        for (int r = 0; r < 5; ++r) { const int t = t0 - 3 + r;
            if (t >= 0 || !first) { const u32x4 w = *(const u32x4*)(qkv + (size_t)(lr0 + t) * 3072 + cb);
                x[r][0] = bflo(w.x); x[r][1] = bfhi(w.x); x[r][2] = bflo(w.y); x[r][3] = bfhi(w.y); x[r][4] = bflo(w.z); x[r][5] = bfhi(w.z); x[r][6] = bflo(w.w); x[r][7] = bfhi(w.w); }
            else if (sample) { const float* hp = p.in[2] + ((size_t)hb * 3 + (3 + t)) * 3072 + cb;
#pragma unroll
                for (int k = 0; k < 8; ++k) x[r][k] = hp[k]; }
            else if (s == 0) {
#pragma unroll
                for (int k = 0; k < 8; ++k) x[r][k] = 0.f; }
            else { const float* hp = (const float*)(p.ws + WS_HQ + (size_t)((s - 1) & 1) * SZ_HQ) + ((size_t)hb * 3 + (3 + t)) * 3072 + cb;
#pragma unroll
                for (int k = 0; k < 8; ++k) x[r][k] = hp[k]; } }
        if (last && t0 + 1 == ntok - 1) {
#pragma unroll
            for (int r = 0; r < 3; ++r) {
                float* d1 = sample ? p.out + O_SGC + ((size_t)hb * 3 + r) * 3072 + cb : (float*)(p.ws + WS_HQ + (size_t)(s & 1) * SZ_HQ) + ((size_t)hb * 3 + r) * 3072 + cb;
#pragma unroll
                for (int k = 0; k < 8; ++k) d1[k] = x[2 + r][k];
                if (!sample && s == 7) { float* d2 = p.out + O_PGC + ((size_t)hb * 3 + r) * 3072 + cb;
#pragma unroll
                    for (int k = 0; k < 8; ++k) d2[k] = x[2 + r][k]; } } }
        f32x2_ yk[8]; f32x2_ ssv = {0.f, 0.f};
        float cw0[8], cw1[8], cw2[8], cw3[8];
        { const f32x4 q0 = *(const f32x4*)(cw + cb), q1 = *(const f32x4*)(cw + cb + 4), q2 = *(const f32x4*)(cw + 3072 + cb), q3 = *(const f32x4*)(cw + 3072 + cb + 4), q4 = *(const f32x4*)(cw + 6144 + cb), q5 = *(const f32x4*)(cw + 6144 + cb + 4), q6 = *(const f32x4*)(cw + 9216 + cb), q7 = *(const f32x4*)(cw + 9216 + cb + 4);
#pragma unroll
          for (int k = 0; k < 4; ++k) { cw0[k] = q0[k]; cw0[4 + k] = q1[k]; cw1[k] = q2[k]; cw1[4 + k] = q3[k]; cw2[k] = q4[k]; cw2[4 + k] = q5[k]; cw3[k] = q6[k]; cw3[4 + k] = q7[k]; } }
#pragma unroll
        for (int k = 0; k < 8; ++k) { const float w0 = cw0[k], w1 = cw1[k], w2 = cw2[k], w3 = cw3[k];
            f32x2_ ab = (f32x2_){x[0][k], x[1][k]} * w0 + (f32x2_){x[1][k], x[2][k]} * w1 + (f32x2_){x[2][k], x[3][k]} * w2 + (f32x2_){x[3][k], x[4][k]} * w3;
            f32x2_ ex; ex.x = __expf(-ab.x); ex.y = __expf(-ab.y); const f32x2_ den = ex + 1.0f; f32x2_ rc; rc.x = __builtin_amdgcn_rcpf(den.x); rc.y = __builtin_amdgcn_rcpf(den.y);
            ab = ab * rc; yk[k] = ab; ssv += ab * ab; }
        float ss0 = ssv.x, ss1 = ssv.y;
#pragma unroll
        for (int d = 1; d < 16; d <<= 1) { ss0 += __shfl_xor(ss0, d); ss1 += __shfl_xor(ss1, d); }
        const int t1 = t0 + 1; const bool v0 = t0 < ntok, v1 = t1 < ntok;
        f32x2_ mm;
        if (tensor == 0) { mm.x = rsqrtf(ss0 + 1e-6f) * 0.08838834764831845f; mm.y = rsqrtf(ss1 + 1e-6f) * 0.08838834764831845f; }
        else if (tensor == 1) { mm.x = rsqrtf(ss0 + 1e-6f); mm.y = rsqrtf(ss1 + 1e-6f); }
        else { mm.x = 1.f; mm.y = 1.f; }
        float y0[8], y1[8];
#pragma unroll
        for (int k = 0; k < 8; ++k) { f32x2_ q = yk[k] * mm; q.x = v0 ? q.x : 0.f; q.y = v1 ? q.y : 0.f; yk[k] = q; y0[k] = q.x; y1[k] = q.y; }
        const float b0 = sBeta[t0], b1 = sBeta[t1], eg0 = sEG[t0], eg1 = sEG[t1], et0 = sET[t0], et1 = sET[t1];
        const f32x2_ egv = {eg0, eg1}, etv = {et0, et1}, bv = {b0, b1}, begv = bv * egv;
        if (tensor == 0) {
            u32x4 w; w.x = cvt_pk_bf16(y0[0], y0[1]); w.y = cvt_pk_bf16(y0[2], y0[3]); w.z = cvt_pk_bf16(y0[4], y0[5]); w.w = cvt_pk_bf16(y0[6], y0[7]);
            *(LAS u32x4*)(lds + P_QB + t0 * 272 + o * 16) = w;
            w.x = cvt_pk_bf16(y1[0], y1[1]); w.y = cvt_pk_bf16(y1[2], y1[3]); w.z = cvt_pk_bf16(y1[4], y1[5]); w.w = cvt_pk_bf16(y1[6], y1[7]);
            *(LAS u32x4*)(lds + P_QB + t1 * 272 + o * 16) = w;
            const int kb = o >> 2, oo = o & 3, half = oo >> 1, g0 = (oo & 1) * 2;
#pragma unroll
            for (int tt = 0; tt < 2; ++tt) { const int t = t0 + tt; const float e = tt ? eg1 : eg0; const float* yy = tt ? y1 : y0; const int mt = t >> 4, m = t & 15;
                const int ck = (mt * 4 + kb) * 64 + g0 * 16 + m;
                u32x2 a; a.x = cvt_pk_bf16(yy[0] * e, yy[1] * e); a.y = cvt_pk_bf16(yy[2] * e, yy[3] * e); *(LAS u32x2*)(lds + P_OQD + pslot(ck) + half * 8) = a;
                a.x = cvt_pk_bf16(yy[4] * e, yy[5] * e); a.y = cvt_pk_bf16(yy[6] * e, yy[7] * e); *(LAS u32x2*)(lds + P_OQD + pslot(ck + 16) + half * 8) = a; }
        } else if (tensor == 1) {
            u32x4 w; w.x = cvt_pk_bf16(y0[0], y0[1]); w.y = cvt_pk_bf16(y0[2], y0[3]); w.z = cvt_pk_bf16(y0[4], y0[5]); w.w = cvt_pk_bf16(y0[6], y0[7]);
            *(LAS u32x4*)(lds + P_KB + t0 * 272 + o * 16) = w;
            w.x = cvt_pk_bf16(y1[0], y1[1]); w.y = cvt_pk_bf16(y1[2], y1[3]); w.z = cvt_pk_bf16(y1[4], y1[5]); w.w = cvt_pk_bf16(y1[6], y1[7]);
            *(LAS u32x4*)(lds + P_KB + t1 * 272 + o * 16) = w;
            const int dt = o >> 1, kb = t0 >> 5, r = t0 & 31, half = r >> 4, rr = r & 15, gp = rr >> 2, ep = half * 4 + (rr & 3);
#pragma unroll
            for (int k = 0; k < 8; ++k) { const int m = (o & 1) * 8 + k;
                const f32x2_ r1 = yk[k] * begv, r2 = yk[k] * etv;
                *(LAS unsigned*)(lds + P_RT + (128 + o * 8 + k) * 132 + t0 * 2) = cvt_pk_bf16(r1.x, r1.y);
                *(LAS unsigned*)(lds + P_OKT + pslot((dt * 2 + kb) * 64 + gp * 16 + m) + ep * 2) = cvt_pk_bf16(r2.x, r2.y); }
        } else {
#pragma unroll
            for (int k = 0; k < 8; ++k) { const f32x2_ r1 = yk[k] * bv; *(LAS unsigned*)(lds + P_RT + (o * 8 + k) * 132 + t0 * 2) = cvt_pk_bf16(r1.x, r1.y); }
        }
    }
    __syncthreads();
    const int n = lane & 15, g = lane >> 4;
    {
        const int itile = wid >> 1;
        bf16x8 ak[4], aq[4];
#pragma unroll
        for (int kb = 0; kb < 4; ++kb) { ak[kb] = *(const LAS bf16x8*)(lds + P_KB + (itile * 16 + n) * 272 + kb * 64 + g * 16); aq[kb] = *(const LAS bf16x8*)(lds + P_QB + (itile * 16 + n) * 272 + kb * 64 + g * 16); }
#pragma unroll
        for (int jj = 0; jj < 2; ++jj) { const int jt = (wid & 1) * 2 + jj;
            f32x4 ckk = {0.f, 0.f, 0.f, 0.f}, cqk = {0.f, 0.f, 0.f, 0.f};
#pragma unroll
            for (int kb = 0; kb < 4; ++kb) { const bf16x8 bk = *(const LAS bf16x8*)(lds + P_KB + (jt * 16 + n) * 272 + kb * 64 + g * 16);
                ckk = __builtin_amdgcn_mfma_f32_16x16x32_bf16(ak[kb], bk, ckk, 0, 0, 0); cqk = __builtin_amdgcn_mfma_f32_16x16x32_bf16(aq[kb], bk, cqk, 0, 0, 0); }
            const int j = jt * 16 + n; const float Gj = sG[j];
#pragma unroll
            for (int e = 0; e < 4; ++e) { const int i = itile * 16 + 4 * g + e; const float dd = fminf(sG[i] - Gj, 0.f), ex = __expf(dd);
                const float av = (j < i) ? sBeta[i] * ckk[e] * ex : 0.f, qv = (j <= i) ? cqk[e] * ex : 0.f;
                *(LAS bf16_t*)(lds + P_ABF + i * 136 + j * 2) = f2bf(-av);
                if (itile == jt) *(LAS float*)(lds + P_ADIAG + ((itile * 16 + 4 * g + e) * 16 + n) * 4) = av;
                const int kb2 = jt >> 1, half = jt & 1, gp = n >> 2, ep = half * 4 + (n & 3), m = 4 * g + e;
                *(LAS bf16_t*)(lds + P_OQK + pslot((itile * 2 + kb2) * 64 + gp * 16 + m) + ep * 2) = f2bf(qv); }
        }
    }
    __syncthreads();
    if (wid == 0) {
        const int blk = lane >> 4, c = lane & 15; const LAS float* A = (const LAS float*)(lds + P_ADIAG) + blk * 256;
        float T[16];
#pragma unroll
        for (int r = 0; r < 16; ++r) { float a = (r == c) ? 1.f : 0.f;
#pragma unroll
            for (int jx = 0; jx < r; ++jx) a -= A[r * 16 + jx] * T[jx];
            T[r] = a; }
#pragma unroll
        for (int r = 0; r < 16; ++r) *(LAS bf16_t*)(lds + P_TB + (blk * 16 + r) * 40 + c * 2) = f2bf(T[r]);
    }
    __syncthreads();
    {
        bf16x8 Xop[2][2];
#pragma unroll
        for (int a = 0; a < 2; ++a)
#pragma unroll
            for (int b = 0; b < 2; ++b) Xop[a][b] = mk8(0u, 0u, 0u, 0u);
        unsigned xw[2][2][4];
#pragma unroll
        for (int a = 0; a < 2; ++a)
#pragma unroll
            for (int b = 0; b < 2; ++b)
#pragma unroll
                for (int c = 0; c < 4; ++c) xw[a][b][c] = 0u;
#pragma unroll
        for (int blk = 0; blk < 4; ++blk) {
            f32x4 acc[2];
#pragma unroll
            for (int ct = 0; ct < 2; ++ct) { const int f = 32 * wid + 16 * ct + n; const LAS unsigned* rp = (const LAS unsigned*)(lds + P_RT + f * 132 + 32 * blk + 8 * g);
                const unsigned r0 = rp[0], r1 = rp[1]; acc[ct] = (f32x4){bflo(r0), bfhi(r0), bflo(r1), bfhi(r1)}; }
            if (blk >= 1) { const LAS unsigned char* ap = lds + P_ABF + (blk * 16 + n) * 136 + 8 * g; const u32x2 a0 = *(const LAS u32x2*)ap, a1 = *(const LAS u32x2*)(ap + 32);
                const bf16x8 A = mk8(a0.x, a0.y, a1.x, a1.y);
#pragma unroll
                for (int ct = 0; ct < 2; ++ct) acc[ct] = __builtin_amdgcn_mfma_f32_16x16x32_bf16(A, mk8(xw[0][ct][0], xw[0][ct][1], xw[0][ct][2], xw[0][ct][3]), acc[ct], 0, 0, 0); }
            if (blk == 3) { const LAS unsigned char* ap = lds + P_ABF + (blk * 16 + n) * 136 + 64 + 8 * g; const u32x2 a0 = *(const LAS u32x2*)ap, a1 = *(const LAS u32x2*)(ap + 32);
                const bf16x8 A = mk8(a0.x, a0.y, a1.x, a1.y);
#pragma unroll
                for (int ct = 0; ct < 2; ++ct) acc[ct] = __builtin_amdgcn_mfma_f32_16x16x32_bf16(A, mk8(xw[1][ct][0], xw[1][ct][1], xw[1][ct][2], xw[1][ct][3]), acc[ct], 0, 0, 0); }
            const u32x2 tv = *(const LAS u32x2*)(lds + P_TB + (blk * 16 + n) * 40 + 8 * g);
            const bf16x8 Top = mk8(tv.x, tv.y, 0u, 0u);
#pragma unroll
            for (int ct = 0; ct < 2; ++ct) {
                const bf16x8 Yop = mk8(cvt_pk_bf16(acc[ct][0], acc[ct][1]), cvt_pk_bf16(acc[ct][2], acc[ct][3]), 0u, 0u);
                f32x4 x = {0.f, 0.f, 0.f, 0.f}; x = __builtin_amdgcn_mfma_f32_16x16x32_bf16(Top, Yop, x, 0, 0, 0);
                const unsigned p0 = cvt_pk_bf16(x[0], x[1]), p1 = cvt_pk_bf16(x[2], x[3]);
                xw[blk >> 1][ct][(blk & 1) * 2] = p0; xw[blk >> 1][ct][(blk & 1) * 2 + 1] = p1;
                if (wid < 4) { const int wv = 2 * wid + ct; u32x2 st; st.x = p0; st.y = p1; *(LAS u32x2*)(lds + P_OU + ((wv * 4 + blk) * 64 + lane) * 8) = st; }
                else { const int kbp = wid - 4, gp = n >> 2, ep = ct * 4 + (n & 3);
#pragma unroll
                    for (int e = 0; e < 4; ++e) { const int mp = 4 * g + e; *(LAS bf16_t*)(lds + P_OW + pslot((blk * 4 + kbp) * 64 + gp * 16 + mp) + ep * 2) = f2bf(-x[e]); } }
            }
        }
        (void)Xop;
    }
    __syncthreads();
#pragma unroll
    for (int i = 0; i < 9; ++i) { const int c = i * 512 + tid;
        int off; if (i < 2) off = P_OW + pslot(c); else if (i < 4) off = P_OQD + pslot(c - 1024); else if (i < 6) off = P_OKT + pslot(c - 2048); else if (i < 7) off = P_OQK + pslot(c - 3072); else off = P_OU + (c - 3584) * 16;
        *(u32x4*)(rec + (size_t)c * 16) = *(const LAS u32x4*)(lds + off); }
    __syncthreads();
}
__device__ void stage_prep(const Params& p, int s, LAS unsigned char* lds, int vid, int V) {
    const int nu = s < 8 ? 512 : 256;
    for (int idx = vid; idx < nu; idx += V) prep_unit(p, s, idx, lds);
}

__device__ void scan_chain(const Params& p, int s, int chain, LAS unsigned char* lds) {
    const int tid = opaque_tid(), wv = tid >> 6, lane = tid & 63, n = lane & 15, g = lane >> 4;
    const bool sample = (s == 8);
    int h, lr0, nch, ntok; const unsigned char* rec; const float* Sin; float* Sout;
    if (!sample) { const int b = chain >> 3; h = chain & 7; lr0 = b * 2048; nch = 32; ntok = 64; rec = p.ws + WS_REC + (size_t)(s & 1) * SZ_REC + (size_t)chain * 32 * REC_BYTES;
        Sout = p.out + O_PS + (size_t)chain * 16384; Sin = s == 0 ? nullptr : Sout; }
    else { const int seq = chain >> 3; h = chain & 7; lr0 = seq * 16; nch = 1; ntok = 16; rec = p.ws + WS_REC + (size_t)(s & 1) * SZ_REC + (size_t)chain * REC_BYTES;
        Sin = p.in[3] + (size_t)chain * 16384; Sout = p.out + O_SS + (size_t)chain * 16384; }
    bf16_t* orow = (bf16_t*)(p.ws + WS_ORAW + (size_t)(s & 1) * SZ_G1) + (size_t)(lr0 + lane) * 1024 + h * 128 + wv * 16;
    f32x4 S[8];
#pragma unroll
    for (int dt = 0; dt < 8; ++dt) S[dt] = (f32x4){0.f, 0.f, 0.f, 0.f};
    if (Sin) {
#pragma unroll
        for (int i = 0; i < 8; ++i) *(LAS u32x4*)(lds + (i * 512 + tid) * 16) = *(const u32x4*)((const unsigned char*)Sin + (size_t)(i * 512 + tid) * 16);
        __syncthreads();
        const LAS float* sp = (const LAS float*)lds + (4 * g) * 128 + wv * 16 + n;
#pragma unroll
        for (int dt = 0; dt < 8; ++dt)
#pragma unroll
            for (int e = 0; e < 4; ++e) S[dt][e] = sp[(dt * 16 + e) * 128];
        __syncthreads();
    }
    u32x4 pre[9];
#pragma unroll
    for (int i = 0; i < 9; ++i) pre[i] = *(const u32x4*)(rec + (size_t)(i * 512 + tid) * 16);
#pragma unroll
    for (int i = 0; i < 9; ++i) *(LAS u32x4*)(lds + (i * 512 + tid) * 16) = pre[i];
    __syncthreads();
#pragma unroll 1
    for (int c = 0; c < nch; ++c) {
        const unsigned char* rc = rec + (size_t)c * REC_BYTES;
        const bool more = c + 1 < nch;
        if (more) {
#pragma unroll
            for (int i = 0; i < 9; ++i) pre[i] = *(const u32x4*)(rc + REC_BYTES + (size_t)(i * 512 + tid) * 16); }
        const float gamma = *(const float*)(rc + R_HDR);
        const LAS unsigned char* cur = lds + (c & 1) * 73728;
        bf16x8 Sop[4];
#pragma unroll
        for (int kb = 0; kb < 4; ++kb) Sop[kb] = mk8(cvt_pk_bf16(S[2 * kb][0], S[2 * kb][1]), cvt_pk_bf16(S[2 * kb][2], S[2 * kb][3]), cvt_pk_bf16(S[2 * kb + 1][0], S[2 * kb + 1][1]), cvt_pk_bf16(S[2 * kb + 1][2], S[2 * kb + 1][3]));
        f32x4 vn[4], oa[4];
#pragma unroll
        for (int mt = 0; mt < 4; ++mt) { const u32x2 uu = *(const LAS u32x2*)(cur + R_U + ((wv * 4 + mt) * 64 + lane) * 8);
            f32x4 a = {bflo(uu.x), bfhi(uu.x), bflo(uu.y), bfhi(uu.y)}; f32x4 o = {0.f, 0.f, 0.f, 0.f};
#pragma unroll
            for (int kb = 0; kb < 4; ++kb) { const bf16x8 wf = *(const LAS bf16x8*)(cur + R_W + ((mt * 4 + kb) * 64 + lane) * 16); const bf16x8 qf = *(const LAS bf16x8*)(cur + R_QD + ((mt * 4 + kb) * 64 + lane) * 16);
                a = __builtin_amdgcn_mfma_f32_16x16x32_bf16(wf, Sop[kb], a, 0, 0, 0); o = __builtin_amdgcn_mfma_f32_16x16x32_bf16(qf, Sop[kb], o, 0, 0, 0); }
            vn[mt] = a; oa[mt] = o; __builtin_amdgcn_sched_barrier(0); }
        bf16x8 Vop[2];
#pragma unroll
        for (int kb = 0; kb < 2; ++kb) Vop[kb] = mk8(cvt_pk_bf16(vn[2 * kb][0], vn[2 * kb][1]), cvt_pk_bf16(vn[2 * kb][2], vn[2 * kb][3]), cvt_pk_bf16(vn[2 * kb + 1][0], vn[2 * kb + 1][1]), cvt_pk_bf16(vn[2 * kb + 1][2], vn[2 * kb + 1][3]));
#pragma unroll
        for (int mt = 0; mt < 4; ++mt) {
#pragma unroll
            for (int kb = 0; kb < 2; ++kb) { const bf16x8 qk = *(const LAS bf16x8*)(cur + R_QK + ((mt * 2 + kb) * 64 + lane) * 16); oa[mt] = __builtin_amdgcn_mfma_f32_16x16x32_bf16(qk, Vop[kb], oa[mt], 0, 0, 0); }
            { LAS unsigned char* wreg = (LAS unsigned char*)cur + R_U + wv * 2048 + (mt * 16 + 4 * g) * 32 + n * 2;
#pragma unroll
              for (int e = 0; e < 4; ++e) *(LAS bf16_t*)(wreg + e * 32) = f2bf(oa[mt][e]); }
            __builtin_amdgcn_sched_barrier(0); }
        { const LAS unsigned char* wreg = cur + R_U + wv * 2048 + lane * 32; const u32x4 o0 = *(const LAS u32x4*)wreg, o1 = *(const LAS u32x4*)(wreg + 16);
          if (lane < ntok) { bf16_t* op = orow + (size_t)c * 64 * 1024; *(u32x4*)op = o0; *(u32x4*)(op + 8) = o1; } }
#pragma unroll
        for (int dt = 0; dt < 8; ++dt) { S[dt] *= gamma;
#pragma unroll
            for (int kb = 0; kb < 2; ++kb) { const bf16x8 kf = *(const LAS bf16x8*)(cur + R_KT + ((dt * 2 + kb) * 64 + lane) * 16); S[dt] = __builtin_amdgcn_mfma_f32_16x16x32_bf16(kf, Vop[kb], S[dt], 0, 0, 0); } if (dt & 1) __builtin_amdgcn_sched_barrier(0); }
        if (more) {
#pragma unroll
            for (int i = 0; i < 9; ++i) *(LAS u32x4*)(lds + ((c + 1) & 1) * 73728 + (i * 512 + tid) * 16) = pre[i]; }
        __syncthreads();
    }
    {
        LAS float* sp = (LAS float*)lds + (4 * g) * 128 + wv * 16 + n;
#pragma unroll
        for (int dt = 0; dt < 8; ++dt)
#pragma unroll
            for (int e = 0; e < 4; ++e) sp[(dt * 16 + e) * 128] = S[dt][e];
        __syncthreads();
#pragma unroll
        for (int i = 0; i < 8; ++i) *(u32x4*)((unsigned char*)Sout + (size_t)(i * 512 + tid) * 16) = *(const LAS u32x4*)(lds + (i * 512 + tid) * 16);
    }
}
__device__ void stage_scan(const Params& p, int s, LAS unsigned char* lds) {
    const int G = gridDim.x;
    if (s < 8) { const int j = G - 1 - (int)blockIdx.x; for (int ch = j; ch < 16; ch += G) { scan_chain(p, s, ch, lds); __syncthreads(); } }
    else { for (int ch = blockIdx.x; ch < 256; ch += G) { scan_chain(p, s, ch, lds); __syncthreads(); } }
}

__device__ void stage_merge(const Params& p, int s, int vid, int V) {
    const int tid = opaque_tid(), wid = tid >> 6, lane = tid & 63;
    const bool sample = (s == 8); const int rows = slab_rows(s);
    const bf16_t* oraw = (const bf16_t*)(p.ws + WS_ORAW + (size_t)(s & 1) * SZ_G1);
    const bf16_t* gE = (const bf16_t*)(p.ws + WS_GATE + (size_t)(s & 3) * SZ_GATE); const bf16_t* gR = gE + (size_t)4096 * 1024; const bf16_t* gP = gR + (size_t)4096 * 1024;
    bf16_t* mix = (bf16_t*)(p.ws + WS_MIX + (size_t)(s & 1) * SZ_G1);
    const float* scw = p.in[11];
    const int nitem = (rows >> 2) * 2;
    for (int it = vid * 8 + wid; it < nitem; it += V * 8) {
        const int lr0 = (it >> 1) * 4, ch = ((it & 1) * 64 + lane) * 8;
        const int hb = sample ? (lr0 >> 4) : (lr0 >> 11), tl0 = sample ? (lr0 & 15) : (lr0 & 2047), tlast = sample ? 15 : 2047;
        float w0[8], w1[8], w2[8], pm2[8], pm1[8];
        { const f32x4 q0 = *(const f32x4*)(scw + ch), q1 = *(const f32x4*)(scw + ch + 4), q2 = *(const f32x4*)(scw + 1024 + ch), q3 = *(const f32x4*)(scw + 1024 + ch + 4), q4 = *(const f32x4*)(scw + 2048 + ch), q5 = *(const f32x4*)(scw + 2048 + ch + 4);
#pragma unroll
          for (int k = 0; k < 4; ++k) { w0[k] = q0[k]; w0[4 + k] = q1[k]; w1[k] = q2[k]; w1[4 + k] = q3[k]; w2[k] = q4[k]; w2[4 + k] = q5[k]; } }
        if (tl0 > 0) { const u32x4 u0 = *(const u32x4*)(gP + (size_t)(lr0 - 2) * 1024 + ch), u1 = *(const u32x4*)(gP + (size_t)(lr0 - 1) * 1024 + ch);
            pm2[0] = bflo(u0.x); pm2[1] = bfhi(u0.x); pm2[2] = bflo(u0.y); pm2[3] = bfhi(u0.y); pm2[4] = bflo(u0.z); pm2[5] = bfhi(u0.z); pm2[6] = bflo(u0.w); pm2[7] = bfhi(u0.w);
            pm1[0] = bflo(u1.x); pm1[1] = bfhi(u1.x); pm1[2] = bflo(u1.y); pm1[3] = bfhi(u1.y); pm1[4] = bflo(u1.z); pm1[5] = bfhi(u1.z); pm1[6] = bflo(u1.w); pm1[7] = bfhi(u1.w); }
        else { const float* hp = sample ? p.in[4] + (size_t)hb * 2 * 1024 + ch : (s == 0 ? nullptr : (const float*)(p.ws + WS_HS + (size_t)((s - 1) & 1) * SZ_HS) + (size_t)hb * 2 * 1024 + ch);
#pragma unroll
            for (int k = 0; k < 8; ++k) { pm2[k] = hp ? hp[k] : 0.f; pm1[k] = hp ? hp[1024 + k] : 0.f; } }
#pragma unroll
        for (int r = 0; r < 4; ++r) { const int lr = lr0 + r;
            const u32x4 ow = *(const u32x4*)(oraw + (size_t)lr * 1024 + ch);
            const float o[8] = {bflo(ow.x), bfhi(ow.x), bflo(ow.y), bfhi(ow.y), bflo(ow.z), bfhi(ow.z), bflo(ow.w), bfhi(ow.w)};
            float ss = 0.f;
#pragma unroll
            for (int k = 0; k < 8; ++k) ss += o[k] * o[k];
#pragma unroll
            for (int d = 1; d < 16; d <<= 1) ss += __shfl_xor(ss, d);
            const float rstd = rsqrtf(ss * (1.0f / 128.0f) + 1e-6f);
            const u32x4 ew = __builtin_nontemporal_load((const u32x4*)(gE + (size_t)lr * 1024 + ch)), rw = __builtin_nontemporal_load((const u32x4*)(gR + (size_t)lr * 1024 + ch)), pw = *(const u32x4*)(gP + (size_t)lr * 1024 + ch);
            const float E[8] = {bflo(ew.x), bfhi(ew.x), bflo(ew.y), bfhi(ew.y), bflo(ew.z), bfhi(ew.z), bflo(ew.w), bfhi(ew.w)};
            const float R[8] = {bflo(rw.x), bfhi(rw.x), bflo(rw.y), bfhi(rw.y), bflo(rw.z), bfhi(rw.z), bflo(rw.w), bfhi(rw.w)};
            const float P[8] = {bflo(pw.x), bfhi(pw.x), bflo(pw.y), bfhi(pw.y), bflo(pw.z), bfhi(pw.z), bflo(pw.w), bfhi(pw.w)};
            float m[8];
#pragma unroll
            for (int k = 0; k < 8; k += 2) { const f32x2_ c3 = (f32x2_){w0[k], w0[k + 1]} * (f32x2_){pm2[k], pm2[k + 1]} + (f32x2_){w1[k], w1[k + 1]} * (f32x2_){pm1[k], pm1[k + 1]} + (f32x2_){w2[k], w2[k + 1]} * (f32x2_){P[k], P[k + 1]};
                const f32x2_ mm = (f32x2_){o[k], o[k + 1]} * rstd * (f32x2_){E[k], E[k + 1]} + (f32x2_){R[k], R[k + 1]} * c3; m[k] = mm.x; m[k + 1] = mm.y; pm2[k] = pm1[k]; pm2[k + 1] = pm1[k + 1]; pm1[k] = P[k]; pm1[k + 1] = P[k + 1]; }
            u32x4 w; w.x = cvt_pk_bf16(m[0], m[1]); w.y = cvt_pk_bf16(m[2], m[3]); w.z = cvt_pk_bf16(m[4], m[5]); w.w = cvt_pk_bf16(m[6], m[7]);
            *(u32x4*)(mix + (size_t)lr * 1024 + ch) = w; }
        if (tl0 + 3 == tlast) {
            float* d1 = sample ? p.out + O_SSC + (size_t)hb * 2 * 1024 + ch : (float*)(p.ws + WS_HS + (size_t)(s & 1) * SZ_HS) + (size_t)hb * 2 * 1024 + ch;
#pragma unroll
            for (int k = 0; k < 8; ++k) { d1[k] = pm2[k]; d1[1024 + k] = pm1[k]; }
            if (!sample && s == 7) { float* d2 = p.out + O_PSC + (size_t)hb * 2 * 1024 + ch;
#pragma unroll
                for (int k = 0; k < 8; ++k) { d2[k] = pm2[k]; d2[1024 + k] = pm1[k]; } } }
    }
}

__device__ void stage_ln(const Params& p, int s, int which, int vid, int V) {
    const int tid = opaque_tid(), wid = tid >> 6, lane = tid & 63; const int rows = slab_rows(s);
    const float* gam = p.in[which ? 18 : 13]; const float* bet = p.in[which ? 19 : 14];
    const float* stats = (const float*)(p.ws + WS_STATS); bf16_t* x1b = (bf16_t*)(p.ws + WS_X1B + (size_t)(s & 3) * SZ_G1);
    const bf16_t* pre1 = (const bf16_t*)(p.ws + (which ? WS_PRE2 : WS_PRE1) + (size_t)(s & 1) * SZ_G1);
    for (int lr = vid * 8 + wid; lr < rows; lr += V * 8) {
        const int grow = grow_of(s, lr); float* yp = p.out + O_YP + (size_t)grow * 1024;
        f32x4 v[4];
#pragma unroll
        for (int i = 0; i < 4; ++i) { const u32x2 q = __builtin_nontemporal_load((const u32x2*)(pre1 + (size_t)lr * 1024 + lane * 4 + 256 * i)); v[i] = (f32x4){bflo(q.x), bfhi(q.x), bflo(q.y), bfhi(q.y)}; }
        float mu, rstd;
        if (which && s >= SPLIT_FROM) {
            const bf16_t* p2 = (const bf16_t*)(p.ws + WS_PRE2B + (size_t)(s & 1) * SZ_G1) + (size_t)lr * 1024; float sm = 0.f;
#pragma unroll
            for (int i = 0; i < 4; ++i) { const u32x2 q = *(const u32x2*)(p2 + lane * 4 + 256 * i); v[i] += (f32x4){bflo(q.x), bfhi(q.x), bflo(q.y), bfhi(q.y)}; sm += (v[i][0] + v[i][1]) + (v[i][2] + v[i][3]); }
#pragma unroll
            for (int d = 32; d >= 1; d >>= 1) sm += __shfl_xor(sm, d);
            mu = sm * (1.0f / 1024.0f); float sq = 0.f;
#pragma unroll
            for (int i = 0; i < 4; ++i) { const f32x4 dv = v[i] - mu; sq += (dv[0] * dv[0] + dv[1] * dv[1]) + (dv[2] * dv[2] + dv[3] * dv[3]); }
#pragma unroll
            for (int d = 32; d >= 1; d >>= 1) sq += __shfl_xor(sq, d);
            rstd = rsqrtf(sq * (1.0f / 1024.0f) + 1e-5f);
        } else {
            const float sm = stats[(size_t)grow * 4 + which * 2], sq = stats[(size_t)grow * 4 + which * 2 + 1];
            mu = sm * (1.0f / 1024.0f); const float var = fmaxf(sq * (1.0f / 1024.0f) - mu * mu, 0.f); rstd = rsqrtf(var + 1e-5f);
        }
#pragma unroll
        for (int i = 0; i < 4; ++i) { const int c = lane * 4 + 256 * i; const f32x4 gg = *(const f32x4*)(gam + c), bb = *(const f32x4*)(bet + c);
            const f32x4 o = (v[i] - mu) * rstd * gg + bb;
            if (which) __builtin_nontemporal_store(o, (f32x4*)(yp + c)); else { u32x2 w; w.x = cvt_pk_bf16(o[0], o[1]); w.y = cvt_pk_bf16(o[2], o[3]); *(u32x2*)(x1b + (size_t)lr * 1024 + c) = w; } }
    }
}

__device__ void stage_glu(const Params& p, int s, int vid, int V) {
    const bool sample = (s == 8); const int rows = slab_rows(s);
    const bf16_t* av = (const bf16_t*)(p.ws + WS_AV + (size_t)(s & 1) * SZ_AV); bf16_t* hh = (bf16_t*)(p.ws + WS_H + (size_t)(s & 1) * SZ_H);
    const float* fw = p.in[16];
    const int total = (rows >> 3) * 352;
    const int tid = opaque_tid();
    for (int it = vid * 512 + tid; it < total; it += V * 512) {
        const int blk = it / 352, oc = it - blk * 352, ch = oc * 8, lr0 = blk * 8;
        const int hb = sample ? (lr0 >> 4) : (lr0 >> 11), tl0 = sample ? (lr0 & 15) : (lr0 & 2047), tlast = sample ? 15 : 2047;
        float w0[8], w1[8], w2[8], am2[8], am1[8];
        { const f32x4 q0 = *(const f32x4*)(fw + ch), q1 = *(const f32x4*)(fw + ch + 4), q2 = *(const f32x4*)(fw + 2816 + ch), q3 = *(const f32x4*)(fw + 2816 + ch + 4), q4 = *(const f32x4*)(fw + 5632 + ch), q5 = *(const f32x4*)(fw + 5632 + ch + 4);
#pragma unroll
          for (int k = 0; k < 4; ++k) { w0[k] = q0[k]; w0[4 + k] = q1[k]; w1[k] = q2[k]; w1[4 + k] = q3[k]; w2[k] = q4[k]; w2[4 + k] = q5[k]; } }
        if (tl0 > 0) { const u32x4 u0 = *(const u32x4*)(av + (size_t)(lr0 - 2) * 5632 + ch), u1 = *(const u32x4*)(av + (size_t)(lr0 - 1) * 5632 + ch);
            am2[0] = bflo(u0.x); am2[1] = bfhi(u0.x); am2[2] = bflo(u0.y); am2[3] = bfhi(u0.y); am2[4] = bflo(u0.z); am2[5] = bfhi(u0.z); am2[6] = bflo(u0.w); am2[7] = bfhi(u0.w);
            am1[0] = bflo(u1.x); am1[1] = bfhi(u1.x); am1[2] = bflo(u1.y); am1[3] = bfhi(u1.y); am1[4] = bflo(u1.z); am1[5] = bfhi(u1.z); am1[6] = bflo(u1.w); am1[7] = bfhi(u1.w); }
        else { const float* hp = sample ? p.in[5] + (size_t)hb * 2 * 2816 + ch : (s == 0 ? nullptr : (const float*)(p.ws + WS_HF + (size_t)((s - 1) & 1) * SZ_HF) + (size_t)hb * 2 * 2816 + ch);
#pragma unroll
            for (int k = 0; k < 8; ++k) { am2[k] = hp ? hp[k] : 0.f; am1[k] = hp ? hp[2816 + k] : 0.f; } }
#pragma unroll
        for (int r = 0; r < 8; ++r) {
            const u32x4 aw = *(const u32x4*)(av + (size_t)(lr0 + r) * 5632 + ch), vw = *(const u32x4*)(av + (size_t)(lr0 + r) * 5632 + 2816 + ch);
            const float a[8] = {bflo(aw.x), bfhi(aw.x), bflo(aw.y), bfhi(aw.y), bflo(aw.z), bfhi(aw.z), bflo(aw.w), bfhi(aw.w)};
            const float v[8] = {bflo(vw.x), bfhi(vw.x), bflo(vw.y), bfhi(vw.y), bflo(vw.z), bfhi(vw.z), bflo(vw.w), bfhi(vw.w)};
            float o[8];
#pragma unroll
            for (int k = 0; k < 8; k += 2) { const f32x2_ c3 = (f32x2_){w0[k], w0[k + 1]} * (f32x2_){am2[k], am2[k + 1]} + (f32x2_){w1[k], w1[k + 1]} * (f32x2_){am1[k], am1[k + 1]} + (f32x2_){w2[k], w2[k + 1]} * (f32x2_){a[k], a[k + 1]};
                const f32x2_ g2 = gelu_pk(c3) * (f32x2_){v[k], v[k + 1]}; o[k] = g2.x; o[k + 1] = g2.y; am2[k] = am1[k]; am2[k + 1] = am1[k + 1]; am1[k] = a[k]; am1[k + 1] = a[k + 1]; }
            u32x4 w; w.x = cvt_pk_bf16(o[0], o[1]); w.y = cvt_pk_bf16(o[2], o[3]); w.z = cvt_pk_bf16(o[4], o[5]); w.w = cvt_pk_bf16(o[6], o[7]);
            if (s >= SPLIT_FROM) *(u32x4*)(hh + (size_t)(ch >= 1408) * 4096 * 1408 + (size_t)(lr0 + r) * 1408 + (ch >= 1408 ? ch - 1408 : ch)) = w;
            else *(u32x4*)(hh + (size_t)(lr0 + r) * 2816 + ch) = w;
        }
        if (tl0 + 7 == tlast) {
            float* d1 = sample ? p.out + O_SFF + (size_t)hb * 2 * 2816 + ch : (float*)(p.ws + WS_HF + (size_t)(s & 1) * SZ_HF) + (size_t)hb * 2 * 2816 + ch;
#pragma unroll
            for (int k = 0; k < 8; ++k) { d1[k] = am2[k]; d1[2816 + k] = am1[k]; }
            if (!sample && s == 7) { float* d2 = p.out + O_PFF + (size_t)hb * 2 * 2816 + ch;
#pragma unroll
                for (int k = 0; k < 8; ++k) { d2[k] = am2[k]; d2[2816 + k] = am1[k]; } } }
    }
}

#define XB_TMO      128
#define XB_XCNT(j)  (256  + 64 * (j))
#define XB_XSUB(j)  (1280 + 64 * (j))
#define XB_XGEN(j)  (2304 + 64 * (j))
#define XB_TOP      3328
#define XB_TOPGEN   3392
#define XCD_BAR_WORDS 3456
#define XB_SPIN_CAP (1u << 22)
__device__ __forceinline__ unsigned xb_ld(unsigned* p)              { return __hip_atomic_load(p, __ATOMIC_RELAXED, __HIP_MEMORY_SCOPE_AGENT); }
__device__ __forceinline__ unsigned xb_add(unsigned* p, unsigned v) { return __hip_atomic_fetch_add(p, v, __ATOMIC_RELAXED, __HIP_MEMORY_SCOPE_AGENT); }
__device__ __forceinline__ unsigned xb_xcc_id() { return (unsigned)__builtin_amdgcn_s_getreg((3 << 11) | 20) & 0xFu; }
#define XB_SPIN(cond, bar) do { unsigned _sp = 0; while (cond) { __builtin_amdgcn_s_sleep(1); \
    if ((++_sp & 255u) == 0u) { if (xb_ld(&(bar)[XB_TMO])) break; if (_sp > XB_SPIN_CAP) { atomicAdd(&(bar)[XB_TMO], 1u); break; } } } } while (0)
struct XcdBarrier { unsigned* bar; unsigned x; volatile LAS unsigned* st; };
__device__ __forceinline__ XcdBarrier xcd_barrier_post(unsigned* bar, volatile LAS unsigned* st) {
    XcdBarrier b; b.bar = bar; b.x = xb_xcc_id(); b.st = st;
    if (threadIdx.x == 0) (void)xb_add(&bar[XB_XCNT(b.x)], 1u);
    return b;
}
__device__ __forceinline__ void xcd_barrier_complete(unsigned* bar, unsigned x, unsigned& nloc, unsigned& nx) {
    const unsigned G = gridDim.x * gridDim.y * gridDim.z;
    unsigned sum, cnt, mine, sp = 0u;
    for (;;) {
        sum = 0u; cnt = 0u; mine = 0u;
#pragma unroll
        for (unsigned j = 0; j < 16; ++j) { const unsigned c = xb_ld(&bar[XB_XCNT(j)]); sum += c; cnt += (c > 0u) ? 1u : 0u; mine = (j == x) ? c : mine; }
        if (sum == G) break;
        __builtin_amdgcn_s_sleep(1);
        if ((++sp & 255u) == 0u) { if (xb_ld(&bar[XB_TMO])) break; if (sp > XB_SPIN_CAP) { atomicAdd(&bar[XB_TMO], 1u); break; } }
    }
    nloc = mine > 0u ? mine : 1u; nx = cnt > 0u ? cnt : 1u;
}
__device__ __forceinline__ void xcd_barrier(const XcdBarrier& b) {
    asm volatile("s_waitcnt vmcnt(0)" ::: "memory");
    __syncthreads();
    if (threadIdx.x == 0) {
        unsigned* bar = b.bar;
        __builtin_amdgcn_s_waitcnt(0);
        unsigned nloc = b.st[0], nx = b.st[1];
        if (nloc == 0u) { xcd_barrier_complete(bar, b.x, nloc, nx); b.st[0] = nloc; b.st[1] = nx; }
        const unsigned old = xb_add(&bar[XB_XSUB(b.x)], 1u);
        const unsigned gen = old / nloc;
        if (old + 1u == (gen + 1u) * nloc) {
            __builtin_amdgcn_fence(__ATOMIC_RELEASE, "agent");
            asm volatile("s_waitcnt vmcnt(0)" ::: "memory");
            const unsigned og = xb_add(&bar[XB_TOP], 1u);
            const unsigned tg = og / nx;
            if (og + 1u == (tg + 1u) * nx) xb_add(&bar[XB_TOPGEN], 1u);
            else XB_SPIN(xb_ld(&bar[XB_TOPGEN]) == tg, bar);
            __builtin_amdgcn_fence(__ATOMIC_ACQUIRE, "agent");
            xb_add(&bar[XB_XGEN(b.x)], 1u);
            asm volatile("s_waitcnt vmcnt(0)" ::: "memory");
        } else {
            XB_SPIN(xb_ld(&bar[XB_XGEN(b.x)]) == gen, bar);
            __builtin_amdgcn_fence(__ATOMIC_ACQUIRE, "agent");
            asm volatile("s_waitcnt vmcnt(0)" ::: "memory");
        }
    }
    __syncthreads();
}

extern "C" __global__ void __launch_bounds__(512) mega(Params p) {
    extern __shared__ __attribute__((aligned(16))) unsigned char smem_raw[];
    LAS unsigned char* lds = (LAS unsigned char*)smem_raw;
    const int w = blockIdx.x, G = gridDim.x;
    volatile LAS unsigned* bst = (volatile LAS unsigned*)(lds + LDS_BYTES - 16);
    if (threadIdx.x == 0) { bst[0] = 0u; bst[1] = 0u; }
    __syncthreads();
    XcdBarrier xb; xb.bar = (unsigned*)(p.ws + WS_BAR); xb.x = 0; xb.st = bst;
    if (p.use_sync == 1) xb = xcd_barrier_post((unsigned*)(p.ws + WS_BAR), bst);
    for (int i = p.i_lo; i < p.i_hi; ++i) {
        #ifndef NO_WCONV
        if (i < 3) { stage_wconv(p, lds, i == 0 ? 0 : (i == 1 ? 2304 : 3968), i == 0 ? 2304 : (i == 1 ? 3968 : 4672)); __syncthreads(); }
#endif
        #ifndef NO_SCAN
        { const int s = i - 3; if (valid_slab(s)) { stage_scan(p, s, lds); __syncthreads(); } }
#endif
        const int sd = i - 9, s1 = i - 1, su = i - 7, so = i - 5;
        const int nd = valid_slab(sd) ? slab_panels(sd) * 4 : 0, n1 = valid_slab(s1) ? slab_panels(s1) * 36 : 0, nu = valid_slab(su) ? slab_panels(su) * 22 : 0, no = valid_slab(so) ? slab_panels(so) * 4 : 0;
        const int ns = (valid_slab(i - 3) && i - 3 < 8) ? 16 : 0;
        const int cs = (n1 + nu + no <= 3 * (G - (nd > 0 && sd >= SPLIT_FROM ? 2 * nd : nd) - ns)) ? 3 : 2;
        const bool dsplit = nd > 0 && sd >= SPLIT_FROM; const int ndw = dsplit ? 2 * nd : nd;
        if (nd) { DealDown S; S.w = w; S.G = G; S.n = ndw; S.npm = slab_panels(sd); S.split = dsplit ? 1 : 0;
            Gemm g; g.base = (const char*)p.ws; g.oA0 = (long)(WS_H + (size_t)(sd & 1) * SZ_H); g.dA1 = dsplit ? (long)4096 * 1408 * 2 : 0; g.dA2 = 0; g.oB0 = dsplit ? (long)WS_WD2 : (long)WS_WD; g.dB1 = dsplit ? (long)1024 * 1408 * 2 : 0; g.dB2 = 0; g.K = dsplit ? 1408 : 2816;
            EpiRes E; E.resp = nullptr; E.ress = nullptr; E.resb = (const bf16_t*)(p.ws + WS_X1B + (size_t)(sd & 3) * SZ_G1); E.pre = (bf16_t*)(p.ws + WS_PRE2 + (size_t)(sd & 1) * SZ_G1); E.pre2b = (bf16_t*)(p.ws + WS_PRE2B + (size_t)(sd & 1) * SZ_G1); E.y = p.out + O_YP; E.stats = (float*)(p.ws + WS_STATS); E.s = sd; E.soff = dsplit ? -1 : 2; E.mode = 1;
            pg8::gemm_phase<EpiRes, DealDown, false>(lds, g, S, E, nullptr); __syncthreads(); }
        if (n1 + nu + no) { Deal S; S.w = w; S.G = G; S.nd = ndw; S.ns = ns; S.cs = cs; S.n1 = n1; S.nu = nu; S.no = no; S.p1 = n1 ? slab_panels(s1) : 1; S.pu = nu ? slab_panels(su) : 1; S.po = no ? slab_panels(so) : 1;
            Gemm g; g.base = (const char*)p.ws; g.K = 1024;
            { const long a0 = (long)(WS_XB + (size_t)(s1 & 1) * SZ_XB), a1 = (long)(WS_X1B + (size_t)(su & 3) * SZ_G1), a2 = (long)(WS_MIX + (size_t)(so & 1) * SZ_G1);
              g.oA0 = a0; g.dA1 = a1 - a0; g.dA2 = a2 - a1; g.oB0 = (long)WS_WIN; g.dB1 = (long)WS_WUP - (long)WS_WIN; g.dB2 = (long)WS_WO - (long)WS_WUP; }
            EpiMulti E; E.e0.qkv = (bf16_t*)(p.ws + WS_QKV + (size_t)(s1 & 1) * SZ_QKV); E.e0.gate = (bf16_t*)(p.ws + WS_GATE + (size_t)(s1 & 3) * SZ_GATE); E.e0.gnorm = p.in[10];
            E.e1.av = (bf16_t*)(p.ws + WS_AV + (size_t)(su & 1) * SZ_AV);
            E.e2.resp = p.in[0]; E.e2.ress = p.in[1]; E.e2.resb = nullptr; E.e2.pre = (bf16_t*)(p.ws + WS_PRE1 + (size_t)(so & 1) * SZ_G1); E.e2.pre2b = nullptr; E.e2.y = nullptr; E.e2.stats = (float*)(p.ws + WS_STATS); E.e2.s = so; E.e2.soff = 0; E.e2.mode = 0;
            pg8::gemm_phase<EpiMulti, Deal, false>(lds, g, S, E, nullptr); __syncthreads(); }
        const int Gl = G - ns;
        int V = Gl, vid0 = w < Gl ? w : -1, vid1 = -1;
        { const int T = n1 + nu + no;
          if (ndw > 0 && T <= G - ndw - ns) {
              V = Gl - ndw; vid0 = (w >= ndw && w < Gl) ? w - ndw : -1; }
          else if (T > 0) { int rs = 0, before = 0, cap = 0;
              for (;;) { cap = G - (rs < 3 ? ndw : 0) - (rs < cs ? ns : 0); if (before + cap >= T || cap <= 0) break; before += cap; ++rs; }
              const int cl = T - before;
              const bool part = (w >= ndw || rs >= 3) && w < Gl; const int rank = w - (rs < 3 ? (w < ndw ? w : ndw) : 0);
              const int capl = cap - ((rs >= cs) ? ns : 0);
              if (cl > 0 && cl < capl) { V = Gl + (capl - cl); if (part && rank >= cl) vid1 = Gl + (rank - cl); } } }
        for (int rep_ = 0; rep_ < 2; ++rep_) { const int vid = rep_ ? vid1 : vid0; if (vid < 0) continue;
            if (valid_slab(i)) for (int r_ = 0; r_ < (p.pad & 15); ++r_) { stage_cvt(p, i, lds, vid, V); __syncthreads(); }
            if (valid_slab(i - 2)) for (int r_ = 0; r_ < ((p.pad >> 4) & 15); ++r_) { stage_prep(p, i - 2, lds, vid, V); __syncthreads(); }
            if (valid_slab(i - 4)) for (int r_ = 0; r_ < ((p.pad >> 8) & 15); ++r_) stage_merge(p, i - 4, vid, V);
            if (valid_slab(i - 6)) stage_ln(p, i - 6, 0, vid, V);
            if (valid_slab(i - 8)) for (int r_ = 0; r_ < ((p.pad >> 12) & 15); ++r_) stage_glu(p, i - 8, vid, V);
            if (valid_slab(i - 10)) stage_ln(p, i - 10, 1, vid, V);
        }
        if (i + 1 < p.i_hi) { if (p.use_sync == 1) xcd_barrier(xb); else if (p.use_sync == 2) cg::this_grid().sync(); }
    }
}

#ifndef REPS
#define REPS 0x11111
#endif
#ifndef MK_LAUNCHES
#define MK_LAUNCHES 1
#endif
extern "C" void kernel_launch(void* const* d_in, const int* in_sizes, int n_in, void* d_out, int out_size, void* d_ws, size_t ws_size, hipStream_t stream) {
    static int grid = 0;
    if (grid == 0) {
        int dev = 0, cus = 0, per_cu = 0;
        hipGetDevice(&dev); hipDeviceGetAttribute(&cus, hipDeviceAttributeMultiprocessorCount, dev);
        if (hipFuncSetAttribute((const void*)mega, hipFuncAttributeMaxDynamicSharedMemorySize, LDS_BYTES) != hipSuccess) fprintf(stderr, "hipFuncSetAttribute failed\n");
        if (hipOccupancyMaxActiveBlocksPerMultiprocessor(&per_cu, (const void*)mega, 512, LDS_BYTES) != hipSuccess || per_cu < 1) { fprintf(stderr, "occupancy query: %d\n", per_cu); per_cu = 1; }
        (void)hipGetLastError();
        grid = cus * 1;
        if (ws_size < WS_END) { fprintf(stderr, "workspace too small: %zu < %zu\n", ws_size, (size_t)WS_END); grid = -1; }
    }
    if (grid < 0) return;
    if (hipMemsetAsync((unsigned char*)d_ws + WS_BAR, 0, 16384, stream) != hipSuccess) fprintf(stderr, "memset of barrier words failed\n");
    Params p{};
    for (int i = 0; i < 20; ++i) p.in[i] = (const float*)d_in[i];
    p.out = (float*)d_out; p.ws = (unsigned char*)d_ws;
#if MK_LAUNCHES == 1
    p.i_lo = 0; p.i_hi = NINT; p.use_sync = 1; p.pad = REPS;
    void* args[] = {&p};
    hipError_t e = hipLaunchCooperativeKernel((const void*)mega, dim3(grid), dim3(512), args, LDS_BYTES, stream);
    if (e != hipSuccess) fprintf(stderr, "cooperative launch failed: %s (grid %d)\n", hipGetErrorString(e), grid);
#else
    for (int i = 0; i < NINT; ++i) { p.i_lo = i; p.i_hi = i + 1; p.use_sync = 0; p.pad = 0; hipLaunchKernelGGL(mega, dim3(grid), dim3(512), LDS_BYTES, stream, p); }
#endif
}
```

```cpp
#include <hip/hip_runtime.h>
#include <hip/hip_cooperative_groups.h>
#include <cstdio>
namespace cg = cooperative_groups;
__device__ __forceinline__ int opaque_tid() { int t; asm volatile("v_mov_b32 %0, %1" : "=v"(t) : "v"(threadIdx.x)); return t; }
namespace pg8 {
#define PG8_LAS __attribute__((address_space(3)))
typedef unsigned short bf16_t;
typedef short bf16x8 __attribute__((ext_vector_type(8)));
typedef float f32x4 __attribute__((ext_vector_type(4)));
typedef unsigned u32x4 __attribute__((ext_vector_type(4)));
constexpr int BM = 256, BK = 64, HALF = 128, HTB = HALF * BK * 2  , STAGE_BYTES = 8 * HTB, NXCD = 8, WGM = 8;
__host__ __device__ __forceinline__ int lds_byte(int r, int c) { const int st = (r >> 4) * 2 + (c >> 5), rr = r & 15, cc = c & 31, ob = rr * 64 + cc * 2; return st * 1024 + (ob ^ (((ob >> 9) & 1) << 5)); }
__host__ __device__ __forceinline__ void stage_rc(int b, int& R, int& C) { const int st = b / 1024, sb = b % 1024, swz = sb ^ (((sb >> 9) & 1) << 5); R = (st >> 1) * 16 + swz / 64; C = (st & 1) * 32 + (swz % 64) / 2; }
__host__ __device__ __forceinline__ int perm32(int rho) { const int n = rho >> 4, i = rho & 15; return 8 * (i >> 2) + 4 * n + (i & 3); }
struct Unit { int pm, pn, ty; };
struct Gemm { const char* base; long oA0, dA1, dA2, oB0, dB1, dB2; int K;
    __device__ __forceinline__ const char* selA(int ty) const { return base + oA0 + (long)(ty > 0) * dA1 + (long)(ty > 1) * dA2; }
    __device__ __forceinline__ const char* selB(int ty) const { return base + oB0 + (long)(ty > 0) * dB1 + (long)(ty > 1) * dB2; } };
typedef float f32x2c_ __attribute__((ext_vector_type(2))); typedef __bf16 bf16x2c_ __attribute__((ext_vector_type(2)));
__device__ __forceinline__ unsigned cvt_pk_bf16(float lo, float hi) { const f32x2c_ v = {lo, hi}; const bf16x2c_ b = __builtin_convertvector(v, bf16x2c_); return __builtin_bit_cast(unsigned, b); }
typedef float f32x2 __attribute__((ext_vector_type(2)));
template <class Epi, class Sched, bool STAMP = false>
__device__ __forceinline__ void gemm_phase(PG8_LAS unsigned char* lds, const Gemm g, const Sched& S, const Epi& E, unsigned long long* stamps) {
    const int tid = opaque_tid(), wid = __builtin_amdgcn_readfirstlane(tid >> 6), lane = tid & 63, wr = wid >> 2, wc = wid & 3, fr = lane & 15, fq = lane >> 4;
    const int K = g.K, nt = K / BK;
    int ts_lo = 0, ts_hi = 0, nts = 0; const unsigned long long rt_entry = STAMP ? (unsigned long long)wall_clock64() : 0ull;
#define PG8_STAMP() do { if (STAMP && wid == 0 && nts < 64) { const unsigned long long _c = (unsigned long long)clock64(); \
        ts_lo = (lane == nts) ? (int)(unsigned)_c : ts_lo; ts_hi = (lane == nts) ? (int)(unsigned)(_c >> 32) : ts_hi; ++nts; } } while (0)
    PG8_STAMP();
    unsigned voffA[2], voffB[2];
#pragma unroll
    for (int i = 0; i < 2; ++i) { int R, C; stage_rc(tid * 16 + i * 8192, R, C); const int Rb = Epi::PERM ? ((R & ~31) + perm32(R & 31)) : R;
        voffA[i] = (unsigned)(R * K + C) * 2u; voffB[i] = (unsigned)(Rb * K + C) * 2u; }
    const size_t kstep = (size_t)(BK * 2);
    const size_t hstep = (size_t)HALF * K * 2;
    const size_t tstep = 2 * hstep;
    const unsigned ldsw = (unsigned)wid * 1024u;
    const int aoff = lds_byte(wr * 64 + fr, fq * 8), boff = lds_byte(wc * 32 + fr, fq * 8);
#define PG8_SA(b, h) (((b) * 2 + (h)) * HTB)
#define PG8_SB(b, h) ((4 + (b) * 2 + (h)) * HTB)
#define PG8_STAGE(bufoff, gbase, voff) do { _Pragma("unroll") for (int _i = 0; _i < 2; ++_i) \
        __builtin_amdgcn_global_load_lds((const unsigned*)((const char*)(gbase) + (voff)[_i]), (PG8_LAS unsigned*)(lds + (bufoff) + ldsw + _i * 8192), 16, 0, 0); } while (0)
#define PG8_LDA(dst, b, h) do { _Pragma("unroll") for (int m = 0; m < 4; ++m) _Pragma("unroll") for (int k = 0; k < 2; ++k) dst[m][k] = *(const PG8_LAS bf16x8*)(lds + PG8_SA(b, h) + aoff + m * 2048 + k * 1024); } while (0)
#define PG8_LDB(dst, b, h) do { _Pragma("unroll") for (int n = 0; n < 2; ++n) _Pragma("unroll") for (int k = 0; k < 2; ++k) dst[n][k] = *(const PG8_LAS bf16x8*)(lds + PG8_SB(b, h) + boff + n * 2048 + k * 1024); } while (0)
#define PG8_MMA(ai, bj, At, Bt) do { __builtin_amdgcn_s_setprio(1); _Pragma("unroll") for (int m = 0; m < 4; ++m) _Pragma("unroll") for (int n = 0; n < 2; ++n) _Pragma("unroll") for (int k = 0; k < 2; ++k) \
        acc[ai][bj][m][n] = __builtin_amdgcn_mfma_f32_16x16x32_bf16(Bt[n][k], At[m][k], acc[ai][bj][m][n], 0, 0, 0); __builtin_amdgcn_s_setprio(0); } while (0)
#define PG8_WAIT_V(n) asm volatile("s_waitcnt vmcnt(" #n ")" ::: "memory")
#define PG8_WAIT_L(n) asm volatile("s_waitcnt lgkmcnt(" #n ")" ::: "memory")
#define PG8_BAR __builtin_amdgcn_s_barrier()
#define PG8_SCHED __builtin_amdgcn_sched_barrier(0)
    Unit cur, nxt; int ui = 0;
    if (!S.next(0, cur)) return;
    f32x4 acc[2][2][4][2];
#pragma unroll
    for (int a = 0; a < 2; ++a)
#pragma unroll
        for (int b = 0; b < 2; ++b)
#pragma unroll
            for (int m = 0; m < 4; ++m)
#pragma unroll
                for (int n = 0; n < 2; ++n) acc[a][b][m][n] = (f32x4){0.f, 0.f, 0.f, 0.f};
    bf16x8 At[4][2], B0[2][2], B1[2][2];
    const char* cA = g.selA(cur.ty) + (size_t)cur.pm * tstep; const char* cB = g.selB(cur.ty) + (size_t)cur.pn * tstep;
    S.a_ready(cur);
    PG8_STAGE(PG8_SB(0, 0), cB, voffB); PG8_STAGE(PG8_SA(0, 0), cA, voffA); PG8_STAGE(PG8_SB(0, 1), cB + hstep, voffB); PG8_STAGE(PG8_SA(0, 1), cA + hstep, voffA);
    if (wr == 1) PG8_BAR;
    PG8_WAIT_V(4); PG8_BAR;
    PG8_STAGE(PG8_SB(1, 0), cB + kstep, voffB); PG8_STAGE(PG8_SA(1, 0), cA + kstep, voffA); PG8_STAGE(PG8_SB(1, 1), cB + hstep + kstep, voffB);
    PG8_WAIT_V(6); PG8_BAR;
    PG8_STAMP();
    for (;;) {
        const bool has_next = S.next(ui + 1, nxt);
        const char* nA = has_next ? g.selA(nxt.ty) + (size_t)nxt.pm * tstep : cA; const char* nB = has_next ? g.selB(nxt.ty) + (size_t)nxt.pn * tstep : cB;
        for (int t = 0; t < nt; t += 2) {
            const bool last = (t == nt - 2);
            const char* a1 = cA + (size_t)(t + 1) * kstep;
            const char* a2 = last ? nA : cA + (size_t)(t + 2) * kstep; const char* b2 = last ? nB : cB + (size_t)(t + 2) * kstep;
            const char* a3 = a2 + kstep; const char* b3 = b2 + kstep;
            if (last && has_next) S.a_ready(nxt);
            PG8_LDB(B0, 0, 0); PG8_SCHED; PG8_LDA(At, 0, 0); PG8_STAGE(PG8_SA(1, 1), a1 + hstep, voffA);
            PG8_WAIT_L(8); PG8_BAR; PG8_WAIT_L(0); PG8_MMA(0, 0, At, B0); PG8_BAR; PG8_SCHED;
            PG8_LDB(B1, 0, 1); PG8_STAGE(PG8_SB(0, 0), b2, voffB);
            PG8_BAR; PG8_WAIT_L(0); PG8_MMA(0, 1, At, B1); PG8_BAR;
            PG8_LDA(At, 0, 1); PG8_STAGE(PG8_SA(0, 0), a2, voffA);
            PG8_BAR; PG8_WAIT_L(0); PG8_MMA(1, 0, At, B0); PG8_BAR; PG8_SCHED;
            PG8_STAGE(PG8_SB(0, 1), b2 + hstep, voffB);
            PG8_WAIT_V(6); PG8_BAR; PG8_MMA(1, 1, At, B1); PG8_BAR;
            PG8_LDB(B0, 1, 0); PG8_SCHED; PG8_LDA(At, 1, 0); PG8_STAGE(PG8_SA(0, 1), a2 + hstep, voffA);
            PG8_WAIT_L(8); PG8_BAR; PG8_WAIT_L(0); PG8_MMA(0, 0, At, B0); PG8_BAR; PG8_SCHED;
            PG8_LDB(B1, 1, 1); PG8_STAGE(PG8_SB(1, 0), b3, voffB);
            PG8_BAR; PG8_WAIT_L(0); PG8_MMA(0, 1, At, B1); PG8_BAR;
            PG8_LDA(At, 1, 1); PG8_STAGE(PG8_SA(1, 0), a3, voffA);
            PG8_BAR; PG8_WAIT_L(0); PG8_MMA(1, 0, At, B0); PG8_BAR; PG8_SCHED;
            PG8_STAGE(PG8_SB(1, 1), b3 + hstep, voffB);
            PG8_WAIT_V(6); PG8_BAR; PG8_MMA(1, 1, At, B1); PG8_BAR;
        }
        PG8_STAMP();
        if constexpr (!Epi::AFTER_DRAIN) { E(acc, cur, wr, wc, fr, fq); S.done(cur); }
        PG8_STAMP();
        if (!has_next) break;
#pragma unroll
        for (int a = 0; a < 2; ++a)
#pragma unroll
            for (int b = 0; b < 2; ++b)
#pragma unroll
                for (int m = 0; m < 4; ++m)
#pragma unroll
                    for (int n = 0; n < 2; ++n) acc[a][b][m][n] = (f32x4){0.f, 0.f, 0.f, 0.f};
        cur = nxt; cA = nA; cB = nB; ++ui;
    }
    PG8_WAIT_V(0);
    if (wr == 0) PG8_BAR;
    PG8_BAR;
    if constexpr (Epi::AFTER_DRAIN) { E.fused(acc, cur, wr, wc, fr, fq, lds, wid, lane); S.done(cur); }
    PG8_STAMP();
    if (STAMP && wid == 0) { stamps[lane] = lane < nts ? (((unsigned long long)(unsigned)ts_hi << 32) | (unsigned)ts_lo) : 0ull;
        if (lane == 62) stamps[62] = rt_entry; if (lane == 63) stamps[63] = (unsigned long long)wall_clock64(); }
#undef PG8_STAMP
#undef PG8_SA
#undef PG8_SB
#undef PG8_STAGE
#undef PG8_LDA
#undef PG8_LDB
#undef PG8_MMA
#undef PG8_WAIT_V
#undef PG8_WAIT_L
#undef PG8_BAR
#undef PG8_SCHED
}
}

using pg8::bf16_t; using pg8::bf16x8; using pg8::f32x4; using pg8::u32x4; using pg8::Unit; using pg8::Gemm; using pg8::cvt_pk_bf16;
typedef unsigned u32x2 __attribute__((ext_vector_type(2)));
#define LAS __attribute__((address_space(3)))
constexpr int NSLAB = 9, NSTAGE = 11, NINT = NSLAB + NSTAGE - 1;
constexpr int IN_DIM = 9232;
constexpr float ALPHA = 1.189207115002721f;
constexpr int LDS_BYTES = 152 * 1024;
constexpr size_t O_YP = 0, O_PGC = 34078720, O_PS = 34097152, O_PSC = 34359296, O_PFF = 34363392, O_SGC = 34374656, O_SS = 34669568, O_SSC = 38863872, O_SFF = 38929408;
constexpr int R_W = 0, R_QD = 16384, R_KT = 32768, R_QK = 49152, R_U = 57344, R_HDR = 73728, REC_BYTES = 73984;
constexpr size_t A256(size_t x) { return (x + 255) & ~(size_t)255; }
constexpr size_t WS_WIN = 0;
constexpr size_t WS_WO = WS_WIN + (size_t)9216 * 1024 * 2;
constexpr size_t WS_WUP = WS_WO + (size_t)1024 * 1024 * 2;
constexpr size_t WS_WD = WS_WUP + (size_t)5632 * 1024 * 2;
constexpr size_t WS_XB = WS_WD + (size_t)1024 * 2816 * 2;
constexpr size_t SZ_XB = (size_t)4096 * 1024 * 2;
constexpr size_t WS_AB = WS_XB + 2 * SZ_XB;
constexpr size_t WS_QKV = A256(WS_AB + (size_t)33280 * 16 * 4);
constexpr size_t SZ_QKV = (size_t)4096 * 3072 * 2;
constexpr size_t WS_GATE = WS_QKV + 2 * SZ_QKV;
constexpr size_t SZ_G1 = (size_t)4096 * 1024 * 2, SZ_GATE = 3 * SZ_G1;
constexpr size_t WS_REC = WS_GATE + 4 * SZ_GATE;
constexpr size_t SZ_REC = (size_t)512 * REC_BYTES;
constexpr size_t WS_ORAW = WS_REC + 2 * SZ_REC;
constexpr size_t WS_MIX = WS_ORAW + 2 * SZ_G1;
constexpr size_t WS_X1B = WS_MIX + 2 * SZ_G1;
constexpr size_t WS_AV = WS_X1B + 4 * SZ_G1;
constexpr size_t SZ_AV = (size_t)4096 * 5632 * 2;
constexpr size_t WS_H = WS_AV + 2 * SZ_AV;
constexpr size_t SZ_H = (size_t)4096 * 2816 * 2;
constexpr size_t WS_STATS = WS_H + 2 * SZ_H;
constexpr size_t WS_HQ = WS_STATS + (size_t)33280 * 16;
constexpr size_t SZ_HQ = (size_t)2 * 3 * 3072 * 4;
constexpr size_t WS_HS = WS_HQ + 2 * SZ_HQ;
constexpr size_t SZ_HS = (size_t)2 * 2 * 1024 * 4;
constexpr size_t WS_HF = WS_HS + 2 * SZ_HS;
constexpr size_t SZ_HF = (size_t)2 * 2 * 2816 * 4;
constexpr size_t WS_BAR = A256(WS_HF + 2 * SZ_HF);
constexpr size_t WS_PRE1 = WS_BAR + 16384;
constexpr size_t WS_PRE2 = WS_PRE1 + 2 * SZ_G1;
constexpr size_t WS_PRE2B = WS_PRE2 + 2 * SZ_G1;
constexpr size_t WS_WD2 = WS_PRE2B + 2 * SZ_G1;
constexpr size_t WS_END = WS_WD2 + (size_t)2 * 1024 * 1408 * 2;
constexpr int SPLIT_FROM = 5;

struct Params { const float* in[20]; float* out; unsigned char* ws; int i_lo, i_hi, use_sync, pad; };

__device__ __forceinline__ float bf2f(unsigned short b) { return __uint_as_float((unsigned)b << 16); }
__device__ __forceinline__ float bflo(unsigned w) { return __uint_as_float(w << 16); }
__device__ __forceinline__ float bfhi(unsigned w) { return __uint_as_float(w & 0xffff0000u); }
__device__ __forceinline__ unsigned short f2bf(float f) { return (unsigned short)(cvt_pk_bf16(f, 0.f) & 0xffffu); }
__device__ __forceinline__ float sigmoidf_(float x) { return __builtin_amdgcn_rcpf(1.0f + __expf(-x)); }
__device__ __forceinline__ float gelu_f(float v) {
    const float av = fabsf(v), t = __builtin_amdgcn_rcpf(av * 0.2316418882f + 1.0f);
    float q = t * 0.5307027145f + (-0.7265760135f); q = q * t + 0.7107068705f; q = q * t + (-0.142248368f); q = q * t + 0.127414796f; q = q * t;
    const float e = __builtin_amdgcn_exp2f(v * v * (-0.72134752044f)), m = v * (q * e);
    return v < 0.f ? m : v - m; }
typedef float f32x2_ __attribute__((ext_vector_type(2)));
__device__ __forceinline__ f32x2_ gelu_pk(f32x2_ v) {
    const f32x2_ av = __builtin_elementwise_abs(v), d = av * 0.2316418882f + 1.0f;
    f32x2_ t; t.x = __builtin_amdgcn_rcpf(d.x); t.y = __builtin_amdgcn_rcpf(d.y);
    f32x2_ q = t * 0.5307027145f + (-0.7265760135f); q = q * t + 0.7107068705f; q = q * t + (-0.142248368f); q = q * t + 0.127414796f; q = q * t;
    const f32x2_ s = (v * v) * (-0.72134752044f);
    f32x2_ e; e.x = __builtin_amdgcn_exp2f(s.x); e.y = __builtin_amdgcn_exp2f(s.y);
    const f32x2_ m = v * (q * e), r = v - m;
    f32x2_ o; o.x = v.x < 0.f ? m.x : r.x; o.y = v.y < 0.f ? m.y : r.y; return o;
}
__device__ __forceinline__ int slab_rows(int s) { return s < 8 ? 4096 : 512; }
__device__ __forceinline__ int slab_panels(int s) { return s < 8 ? 16 : 2; }
__device__ __forceinline__ int grow_of(int s, int lr) { return s < 8 ? ((lr >> 11) * 16384 + s * 2048 + (lr & 2047)) : (32768 + lr); }
__device__ __forceinline__ const float* xrow(const Params& p, int grow) { return grow < 32768 ? p.in[0] + (size_t)grow * 1024 : p.in[1] + (size_t)(grow - 32768) * 1024; }
__device__ __forceinline__ bool valid_slab(int s) { return s >= 0 && s < NSLAB; }

struct Deal {
    int w, G, nd, ns, cs, n1, nu, no, p1, pu, po;
    __device__ __forceinline__ int cand(int i) const { const int busy = w < nd ? 3 : (w >= G - ns ? cs : 0), r = busy + i;
        const int before = r * G - nd * (r < 3 ? r : 3) - ns * (r < cs ? r : cs), rank = w - (r < 3 ? (w < nd ? w : nd) : 0); return before + rank; }
    __device__ __forceinline__ static void map16(int j, int N, int& pm, int& pn) { const int x = j & 7, t = j >> 3; pm = 4 * (x & 3) + (t & 3); pn = 2 * (t >> 2) + (x >> 2); (void)N; }
    __device__ __forceinline__ bool next(int i, Unit& u) const { const int q = cand(i); if (q >= n1 + nu + no) return false;
        if (q < n1) { u.ty = 0; if (p1 == 16) map16(q, 36, u.pm, u.pn); else { u.pm = q % p1; u.pn = q / p1; } }
        else if (q < n1 + nu) { const int j = q - n1; u.ty = 1; if (pu == 16) map16(j, 22, u.pm, u.pn); else { u.pm = j % pu; u.pn = j / pu; } }
        else { const int j = q - n1 - nu; u.ty = 2; if (po == 16) map16(j, 4, u.pm, u.pn); else { u.pm = j % po; u.pn = j / po; } }
        return true; }
    __device__ __forceinline__ void a_ready(const Unit&) const {}
    __device__ __forceinline__ void done(const Unit&) const {}
};
struct DealDown {
    int w, G, n, npm, split;
    __device__ __forceinline__ bool next(int i, Unit& u) const { const int j = w + i * G; if (j >= n || (n <= G && i > 0)) return false; const int t = split ? (j >> 1) : j; u.pm = t % npm; u.pn = t / npm; u.ty = split ? (j & 1) : 0; return true; }
    __device__ __forceinline__ void a_ready(const Unit&) const {}
    __device__ __forceinline__ void done(const Unit&) const {}
};

struct EpiIn {
    static constexpr bool PERM = true, AFTER_DRAIN = false;
    bf16_t* qkv; bf16_t* gate; const float* gnorm;
    __device__ __forceinline__ void operator()(const f32x4 (&acc)[2][2][4][2], const Unit& u, int wr, int wc, int fr, int fq) const {
        const int row0 = u.pm * 256 + wr * 64 + fr;
        if (u.pn < 12) {
#pragma unroll
            for (int ai = 0; ai < 2; ++ai)
#pragma unroll
                for (int m = 0; m < 4; ++m) { bf16_t* rowp = qkv + (size_t)(row0 + ai * 128 + m * 16) * 3072 + u.pn * 256 + wc * 32 + 8 * fq;
#pragma unroll
                    for (int bj = 0; bj < 2; ++bj) { const f32x4 v0 = acc[ai][bj][m][0], v1 = acc[ai][bj][m][1]; u32x4 w;
                        w.x = cvt_pk_bf16(v0[0], v0[1]); w.y = cvt_pk_bf16(v0[2], v0[3]); w.z = cvt_pk_bf16(v1[0], v1[1]); w.w = cvt_pk_bf16(v1[2], v1[3]);
                        *(u32x4*)(rowp + bj * 128) = w; } }
        } else {
            const int type = (u.pn - 12) >> 3, j = (u.pn - 12) & 7, ch = j * 128 + wc * 32 + 8 * fq;
            bf16_t* base = gate + (size_t)type * 4096 * 1024 + ch;
            float gn[8];
#pragma unroll
            for (int k = 0; k < 8; ++k) gn[k] = (type == 0) ? gnorm[(ch + k) & 127] : 1.0f;
#pragma unroll
            for (int ai = 0; ai < 2; ++ai)
#pragma unroll
                for (int m = 0; m < 4; ++m) { float o[8];
#pragma unroll
                    for (int n = 0; n < 2; ++n)
#pragma unroll
                        for (int k = 0; k < 4; k += 2) { const f32x2_ X = {acc[ai][0][m][n][k], acc[ai][0][m][n][k + 1]}, Y = {acc[ai][1][m][n][k], acc[ai][1][m][n][k + 1]}; f32x2_ r;
                            if (type == 2) r = X * Y;
                            else { f32x2_ ey; ey.x = __expf(-Y.x); ey.y = __expf(-Y.y);
                                if (type == 0) { f32x2_ ex; ex.x = __expf(-X.x); ex.y = __expf(-X.y); const f32x2_ den = (ey + 1.0f) * (ex + 1.0f); f32x2_ rc; rc.x = __builtin_amdgcn_rcpf(den.x); rc.y = __builtin_amdgcn_rcpf(den.y);
                                    r = X * rc * (f32x2_){gn[n * 4 + k], gn[n * 4 + k + 1]}; }
                                else { const f32x2_ den = ey + 1.0f; f32x2_ rc; rc.x = __builtin_amdgcn_rcpf(den.x); rc.y = __builtin_amdgcn_rcpf(den.y); r = X * rc; } }
                            o[n * 4 + k] = r.x; o[n * 4 + k + 1] = r.y; }
                    u32x4 w; w.x = cvt_pk_bf16(o[0], o[1]); w.y = cvt_pk_bf16(o[2], o[3]); w.z = cvt_pk_bf16(o[4], o[5]); w.w = cvt_pk_bf16(o[6], o[7]);
                    __builtin_nontemporal_store(w, (u32x4*)(base + (size_t)(row0 + ai * 128 + m * 16) * 1024)); }
        }
    }
};
struct EpiUp {
    static constexpr bool PERM = true, AFTER_DRAIN = false;
    bf16_t* av;
    __device__ __forceinline__ void operator()(const f32x4 (&acc)[2][2][4][2], const Unit& u, int wr, int wc, int fr, int fq) const {
        const int row0 = u.pm * 256 + wr * 64 + fr;
#pragma unroll
        for (int ai = 0; ai < 2; ++ai)
#pragma unroll
            for (int m = 0; m < 4; ++m) { bf16_t* rowp = av + (size_t)(row0 + ai * 128 + m * 16) * 5632 + u.pn * 256 + wc * 32 + 8 * fq;
#pragma unroll
                for (int bj = 0; bj < 2; ++bj) { const f32x4 v0 = acc[ai][bj][m][0], v1 = acc[ai][bj][m][1]; u32x4 w;
                    w.x = cvt_pk_bf16(v0[0], v0[1]); w.y = cvt_pk_bf16(v0[2], v0[3]); w.z = cvt_pk_bf16(v1[0], v1[1]); w.w = cvt_pk_bf16(v1[2], v1[3]);
                    *(u32x4*)(rowp + bj * 128) = w; } }
    }
};
struct EpiRes {
    static constexpr bool PERM = true, AFTER_DRAIN = false;
    const float* resp; const float* ress; const bf16_t* resb; bf16_t* pre; bf16_t* pre2b; float* y; float* stats; int s, soff, mode;
    __device__ __forceinline__ void operator()(const f32x4 (&acc)[2][2][4][2], const Unit& u, int wr, int wc, int fr, int fq) const {
        const int col0 = u.pn * 256 + wc * 32 + 8 * fq;
#pragma unroll
        for (int ai = 0; ai < 2; ++ai)
#pragma unroll
            for (int m = 0; m < 4; ++m) {
                const int lr = u.pm * 256 + ai * 128 + wr * 64 + m * 16 + fr, grow = grow_of(s, lr);
                float sm = 0.f, sq = 0.f;
                if (mode == 1 && u.ty == 1) {
                    bf16_t* op = pre2b + (size_t)lr * 1024 + col0;
#pragma unroll
                    for (int bj = 0; bj < 2; ++bj) { const f32x4 v0 = acc[ai][bj][m][0], v1 = acc[ai][bj][m][1]; u32x4 w; w.x = cvt_pk_bf16(v0[0], v0[1]); w.y = cvt_pk_bf16(v0[2], v0[3]); w.z = cvt_pk_bf16(v1[0], v1[1]); w.w = cvt_pk_bf16(v1[2], v1[3]); *(u32x4*)(op + bj * 128) = w; }
                } else if (mode == 0) {
                    const float* rp = (grow < 32768 ? resp + (size_t)grow * 1024 : ress + (size_t)(grow - 32768) * 1024) + col0; bf16_t* op = pre + (size_t)lr * 1024 + col0;
#pragma unroll
                    for (int bj = 0; bj < 2; ++bj) { const f32x4 r0 = __builtin_nontemporal_load((const f32x4*)(rp + bj * 128)), r1 = __builtin_nontemporal_load((const f32x4*)(rp + bj * 128 + 4)); const f32x4 v0 = r0 * ALPHA + acc[ai][bj][m][0], v1 = r1 * ALPHA + acc[ai][bj][m][1];
                        u32x4 w; w.x = cvt_pk_bf16(v0[0], v0[1]); w.y = cvt_pk_bf16(v0[2], v0[3]); w.z = cvt_pk_bf16(v1[0], v1[1]); w.w = cvt_pk_bf16(v1[2], v1[3]); *(u32x4*)(op + bj * 128) = w;
                        sm += (v0[0] + v0[1]) + (v0[2] + v0[3]) + (v1[0] + v1[1]) + (v1[2] + v1[3]);
                        sq += (v0[0] * v0[0] + v0[1] * v0[1]) + (v0[2] * v0[2] + v0[3] * v0[3]) + (v1[0] * v1[0] + v1[1] * v1[1]) + (v1[2] * v1[2] + v1[3] * v1[3]); }
                } else {
                    const bf16_t* rp = resb + (size_t)lr * 1024 + col0; bf16_t* op = pre + (size_t)lr * 1024 + col0;
#pragma unroll
                    for (int bj = 0; bj < 2; ++bj) { const u32x4 rw = *(const u32x4*)(rp + bj * 128);
                        const f32x4 r0 = {bflo(rw.x), bfhi(rw.x), bflo(rw.y), bfhi(rw.y)}, r1 = {bflo(rw.z), bfhi(rw.z), bflo(rw.w), bfhi(rw.w)};
                        const f32x4 v0 = r0 * ALPHA + acc[ai][bj][m][0], v1 = r1 * ALPHA + acc[ai][bj][m][1];
                        u32x4 w; w.x = cvt_pk_bf16(v0[0], v0[1]); w.y = cvt_pk_bf16(v0[2], v0[3]); w.z = cvt_pk_bf16(v1[0], v1[1]); w.w = cvt_pk_bf16(v1[2], v1[3]); *(u32x4*)(op + bj * 128) = w;
                        sm += (v0[0] + v0[1]) + (v0[2] + v0[3]) + (v1[0] + v1[1]) + (v1[2] + v1[3]);
                        sq += (v0[0] * v0[0] + v0[1] * v0[1]) + (v0[2] * v0[2] + v0[3] * v0[3]) + (v1[0] * v1[0] + v1[1] * v1[1]) + (v1[2] * v1[2] + v1[3] * v1[3]); }
                }
                sm += __shfl_xor(sm, 16); sm += __shfl_xor(sm, 32); sq += __shfl_xor(sq, 16); sq += __shfl_xor(sq, 32);
                if (fq == 0 && soff >= 0) { atomicAdd(stats + (size_t)grow * 4 + soff, sm); atomicAdd(stats + (size_t)grow * 4 + soff + 1, sq); }
            }
    }
};
struct EpiMulti {
    static constexpr bool PERM = true, AFTER_DRAIN = false;
    EpiIn e0; EpiUp e1; EpiRes e2;
    __device__ __forceinline__ void operator()(const f32x4 (&acc)[2][2][4][2], const Unit& u, int wr, int wc, int fr, int fq) const {
        if (u.ty == 0) e0(acc, u, wr, wc, fr, fq); else if (u.ty == 1) e1(acc, u, wr, wc, fr, fq); else e2(acc, u, wr, wc, fr, fq); }
};

__device__ __forceinline__ int src_col_in(int np) {
    const int pn = np >> 8; if (pn < 12) return np;
    const int within = np & 255, half = within >> 7, cl = within & 127, type = (pn - 12) >> 3, j = (pn - 12) & 7;
    const int base = type == 0 ? (half ? 7184 : 3072) : (type == 1 ? (half ? 8208 : 4112) : (half ? 6160 : 5136));
    return base + j * 128 + cl;
}
__device__ void stage_wconv(const Params& p, LAS unsigned char* lds, int t_lo, int t_hi) {
    LAS float* t = (LAS float*)lds;
    const int tid = opaque_tid();
    for (int ti = t_lo + blockIdx.x; ti < t_hi; ti += gridDim.x) {
        const float* W; bf16_t* D; int N, K, tk, tn, which;
        if (ti < 2304) { which = 0; W = p.in[6]; D = (bf16_t*)(p.ws + WS_WIN); N = IN_DIM; K = 1024; tk = ti / 144; tn = ti % 144; }
        else if (ti < 2560) { const int q = ti - 2304; which = 1; W = p.in[12]; D = (bf16_t*)(p.ws + WS_WO); N = 1024; K = 1024; tk = q / 16; tn = q % 16; }
        else if (ti < 3968) { const int q = ti - 2560; which = 2; W = p.in[15]; D = (bf16_t*)(p.ws + WS_WUP); N = 5632; K = 1024; tk = q / 88; tn = q % 88; }
        else { const int q = ti - 3968; which = 3; W = p.in[17]; D = (bf16_t*)(p.ws + WS_WD); N = 1024; K = 2816; tk = q / 16; tn = q % 16; }
        const int c = tid & 63, r8 = tid >> 6;
        const int np = tn * 64 + c, sc = which == 0 ? src_col_in(np) : np;
#pragma unroll
        for (int i = 0; i < 8; ++i) { const int r = r8 + 8 * i; t[r * 65 + c] = W[(size_t)(tk * 64 + r) * N + sc]; }
        __syncthreads();
#pragma unroll
        for (int i = 0; i < 8; ++i) { const int rr = r8 + 8 * i; D[(size_t)(tn * 64 + rr) * K + tk * 64 + c] = f2bf(t[c * 65 + rr]); }
        if (which == 3) { bf16_t* D2 = (bf16_t*)(p.ws + WS_WD2) + (size_t)(tk >= 22) * 1024 * 1408 + (size_t)(tn * 64) * 1408 + (tk >= 22 ? tk - 22 : tk) * 64 + c;
#pragma unroll
            for (int i = 0; i < 8; ++i) { const int rr = r8 + 8 * i; D2[(size_t)rr * 1408] = f2bf(t[c * 65 + rr]); } }
        __syncthreads();
    }
}

__device__ void stage_cvt(const Params& p, int s, LAS unsigned char* lds, int vid, int V) {
    LAS float* sW = (LAS float*)lds;
    const int tid = opaque_tid(), wid = tid >> 6, lane = tid & 63;
    for (int idx = tid; idx < 4096; idx += 512) { const int k = idx >> 2, q = idx & 3; const f32x4 wv4 = *(const f32x4*)(p.in[6] + (size_t)k * IN_DIM + 4096 + q * 4);
#pragma unroll
        for (int j = 0; j < 4; ++j) sW[(q * 4 + j) * 1024 + k] = wv4[j]; }
    __syncthreads();
    bf16_t* xb = (bf16_t*)(p.ws + WS_XB + (size_t)(s & 1) * SZ_XB);
    float* ab = (float*)(p.ws + WS_AB); float* stats = (float*)(p.ws + WS_STATS);
    const int rows = slab_rows(s);
    for (int lr = (vid * 8 + wid) * 2; lr < rows; lr += V * 16) {
        const int grow0 = grow_of(s, lr), grow1 = grow_of(s, lr + 1); const float* xr0 = xrow(p, grow0); const float* xr1 = xrow(p, grow1);
        f32x4 xa[4], xc[4];
#pragma unroll
        for (int i = 0; i < 4; ++i) { xa[i] = __builtin_nontemporal_load((const f32x4*)(xr0 + lane * 4 + 256 * i)); xc[i] = __builtin_nontemporal_load((const f32x4*)(xr1 + lane * 4 + 256 * i)); }
#pragma unroll
        for (int i = 0; i < 4; ++i) { u32x2 w; w.x = cvt_pk_bf16(xa[i][0], xa[i][1]); w.y = cvt_pk_bf16(xa[i][2], xa[i][3]); *(u32x2*)(xb + (size_t)lr * 1024 + lane * 4 + 256 * i) = w;
            w.x = cvt_pk_bf16(xc[i][0], xc[i][1]); w.y = cvt_pk_bf16(xc[i][2], xc[i][3]); *(u32x2*)(xb + (size_t)(lr + 1) * 1024 + lane * 4 + 256 * i) = w; }
        float a0[16], a1[16];
#pragma unroll
        for (int o = 0; o < 16; ++o) { f32x4 s0 = {0.f, 0.f, 0.f, 0.f}, s1 = {0.f, 0.f, 0.f, 0.f};
#pragma unroll
            for (int i = 0; i < 4; ++i) { const f32x4 wv = *(const LAS f32x4*)(sW + o * 1024 + lane * 4 + 256 * i); s0 += xa[i] * wv; s1 += xc[i] * wv; }
            a0[o] = (s0[0] + s0[1]) + (s0[2] + s0[3]); a1[o] = (s1[0] + s1[1]) + (s1[2] + s1[3]); if ((o & 3) == 3) __builtin_amdgcn_sched_barrier(0); }
#pragma unroll
        for (int o = 0; o < 8; ++o) { const bool hi = lane & 32; const float k0 = hi ? a0[o + 8] : a0[o], s0 = hi ? a0[o] : a0[o + 8], k1 = hi ? a1[o + 8] : a1[o], s1 = hi ? a1[o] : a1[o + 8];
            a0[o] = k0 + __shfl_xor(s0, 32); a1[o] = k1 + __shfl_xor(s1, 32); }
#pragma unroll
        for (int o = 0; o < 4; ++o) { const bool hi = lane & 16; const float k0 = hi ? a0[o + 4] : a0[o], s0 = hi ? a0[o] : a0[o + 4], k1 = hi ? a1[o + 4] : a1[o], s1 = hi ? a1[o] : a1[o + 4];
            a0[o] = k0 + __shfl_xor(s0, 16); a1[o] = k1 + __shfl_xor(s1, 16); }
#pragma unroll
        for (int o = 0; o < 2; ++o) { const bool hi = lane & 8; const float k0 = hi ? a0[o + 2] : a0[o], s0 = hi ? a0[o] : a0[o + 2], k1 = hi ? a1[o + 2] : a1[o], s1 = hi ? a1[o] : a1[o + 2];
            a0[o] = k0 + __shfl_xor(s0, 8); a1[o] = k1 + __shfl_xor(s1, 8); }
        { const bool hi = lane & 4; const float k0 = hi ? a0[1] : a0[0], s0 = hi ? a0[0] : a0[1], k1 = hi ? a1[1] : a1[0], s1 = hi ? a1[0] : a1[1];
            a0[0] = k0 + __shfl_xor(s0, 4); a1[0] = k1 + __shfl_xor(s1, 4); }
        a0[0] += __shfl_xor(a0[0], 1); a0[0] += __shfl_xor(a0[0], 2); a1[0] += __shfl_xor(a1[0], 1); a1[0] += __shfl_xor(a1[0], 2);
        if ((lane & 3) == 0) { const int o = ((lane >> 5) & 1) * 8 + ((lane >> 4) & 1) * 4 + ((lane >> 3) & 1) * 2 + ((lane >> 2) & 1); ab[(size_t)grow0 * 16 + o] = a0[0]; ab[(size_t)grow1 * 16 + o] = a1[0]; }
        if (lane < 4) { stats[(size_t)grow0 * 4 + lane] = 0.f; stats[(size_t)grow1 * 4 + lane] = 0.f; }
    }
}

constexpr int P_G = 0, P_BETA = 256, P_EG = 512, P_ET = 768, P_KB = 1024, P_QB = 18432, P_RT = 35840, P_ABF = 69632, P_ADIAG = 78336, P_TB = 82432;
constexpr int P_OW = 1024  , P_OU = 19456, P_OQD = 86016, P_OKT = 104448, P_OQK = 122880;
__device__ __forceinline__ int pslot(int chunk) { return (chunk + (chunk >> 3)) * 16; }
__device__ __forceinline__ bf16x8 mk8(unsigned a, unsigned b, unsigned c, unsigned d) { u32x4 v = {a, b, c, d}; return __builtin_bit_cast(bf16x8, v); }
__device__ void prep_unit(const Params& p, int s, int idx, LAS unsigned char* lds) {
    const int tid = opaque_tid(), wid = tid >> 6, lane = tid & 63;
    const bool sample = (s == 8);
    int h, lr0, grow0, ntok, recidx, hb  ; bool first, last;
    if (!sample) { const int b = idx >> 8, rem = idx & 255, c = rem >> 3; h = rem & 7; lr0 = b * 2048 + c * 64; grow0 = b * 16384 + s * 2048 + c * 64; ntok = 64; recidx = (b * 8 + h) * 32 + c; hb = b; first = (c == 0); last = (c == 31); }
    else { const int seq = idx >> 3; h = idx & 7; lr0 = seq * 16; grow0 = 32768 + seq * 16; ntok = 16; recidx = idx; hb = seq; first = true; last = true; }
    LAS float* sG = (LAS float*)(lds + P_G); LAS float* sBeta = (LAS float*)(lds + P_BETA); LAS float* sEG = (LAS float*)(lds + P_EG); LAS float* sET = (LAS float*)(lds + P_ET);
    unsigned char* rec = p.ws + WS_REC + (size_t)(s & 1) * SZ_REC + (size_t)recidx * REC_BYTES;
    const bf16_t* qkv = (const bf16_t*)(p.ws + WS_QKV + (size_t)(s & 1) * SZ_QKV);
    if (wid == 0) {
        const int t = lane; const bool v = t < ntok; const int gr = grow0 + (v ? t : 0);
        const float* ab = (const float*)(p.ws + WS_AB) + (size_t)gr * 16;
        const float bl = ab[h], al = ab[8 + h] + p.in[9][h];
        const float sp = al > 20.f ? al : log1pf(__expf(al));
        float g = v ? -__expf(p.in[8][h]) * sp : 0.f; const float beta = v ? sigmoidf_(bl) : 0.f;
#pragma unroll
        for (int d = 1; d < 64; d <<= 1) { const float o = __shfl_up(g, d); if (lane >= d) g += o; }
        const float gl = __shfl(g, 63);
        sG[t] = g; sBeta[t] = beta; sEG[t] = __expf(g); sET[t] = __expf(gl - g);
        if (lane == 0) *(float*)(rec + R_HDR) = __expf(gl);
    }
    __syncthreads();
    const float* cw = p.in[7];
#pragma unroll
    for (int it = 0; it < 3; ++it) {
        const int i = it * 512 + tid, o = i & 15, rest = i >> 4, tensor = rest % 3, tp = rest / 3, t0 = 2 * tp;
        const int cb = tensor * 1024 + h * 128 + o * 8;
        float x[5][8];
#pragma unroll
        for (int r = 0; r < 5; ++r) { const int t = t0 - 3 + r;
            if (t >= 0 || !first) { const u32x4 w = *(const u32x4*)(qkv + (size_t)(lr0 + t) * 3072 + cb);
                x[r][0] = bflo(w.x); x[r][1] = bfhi(w.x); x[r][2] = bflo(w.y); x[r][3] = bfhi(w.y); x[r][4] = bflo(w.z); x[r][5] = bfhi(w.z); x[r][6] = bflo(w.w); x[r][7] = bfhi(w.w); }
            else if (sample) { const float* hp = p.in[2] + ((size_t)hb * 3 + (3 + t)) * 3072 + cb;
#pragma unroll
                for (int k = 0; k < 8; ++k) x[r][k] = hp[k]; }
            else if (s == 0) {
#pragma unroll
                for (int k = 0; k < 8; ++k) x[r][k] = 0.f; }
            else { const float* hp = (const float*)(p.ws + WS_HQ + (size_t)((s - 1) & 1) * SZ_HQ) + ((size_t)hb * 3 + (3 + t)) * 3072 + cb;
#pragma unroll
                for (int k = 0; k < 8; ++k) x[r][k] = hp[k]; } }
        if (last && t0 + 1 == ntok - 1) {
#pragma unroll
            for (int r = 0; r < 3; ++r) {
                float* d1 = sample ? p.out + O_SGC + ((size_t)hb * 3 + r) * 3072 + cb : (float*)(p.ws + WS_HQ + (size_t)(s & 1) * SZ_HQ) + ((size_t)hb * 3 + r) * 3072 + cb;
#pragma unroll
                for (int k = 0; k < 8; ++k) d1[k] = x[2 + r][k];
                if (!sample && s == 7) { float* d2 = p.out + O_PGC + ((size_t)hb * 3 + r) * 3072 + cb;
#pragma unroll
                    for (int k = 0; k < 8; ++k) d2[k] = x[2 + r][k]; } } }
        f32x2_ yk[8]; f32x2_ ssv = {0.f, 0.f};
        float cw0[8], cw1[8], cw2[8], cw3[8];
        { const f32x4 q0 = *(const f32x4*)(cw + cb), q1 = *(const f32x4*)(cw + cb + 4), q2 = *(const f32x4*)(cw + 3072 + cb), q3 = *(const f32x4*)(cw + 3072 + cb + 4), q4 = *(const f32x4*)(cw + 6144 + cb), q5 = *(const f32x4*)(cw + 6144 + cb + 4), q6 = *(const f32x4*)(cw + 9216 + cb), q7 = *(const f32x4*)(cw + 9216 + cb + 4);
#pragma unroll
          for (int k = 0; k < 4; ++k) { cw0[k] = q0[k]; cw0[4 + k] = q1[k]; cw1[k] = q2[k]; cw1[4 + k] = q3[k]; cw2[k] = q4[k]; cw2[4 + k] = q5[k]; cw3[k] = q6[k]; cw3[4 + k] = q7[k]; } }
#pragma unroll
        for (int k = 0; k < 8; ++k) { const float w0 = cw0[k], w1 = cw1[k], w2 = cw2[k], w3 = cw3[k];
            f32x2_ ab = (f32x2_){x[0][k], x[1][k]} * w0 + (f32x2_){x[1][k], x[2][k]} * w1 + (f32x2_){x[2][k], x[3][k]} * w2 + (f32x2_){x[3][k], x[4][k]} * w3;
            f32x2_ ex; ex.x = __expf(-ab.x); ex.y = __expf(-ab.y); const f32x2_ den = ex + 1.0f; f32x2_ rc; rc.x = __builtin_amdgcn_rcpf(den.x); rc.y = __builtin_amdgcn_rcpf(den.y);
            ab = ab * rc; yk[k] = ab; ssv += ab * ab; }
        float ss0 = ssv.x, ss1 = ssv.y;
#pragma unroll
        for (int d = 1; d < 16; d <<= 1) { ss0 += __shfl_xor(ss0, d); ss1 += __shfl_xor(ss1, d); }
        const int t1 = t0 + 1; const bool v0 = t0 < ntok, v1 = t1 < ntok;
        f32x2_ mm;
        if (tensor == 0) { mm.x = rsqrtf(ss0 + 1e-6f) * 0.08838834764831845f; mm.y = rsqrtf(ss1 + 1e-6f) * 0.08838834764831845f; }
        else if (tensor == 1) { mm.x = rsqrtf(ss0 + 1e-6f); mm.y = rsqrtf(ss1 + 1e-6f); }
        else { mm.x = 1.f; mm.y = 1.f; }
        float y0[8], y1[8];
#pragma unroll
        for (int k = 0; k < 8; ++k) { f32x2_ q = yk[k] * mm; q.x = v0 ? q.x : 0.f; q.y = v1 ? q.y : 0.f; yk[k] = q; y0[k] = q.x; y1[k] = q.y; }
        const float b0 = sBeta[t0], b1 = sBeta[t1], eg0 = sEG[t0], eg1 = sEG[t1], et0 = sET[t0], et1 = sET[t1];
        const f32x2_ egv = {eg0, eg1}, etv = {et0, et1}, bv = {b0, b1}, begv = bv * egv;
        if (tensor == 0) {
            u32x4 w; w.x = cvt_pk_bf16(y0[0], y0[1]); w.y = cvt_pk_bf16(y0[2], y0[3]); w.z = cvt_pk_bf16(y0[4], y0[5]); w.w = cvt_pk_bf16(y0[6], y0[7]);
            *(LAS u32x4*)(lds + P_QB + t0 * 272 + o * 16) = w;
            w.x = cvt_pk_bf16(y1[0], y1[1]); w.y = cvt_pk_bf16(y1[2], y1[3]); w.z = cvt_pk_bf16(y1[4], y1[5]); w.w = cvt_pk_bf16(y1[6], y1[7]);
            *(LAS u32x4*)(lds + P_QB + t1 * 272 + o * 16) = w;
            const int kb = o >> 2, oo = o & 3, half = oo >> 1, g0 = (oo & 1) * 2;
#pragma unroll
            for (int tt = 0; tt < 2; ++tt) { const int t = t0 + tt; const float e = tt ? eg1 : eg0; const float* yy = tt ? y1 : y0; const int mt = t >> 4, m = t & 15;
                const int ck = (mt * 4 + kb) * 64 + g0 * 16 + m;
                u32x2 a; a.x = cvt_pk_bf16(yy[0] * e, yy[1] * e); a.y = cvt_pk_bf16(yy[2] * e, yy[3] * e); *(LAS u32x2*)(lds + P_OQD + pslot(ck) + half * 8) = a;
                a.x = cvt_pk_bf16(yy[4] * e, yy[5] * e); a.y = cvt_pk_bf16(yy[6] * e, yy[7] * e); *(LAS u32x2*)(lds + P_OQD + pslot(ck + 16) + half * 8) = a; }
        } else if (tensor == 1) {
            u32x4 w; w.x = cvt_pk_bf16(y0[0], y0[1]); w.y = cvt_pk_bf16(y0[2], y0[3]); w.z = cvt_pk_bf16(y0[4], y0[5]); w.w = cvt_pk_bf16(y0[6], y0[7]);
            *(LAS u32x4*)(lds + P_KB + t0 * 272 + o * 16) = w;
            w.x = cvt_pk_bf16(y1[0], y1[1]); w.y = cvt_pk_bf16(y1[2], y1[3]); w.z = cvt_pk_bf16(y1[4], y1[5]); w.w = cvt_pk_bf16(y1[6], y1[7]);
            *(LAS u32x4*)(lds + P_KB + t1 * 272 + o * 16) = w;
            const int dt = o >> 1, kb = t0 >> 5, r = t0 & 31, half = r >> 4, rr = r & 15, gp = rr >> 2, ep = half * 4 + (rr & 3);
#pragma unroll
            for (int k = 0; k < 8; ++k) { const int m = (o & 1) * 8 + k;
                const f32x2_ r1 = yk[k] * begv, r2 = yk[k] * etv;
                *(LAS unsigned*)(lds + P_RT + (128 + o * 8 + k) * 132 + t0 * 2) = cvt_pk_bf16(r1.x, r1.y);
                *(LAS unsigned*)(lds + P_OKT + pslot((dt * 2 + kb) * 64 + gp * 16 + m) + ep * 2) = cvt_pk_bf16(r2.x, r2.y); }
        } else {
#pragma unroll
            for (int k = 0; k < 8; ++k) { const f32x2_ r1 = yk[k] * bv; *(LAS unsigned*)(lds + P_RT + (o * 8 + k) * 132 + t0 * 2) = cvt_pk_bf16(r1.x, r1.y); }
        }
    }
    __syncthreads();
    const int n = lane & 15, g = lane >> 4;
    {
        const int itile = wid >> 1;
        bf16x8 ak[4], aq[4];
#pragma unroll
        for (int kb = 0; kb < 4; ++kb) { ak[kb] = *(const LAS bf16x8*)(lds + P_KB + (itile * 16 + n) * 272 + kb * 64 + g * 16); aq[kb] = *(const LAS bf16x8*)(lds + P_QB + (itile * 16 + n) * 272 + kb * 64 + g * 16); }
#pragma unroll
        for (int jj = 0; jj < 2; ++jj) { const int jt = (wid & 1) * 2 + jj;
            f32x4 ckk = {0.f, 0.f, 0.f, 0.f}, cqk = {0.f, 0.f, 0.f, 0.f};
#pragma unroll
            for (int kb = 0; kb < 4; ++kb) { const bf16x8 bk = *(const LAS bf16x8*)(lds + P_KB + (jt * 16 + n) * 272 + kb * 64 + g * 16);
                ckk = __builtin_amdgcn_mfma_f32_16x16x32_bf16(ak[kb], bk, ckk, 0, 0, 0); cqk = __builtin_amdgcn_mfma_f32_16x16x32_bf16(aq[kb], bk, cqk, 0, 0, 0); }
            const int j = jt * 16 + n; const float Gj = sG[j];
#pragma unroll
            for (int e = 0; e < 4; ++e) { const int i = itile * 16 + 4 * g + e; const float dd = fminf(sG[i] - Gj, 0.f), ex = __expf(dd);
                const float av = (j < i) ? sBeta[i] * ckk[e] * ex : 0.f, qv = (j <= i) ? cqk[e] * ex : 0.f;
                *(LAS bf16_t*)(lds + P_ABF + i * 136 + j * 2) = f2bf(-av);
                if (itile == jt) *(LAS float*)(lds + P_ADIAG + ((itile * 16 + 4 * g + e) * 16 + n) * 4) = av;
                const int kb2 = jt >> 1, half = jt & 1, gp = n >> 2, ep = half * 4 + (n & 3), m = 4 * g + e;
                *(LAS bf16_t*)(lds + P_OQK + pslot((itile * 2 + kb2) * 64 + gp * 16 + m) + ep * 2) = f2bf(qv); }
        }
    }
    __syncthreads();
    if (wid == 0) {
        const int blk = lane >> 4, c = lane & 15; const LAS float* A = (const LAS float*)(lds + P_ADIAG) + blk * 256;
        float T[16];
#pragma unroll
        for (int r = 0; r < 16; ++r) { float a = (r == c) ? 1.f : 0.f;
#pragma unroll
            for (int jx = 0; jx < r; ++jx) a -= A[r * 16 + jx] * T[jx];
            T[r] = a; }
#pragma unroll
        for (int r = 0; r < 16; ++r) *(LAS bf16_t*)(lds + P_TB + (blk * 16 + r) * 40 + c * 2) = f2bf(T[r]);
    }
    __syncthreads();
    {
        bf16x8 Xop[2][2];
#pragma unroll
        for (int a = 0; a < 2; ++a)
#pragma unroll
            for (int b = 0; b < 2; ++b) Xop[a][b] = mk8(0u, 0u, 0u, 0u);
        unsigned xw[2][2][4];
#pragma unroll
        for (int a = 0; a < 2; ++a)
#pragma unroll
            for (int b = 0; b < 2; ++b)
#pragma unroll
                for (int c = 0; c < 4; ++c) xw[a][b][c] = 0u;
#pragma unroll
        for (int blk = 0; blk < 4; ++blk) {
            f32x4 acc[2];
#pragma unroll
            for (int ct = 0; ct < 2; ++ct) { const int f = 32 * wid + 16 * ct + n; const LAS unsigned* rp = (const LAS unsigned*)(lds + P_RT + f * 132 + 32 * blk + 8 * g);
                const unsigned r0 = rp[0], r1 = rp[1]; acc[ct] = (f32x4){bflo(r0), bfhi(r0), bflo(r1), bfhi(r1)}; }
            if (blk >= 1) { const LAS unsigned char* ap = lds + P_ABF + (blk * 16 + n) * 136 + 8 * g; const u32x2 a0 = *(const LAS u32x2*)ap, a1 = *(const LAS u32x2*)(ap + 32);
                const bf16x8 A = mk8(a0.x, a0.y, a1.x, a1.y);
#pragma unroll
                for (int ct = 0; ct < 2; ++ct) acc[ct] = __builtin_amdgcn_mfma_f32_16x16x32_bf16(A, mk8(xw[0][ct][0], xw[0][ct][1], xw[0][ct][2], xw[0][ct][3]), acc[ct], 0, 0, 0); }
            if (blk == 3) { const LAS unsigned char* ap = lds + P_ABF + (blk * 16 + n) * 136 + 64 + 8 * g; const u32x2 a0 = *(const LAS u32x2*)ap, a1 = *(const LAS u32x2*)(ap + 32);
                const bf16x8 A = mk8(a0.x, a0.y, a1.x, a1.y);
#pragma unroll
                for (int ct = 0; ct < 2; ++ct) acc[ct] = __builtin_amdgcn_mfma_f32_16x16x32_bf16(A, mk8(xw[1][ct][0], xw[1][ct][1], xw[1][ct][2], xw[1][ct][3]), acc[ct], 0, 0, 0); }
            const u32x2 tv = *(const LAS u32x2*)(lds + P_TB + (blk * 16 + n) * 40 + 8 * g);
            const bf16x8 Top = mk8(tv.x, tv.y, 0u, 0u);
#pragma unroll
            for (int ct = 0; ct < 2; ++ct) {
                const bf16x8 Yop = mk8(cvt_pk_bf16(acc[ct][0], acc[ct][1]), cvt_pk_bf16(acc[ct][2], acc[ct][3]), 0u, 0u);
                f32x4 x = {0.f, 0.f, 0.f, 0.f}; x = __builtin_amdgcn_mfma_f32_16x16x32_bf16(Top, Yop, x, 0, 0, 0);
                const unsigned p0 = cvt_pk_bf16(x[0], x[1]), p1 = cvt_pk_bf16(x[2], x[3]);
                xw[blk >> 1][ct][(blk & 1) * 2] = p0; xw[blk >> 1][ct][(blk & 1) * 2 + 1] = p1;
                if (wid < 4) { const int wv = 2 * wid + ct; u32x2 st; st.x = p0; st.y = p1; *(LAS u32x2*)(lds + P_OU + ((wv * 4 + blk) * 64 + lane) * 8) = st; }
                else { const int kbp = wid - 4, gp = n >> 2, ep = ct * 4 + (n & 3);
#pragma unroll
                    for (int e = 0; e < 4; ++e) { const int mp = 4 * g + e; *(LAS bf16_t*)(lds + P_OW + pslot((blk * 4 + kbp) * 64 + gp * 16 + mp) + ep * 2) = f2bf(-x[e]); } }
            }
        }
        (void)Xop;
    }
    __syncthreads();
#pragma unroll
    for (int i = 0; i < 9; ++i) { const int c = i * 512 + tid;
        int off; if (i < 2) off = P_OW + pslot(c); else if (i < 4) off = P_OQD + pslot(c - 1024); else if (i < 6) off = P_OKT + pslot(c - 2048); else if (i < 7) off = P_OQK + pslot(c - 3072); else off = P_OU + (c - 3584) * 16;
        *(u32x4*)(rec + (size_t)c * 16) = *(const LAS u32x4*)(lds + off); }
    __syncthreads();
}
__device__ void stage_prep(const Params& p, int s, LAS unsigned char* lds, int vid, int V) {
    const int nu = s < 8 ? 512 : 256;
    for (int idx = vid; idx < nu; idx += V) prep_unit(p, s, idx, lds);
}

__device__ void scan_chain(const Params& p, int s, int chain, LAS unsigned char* lds) {
    const int tid = opaque_tid(), wv = tid >> 6, lane = tid & 63, n = lane & 15, g = lane >> 4;
    const bool sample = (s == 8);
    int h, lr0, nch, ntok; const unsigned char* rec; const float* Sin; float* Sout;
    if (!sample) { const int b = chain >> 3; h = chain & 7; lr0 = b * 2048; nch = 32; ntok = 64; rec = p.ws + WS_REC + (size_t)(s & 1) * SZ_REC + (size_t)chain * 32 * REC_BYTES;
        Sout = p.out + O_PS + (size_t)chain * 16384; Sin = s == 0 ? nullptr : Sout; }
    else { const int seq = chain >> 3; h = chain & 7; lr0 = seq * 16; nch = 1; ntok = 16; rec = p.ws + WS_REC + (size_t)(s & 1) * SZ_REC + (size_t)chain * REC_BYTES;
        Sin = p.in[3] + (size_t)chain * 16384; Sout = p.out + O_SS + (size_t)chain * 16384; }
    bf16_t* orow = (bf16_t*)(p.ws + WS_ORAW + (size_t)(s & 1) * SZ_G1) + (size_t)(lr0 + lane) * 1024 + h * 128 + wv * 16;
    f32x4 S[8];
#pragma unroll
    for (int dt = 0; dt < 8; ++dt) S[dt] = (f32x4){0.f, 0.f, 0.f, 0.f};
    if (Sin) {
#pragma unroll
        for (int i = 0; i < 8; ++i) *(LAS u32x4*)(lds + (i * 512 + tid) * 16) = *(const u32x4*)((const unsigned char*)Sin + (size_t)(i * 512 + tid) * 16);
        __syncthreads();
        const LAS float* sp = (const LAS float*)lds + (4 * g) * 128 + wv * 16 + n;
#pragma unroll
        for (int dt = 0; dt < 8; ++dt)
#pragma unroll
            for (int e = 0; e < 4; ++e) S[dt][e] = sp[(dt * 16 + e) * 128];
        __syncthreads();
    }
    u32x4 pre[9];
#pragma unroll
    for (int i = 0; i < 9; ++i) pre[i] = *(const u32x4*)(rec + (size_t)(i * 512 + tid) * 16);
#pragma unroll
    for (int i = 0; i < 9; ++i) *(LAS u32x4*)(lds + (i * 512 + tid) * 16) = pre[i];
    __syncthreads();
#pragma unroll 1
    for (int c = 0; c < nch; ++c) {
        const unsigned char* rc = rec + (size_t)c * REC_BYTES;
        const bool more = c + 1 < nch;
        if (more) {
#pragma unroll
            for (int i = 0; i < 9; ++i) pre[i] = *(const u32x4*)(rc + REC_BYTES + (size_t)(i * 512 + tid) * 16); }
        const float gamma = *(const float*)(rc + R_HDR);
        const LAS unsigned char* cur = lds + (c & 1) * 73728;
        bf16x8 Sop[4];
#pragma unroll
        for (int kb = 0; kb < 4; ++kb) Sop[kb] = mk8(cvt_pk_bf16(S[2 * kb][0], S[2 * kb][1]), cvt_pk_bf16(S[2 * kb][2], S[2 * kb][3]), cvt_pk_bf16(S[2 * kb + 1][0], S[2 * kb + 1][1]), cvt_pk_bf16(S[2 * kb + 1][2], S[2 * kb + 1][3]));
        f32x4 vn[4], oa[4];
#pragma unroll
        for (int mt = 0; mt < 4; ++mt) { const u32x2 uu = *(const LAS u32x2*)(cur + R_U + ((wv * 4 + mt) * 64 + lane) * 8);
            f32x4 a = {bflo(uu.x), bfhi(uu.x), bflo(uu.y), bfhi(uu.y)}; f32x4 o = {0.f, 0.f, 0.f, 0.f};
#pragma unroll
            for (int kb = 0; kb < 4; ++kb) { const bf16x8 wf = *(const LAS bf16x8*)(cur + R_W + ((mt * 4 + kb) * 64 + lane) * 16); const bf16x8 qf = *(const LAS bf16x8*)(cur + R_QD + ((mt * 4 + kb) * 64 + lane) * 16);
                a = __builtin_amdgcn_mfma_f32_16x16x32_bf16(wf, Sop[kb], a, 0, 0, 0); o = __builtin_amdgcn_mfma_f32_16x16x32_bf16(qf, Sop[kb], o, 0, 0, 0); }
            vn[mt] = a; oa[mt] = o; __builtin_amdgcn_sched_barrier(0); }
        bf16x8 Vop[2];
#pragma unroll
        for (int kb = 0; kb < 2; ++kb) Vop[kb] = mk8(cvt_pk_bf16(vn[2 * kb][0], vn[2 * kb][1]), cvt_pk_bf16(vn[2 * kb][2], vn[2 * kb][3]), cvt_pk_bf16(vn[2 * kb + 1][0], vn[2 * kb + 1][1]), cvt_pk_bf16(vn[2 * kb + 1][2], vn[2 * kb + 1][3]));
#pragma unroll
        for (int mt = 0; mt < 4; ++mt) {
#pragma unroll
            for (int kb = 0; kb < 2; ++kb) { const bf16x8 qk = *(const LAS bf16x8*)(cur + R_QK + ((mt * 2 + kb) * 64 + lane) * 16); oa[mt] = __builtin_amdgcn_mfma_f32_16x16x32_bf16(qk, Vop[kb], oa[mt], 0, 0, 0); }
            { LAS unsigned char* wreg = (LAS unsigned char*)cur + R_U + wv * 2048 + (mt * 16 + 4 * g) * 32 + n * 2;
#pragma unroll
              for (int e = 0; e < 4; ++e) *(LAS bf16_t*)(wreg + e * 32) = f2bf(oa[mt][e]); }
            __builtin_amdgcn_sched_barrier(0); }
        { const LAS unsigned char* wreg = cur + R_U + wv * 2048 + lane * 32; const u32x4 o0 = *(const LAS u32x4*)wreg, o1 = *(const LAS u32x4*)(wreg + 16);
          if (lane < ntok) { bf16_t* op = orow + (size_t)c * 64 * 1024; *(u32x4*)op = o0; *(u32x4*)(op + 8) = o1; } }
#pragma unroll
        for (int dt = 0; dt < 8; ++dt) { S[dt] *= gamma;
#pragma unroll
            for (int kb = 0; kb < 2; ++kb) { const bf16x8 kf = *(const LAS bf16x8*)(cur + R_KT + ((dt * 2 + kb) * 64 + lane) * 16); S[dt] = __builtin_amdgcn_mfma_f32_16x16x32_bf16(kf, Vop[kb], S[dt], 0, 0, 0); } if (dt & 1) __builtin_amdgcn_sched_barrier(0); }
        if (more) {
#pragma unroll
            for (int i = 0; i < 9; ++i) *(LAS u32x4*)(lds + ((c + 1) & 1) * 73728 + (i * 512 + tid) * 16) = pre[i]; }
        __syncthreads();
    }
    {
        LAS float* sp = (LAS float*)lds + (4 * g) * 128 + wv * 16 + n;
#pragma unroll
        for (int dt = 0; dt < 8; ++dt)
#pragma unroll
            for (int e = 0; e < 4; ++e) sp[(dt * 16 + e) * 128] = S[dt][e];
        __syncthreads();
#pragma unroll
        for (int i = 0; i < 8; ++i) *(u32x4*)((unsigned char*)Sout + (size_t)(i * 512 + tid) * 16) = *(const LAS u32x4*)(lds + (i * 512 + tid) * 16);
    }
}
__device__ void stage_scan(const Params& p, int s, LAS unsigned char* lds) {
    const int G = gridDim.x;
    if (s < 8) { const int j = G - 1 - (int)blockIdx.x; for (int ch = j; ch < 16; ch += G) { scan_chain(p, s, ch, lds); __syncthreads(); } }
    else { for (int ch = blockIdx.x; ch < 256; ch += G) { scan_chain(p, s, ch, lds); __syncthreads(); } }
}

__device__ void stage_merge(const Params& p, int s, int vid, int V) {
    const int tid = opaque_tid(), wid = tid >> 6, lane = tid & 63;
    const bool sample = (s == 8); const int rows = slab_rows(s);
    const bf16_t* oraw = (const bf16_t*)(p.ws + WS_ORAW + (size_t)(s & 1) * SZ_G1);
    const bf16_t* gE = (const bf16_t*)(p.ws + WS_GATE + (size_t)(s & 3) * SZ_GATE); const bf16_t* gR = gE + (size_t)4096 * 1024; const bf16_t* gP = gR + (size_t)4096 * 1024;
    bf16_t* mix = (bf16_t*)(p.ws + WS_MIX + (size_t)(s & 1) * SZ_G1);
    const float* scw = p.in[11];
    const int nitem = (rows >> 2) * 2;
    for (int it = vid * 8 + wid; it < nitem; it += V * 8) {
        const int lr0 = (it >> 1) * 4, ch = ((it & 1) * 64 + lane) * 8;
        const int hb = sample ? (lr0 >> 4) : (lr0 >> 11), tl0 = sample ? (lr0 & 15) : (lr0 & 2047), tlast = sample ? 15 : 2047;
        float w0[8], w1[8], w2[8], pm2[8], pm1[8];
        { const f32x4 q0 = *(const f32x4*)(scw + ch), q1 = *(const f32x4*)(scw + ch + 4), q2 = *(const f32x4*)(scw + 1024 + ch), q3 = *(const f32x4*)(scw + 1024 + ch + 4), q4 = *(const f32x4*)(scw + 2048 + ch), q5 = *(const f32x4*)(scw + 2048 + ch + 4);
#pragma unroll
          for (int k = 0; k < 4; ++k) { w0[k] = q0[k]; w0[4 + k] = q1[k]; w1[k] = q2[k]; w1[4 + k] = q3[k]; w2[k] = q4[k]; w2[4 + k] = q5[k]; } }
        if (tl0 > 0) { const u32x4 u0 = *(const u32x4*)(gP + (size_t)(lr0 - 2) * 1024 + ch), u1 = *(const u32x4*)(gP + (size_t)(lr0 - 1) * 1024 + ch);
            pm2[0] = bflo(u0.x); pm2[1] = bfhi(u0.x); pm2[2] = bflo(u0.y); pm2[3] = bfhi(u0.y); pm2[4] = bflo(u0.z); pm2[5] = bfhi(u0.z); pm2[6] = bflo(u0.w); pm2[7] = bfhi(u0.w);
            pm1[0] = bflo(u1.x); pm1[1] = bfhi(u1.x); pm1[2] = bflo(u1.y); pm1[3] = bfhi(u1.y); pm1[4] = bflo(u1.z); pm1[5] = bfhi(u1.z); pm1[6] = bflo(u1.w); pm1[7] = bfhi(u1.w); }
        else { const float* hp = sample ? p.in[4] + (size_t)hb * 2 * 1024 + ch : (s == 0 ? nullptr : (const float*)(p.ws + WS_HS + (size_t)((s - 1) & 1) * SZ_HS) + (size_t)hb * 2 * 1024 + ch);
#pragma unroll
            for (int k = 0; k < 8; ++k) { pm2[k] = hp ? hp[k] : 0.f; pm1[k] = hp ? hp[1024 + k] : 0.f; } }
#pragma unroll
        for (int r = 0; r < 4; ++r) { const int lr = lr0 + r;
            const u32x4 ow = *(const u32x4*)(oraw + (size_t)lr * 1024 + ch);
            const float o[8] = {bflo(ow.x), bfhi(ow.x), bflo(ow.y), bfhi(ow.y), bflo(ow.z), bfhi(ow.z), bflo(ow.w), bfhi(ow.w)};
            float ss = 0.f;
#pragma unroll
            for (int k = 0; k < 8; ++k) ss += o[k] * o[k];
#pragma unroll
            for (int d = 1; d < 16; d <<= 1) ss += __shfl_xor(ss, d);
            const float rstd = rsqrtf(ss * (1.0f / 128.0f) + 1e-6f);
            const u32x4 ew = __builtin_nontemporal_load((const u32x4*)(gE + (size_t)lr * 1024 + ch)), rw = __builtin_nontemporal_load((const u32x4*)(gR + (size_t)lr * 1024 + ch)), pw = *(const u32x4*)(gP + (size_t)lr * 1024 + ch);
            const float E[8] = {bflo(ew.x), bfhi(ew.x), bflo(ew.y), bfhi(ew.y), bflo(ew.z), bfhi(ew.z), bflo(ew.w), bfhi(ew.w)};
            const float R[8] = {bflo(rw.x), bfhi(rw.x), bflo(rw.y), bfhi(rw.y), bflo(rw.z), bfhi(rw.z), bflo(rw.w), bfhi(rw.w)};
            const float P[8] = {bflo(pw.x), bfhi(pw.x), bflo(pw.y), bfhi(pw.y), bflo(pw.z), bfhi(pw.z), bflo(pw.w), bfhi(pw.w)};
            float m[8];
#pragma unroll
            for (int k = 0; k < 8; k += 2) { const f32x2_ c3 = (f32x2_){w0[k], w0[k + 1]} * (f32x2_){pm2[k], pm2[k + 1]} + (f32x2_){w1[k], w1[k + 1]} * (f32x2_){pm1[k], pm1[k + 1]} + (f32x2_){w2[k], w2[k + 1]} * (f32x2_){P[k], P[k + 1]};
                const f32x2_ mm = (f32x2_){o[k], o[k + 1]} * rstd * (f32x2_){E[k], E[k + 1]} + (f32x2_){R[k], R[k + 1]} * c3; m[k] = mm.x; m[k + 1] = mm.y; pm2[k] = pm1[k]; pm2[k + 1] = pm1[k + 1]; pm1[k] = P[k]; pm1[k + 1] = P[k + 1]; }
            u32x4 w; w.x = cvt_pk_bf16(m[0], m[1]); w.y = cvt_pk_bf16(m[2], m[3]); w.z = cvt_pk_bf16(m[4], m[5]); w.w = cvt_pk_bf16(m[6], m[7]);
            *(u32x4*)(mix + (size_t)lr * 1024 + ch) = w; }
        if (tl0 + 3 == tlast) {
            float* d1 = sample ? p.out + O_SSC + (size_t)hb * 2 * 1024 + ch : (float*)(p.ws + WS_HS + (size_t)(s & 1) * SZ_HS) + (size_t)hb * 2 * 1024 + ch;
#pragma unroll
            for (int k = 0; k < 8; ++k) { d1[k] = pm2[k]; d1[1024 + k] = pm1[k]; }
            if (!sample && s == 7) { float* d2 = p.out + O_PSC + (size_t)hb * 2 * 1024 + ch;
#pragma unroll
                for (int k = 0; k < 8; ++k) { d2[k] = pm2[k]; d2[1024 + k] = pm1[k]; } } }
    }
}

__device__ void stage_ln(const Params& p, int s, int which, int vid, int V) {
    const int tid = opaque_tid(), wid = tid >> 6, lane = tid & 63; const int rows = slab_rows(s);
    const float* gam = p.in[which ? 18 : 13]; const float* bet = p.in[which ? 19 : 14];
    const float* stats = (const float*)(p.ws + WS_STATS); bf16_t* x1b = (bf16_t*)(p.ws + WS_X1B + (size_t)(s & 3) * SZ_G1);
    const bf16_t* pre1 = (const bf16_t*)(p.ws + (which ? WS_PRE2 : WS_PRE1) + (size_t)(s & 1) * SZ_G1);
    for (int lr = vid * 8 + wid; lr < rows; lr += V * 8) {
        const int grow = grow_of(s, lr); float* yp = p.out + O_YP + (size_t)grow * 1024;
        f32x4 v[4];
#pragma unroll
        for (int i = 0; i < 4; ++i) { const u32x2 q = __builtin_nontemporal_load((const u32x2*)(pre1 + (size_t)lr * 1024 + lane * 4 + 256 * i)); v[i] = (f32x4){bflo(q.x), bfhi(q.x), bflo(q.y), bfhi(q.y)}; }
        float mu, rstd;
        if (which && s >= SPLIT_FROM) {
            const bf16_t* p2 = (const bf16_t*)(p.ws + WS_PRE2B + (size_t)(s & 1) * SZ_G1) + (size_t)lr * 1024; float sm = 0.f;
#pragma unroll
            for (int i = 0; i < 4; ++i) { const u32x2 q = *(const u32x2*)(p2 + lane * 4 + 256 * i); v[i] += (f32x4){bflo(q.x), bfhi(q.x), bflo(q.y), bfhi(q.y)}; sm += (v[i][0] + v[i][1]) + (v[i][2] + v[i][3]); }
#pragma unroll
            for (int d = 32; d >= 1; d >>= 1) sm += __shfl_xor(sm, d);
            mu = sm * (1.0f / 1024.0f); float sq = 0.f;
#pragma unroll
            for (int i = 0; i < 4; ++i) { const f32x4 dv = v[i] - mu; sq += (dv[0] * dv[0] + dv[1] * dv[1]) + (dv[2] * dv[2] + dv[3] * dv[3]); }
#pragma unroll
            for (int d = 32; d >= 1; d >>= 1) sq += __shfl_xor(sq, d);
            rstd = rsqrtf(sq * (1.0f / 1024.0f) + 1e-5f);
        } else {
            const float sm = stats[(size_t)grow * 4 + which * 2], sq = stats[(size_t)grow * 4 + which * 2 + 1];
            mu = sm * (1.0f / 1024.0f); const float var = fmaxf(sq * (1.0f / 1024.0f) - mu * mu, 0.f); rstd = rsqrtf(var + 1e-5f);
        }
#pragma unroll
        for (int i = 0; i < 4; ++i) { const int c = lane * 4 + 256 * i; const f32x4 gg = *(const f32x4*)(gam + c), bb = *(const f32x4*)(bet + c);
            const f32x4 o = (v[i] - mu) * rstd * gg + bb;
            if (which) __builtin_nontemporal_store(o, (f32x4*)(yp + c)); else { u32x2 w; w.x = cvt_pk_bf16(o[0], o[1]); w.y = cvt_pk_bf16(o[2], o[3]); *(u32x2*)(x1b + (size_t)lr * 1024 + c) = w; } }
    }
}

__device__ void stage_glu(const Params& p, int s, int vid, int V) {
    const bool sample = (s == 8); const int rows = slab_rows(s);
    const bf16_t* av = (const bf16_t*)(p.ws + WS_AV + (size_t)(s & 1) * SZ_AV); bf16_t* hh = (bf16_t*)(p.ws + WS_H + (size_t)(s & 1) * SZ_H);
    const float* fw = p.in[16];
    const int total = (rows >> 3) * 352;
    const int tid = opaque_tid();
    for (int it = vid * 512 + tid; it < total; it += V * 512) {
        const int blk = it / 352, oc = it - blk * 352, ch = oc * 8, lr0 = blk * 8;
        const int hb = sample ? (lr0 >> 4) : (lr0 >> 11), tl0 = sample ? (lr0 & 15) : (lr0 & 2047), tlast = sample ? 15 : 2047;
        float w0[8], w1[8], w2[8], am2[8], am1[8];
        { const f32x4 q0 = *(const f32x4*)(fw + ch), q1 = *(const f32x4*)(fw + ch + 4), q2 = *(const f32x4*)(fw + 2816 + ch), q3 = *(const f32x4*)(fw + 2816 + ch + 4), q4 = *(const f32x4*)(fw + 5632 + ch), q5 = *(const f32x4*)(fw + 5632 + ch + 4);
#pragma unroll
          for (int k = 0; k < 4; ++k) { w0[k] = q0[k]; w0[4 + k] = q1[k]; w1[k] = q2[k]; w1[4 + k] = q3[k]; w2[k] = q4[k]; w2[4 + k] = q5[k]; } }
        if (tl0 > 0) { const u32x4 u0 = *(const u32x4*)(av + (size_t)(lr0 - 2) * 5632 + ch), u1 = *(const u32x4*)(av + (size_t)(lr0 - 1) * 5632 + ch);
            am2[0] = bflo(u0.x); am2[1] = bfhi(u0.x); am2[2] = bflo(u0.y); am2[3] = bfhi(u0.y); am2[4] = bflo(u0.z); am2[5] = bfhi(u0.z); am2[6] = bflo(u0.w); am2[7] = bfhi(u0.w);
            am1[0] = bflo(u1.x); am1[1] = bfhi(u1.x); am1[2] = bflo(u1.y); am1[3] = bfhi(u1.y); am1[4] = bflo(u1.z); am1[5] = bfhi(u1.z); am1[6] = bflo(u1.w); am1[7] = bfhi(u1.w); }
        else { const float* hp = sample ? p.in[5] + (size_t)hb * 2 * 2816 + ch : (s == 0 ? nullptr : (const float*)(p.ws + WS_HF + (size_t)((s - 1) & 1) * SZ_HF) + (size_t)hb * 2 * 2816 + ch);
#pragma unroll
            for (int k = 0; k < 8; ++k) { am2[k] = hp ? hp[k] : 0.f; am1[k] = hp ? hp[2816 + k] : 0.f; } }
#pragma unroll
        for (int r = 0; r < 8; ++r) {
            const u32x4 aw = *(const u32x4*)(av + (size_t)(lr0 + r) * 5632 + ch), vw = *(const u32x4*)(av + (size_t)(lr0 + r) * 5632 + 2816 + ch);
            const float a[8] = {bflo(aw.x), bfhi(aw.x), bflo(aw.y), bfhi(aw.y), bflo(aw.z), bfhi(aw.z), bflo(aw.w), bfhi(aw.w)};
            const float v[8] = {bflo(vw.x), bfhi(vw.x), bflo(vw.y), bfhi(vw.y), bflo(vw.z), bfhi(vw.z), bflo(vw.w), bfhi(vw.w)};
            float o[8];
#pragma unroll
            for (int k = 0; k < 8; k += 2) { const f32x2_ c3 = (f32x2_){w0[k], w0[k + 1]} * (f32x2_){am2[k], am2[k + 1]} + (f32x2_){w1[k], w1[k + 1]} * (f32x2_){am1[k], am1[k + 1]} + (f32x2_){w2[k], w2[k + 1]} * (f32x2_){a[k], a[k + 1]};
                const f32x2_ g2 = gelu_pk(c3) * (f32x2_){v[k], v[k + 1]}; o[k] = g2.x; o[k + 1] = g2.y; am2[k] = am1[k]; am2[k + 1] = am1[k + 1]; am1[k] = a[k]; am1[k + 1] = a[k + 1]; }
            u32x4 w; w.x = cvt_pk_bf16(o[0], o[1]); w.y = cvt_pk_bf16(o[2], o[3]); w.z = cvt_pk_bf16(o[4], o[5]); w.w = cvt_pk_bf16(o[6], o[7]);
            if (s >= SPLIT_FROM) *(u32x4*)(hh + (size_t)(ch >= 1408) * 4096 * 1408 + (size_t)(lr0 + r) * 1408 + (ch >= 1408 ? ch - 1408 : ch)) = w;
            else *(u32x4*)(hh + (size_t)(lr0 + r) * 2816 + ch) = w;
        }
        if (tl0 + 7 == tlast) {
            float* d1 = sample ? p.out + O_SFF + (size_t)hb * 2 * 2816 + ch : (float*)(p.ws + WS_HF + (size_t)(s & 1) * SZ_HF) + (size_t)hb * 2 * 2816 + ch;
#pragma unroll
            for (int k = 0; k < 8; ++k) { d1[k] = am2[k]; d1[2816 + k] = am1[k]; }
            if (!sample && s == 7) { float* d2 = p.out + O_PFF + (size_t)hb * 2 * 2816 + ch;
#pragma unroll
                for (int k = 0; k < 8; ++k) { d2[k] = am2[k]; d2[2816 + k] = am1[k]; } } }
    }
}

#define XB_TMO      128
#define XB_XCNT(j)  (256  + 64 * (j))
#define XB_XSUB(j)  (1280 + 64 * (j))
#define XB_XGEN(j)  (2304 + 64 * (j))
#define XB_TOP      3328
#define XB_TOPGEN   3392
#define XCD_BAR_WORDS 3456
#define XB_SPIN_CAP (1u << 22)
__device__ __forceinline__ unsigned xb_ld(unsigned* p)              { return __hip_atomic_load(p, __ATOMIC_RELAXED, __HIP_MEMORY_SCOPE_AGENT); }
__device__ __forceinline__ unsigned xb_add(unsigned* p, unsigned v) { return __hip_atomic_fetch_add(p, v, __ATOMIC_RELAXED, __HIP_MEMORY_SCOPE_AGENT); }
__device__ __forceinline__ unsigned xb_xcc_id() { return (unsigned)__builtin_amdgcn_s_getreg((3 << 11) | 20) & 0xFu; }
#define XB_SPIN(cond, bar) do { unsigned _sp = 0; while (cond) { __builtin_amdgcn_s_sleep(1); \
    if ((++_sp & 255u) == 0u) { if (xb_ld(&(bar)[XB_TMO])) break; if (_sp > XB_SPIN_CAP) { atomicAdd(&(bar)[XB_TMO], 1u); break; } } } } while (0)
struct XcdBarrier { unsigned* bar; unsigned x; volatile LAS unsigned* st; };
__device__ __forceinline__ XcdBarrier xcd_barrier_post(unsigned* bar, volatile LAS unsigned* st) {
    XcdBarrier b; b.bar = bar; b.x = xb_xcc_id(); b.st = st;
    if (threadIdx.x == 0) (void)xb_add(&bar[XB_XCNT(b.x)], 1u);
    return b;
}
__device__ __forceinline__ void xcd_barrier_complete(unsigned* bar, unsigned x, unsigned& nloc, unsigned& nx) {
    const unsigned G = gridDim.x * gridDim.y * gridDim.z;
    unsigned sum, cnt, mine, sp = 0u;
    for (;;) {
        sum = 0u; cnt = 0u; mine = 0u;
#pragma unroll
        for (unsigned j = 0; j < 16; ++j) { const unsigned c = xb_ld(&bar[XB_XCNT(j)]); sum += c; cnt += (c > 0u) ? 1u : 0u; mine = (j == x) ? c : mine; }
        if (sum == G) break;
        __builtin_amdgcn_s_sleep(1);
        if ((++sp & 255u) == 0u) { if (xb_ld(&bar[XB_TMO])) break; if (sp > XB_SPIN_CAP) { atomicAdd(&bar[XB_TMO], 1u); break; } }
    }
    nloc = mine > 0u ? mine : 1u; nx = cnt > 0u ? cnt : 1u;
}
__device__ __forceinline__ void xcd_barrier(const XcdBarrier& b) {
    asm volatile("s_waitcnt vmcnt(0)" ::: "memory");
    __syncthreads();
    if (threadIdx.x == 0) {
        unsigned* bar = b.bar;
        __builtin_amdgcn_s_waitcnt(0);
        unsigned nloc = b.st[0], nx = b.st[1];
        if (nloc == 0u) { xcd_barrier_complete(bar, b.x, nloc, nx); b.st[0] = nloc; b.st[1] = nx; }
        const unsigned old = xb_add(&bar[XB_XSUB(b.x)], 1u);
        const unsigned gen = old / nloc;
        if (old + 1u == (gen + 1u) * nloc) {
            __builtin_amdgcn_fence(__ATOMIC_RELEASE, "agent");
            asm volatile("s_waitcnt vmcnt(0)" ::: "memory");
            const unsigned og = xb_add(&bar[XB_TOP], 1u);
            const unsigned tg = og / nx;
            if (og + 1u == (tg + 1u) * nx) xb_add(&bar[XB_TOPGEN], 1u);
            else XB_SPIN(xb_ld(&bar[XB_TOPGEN]) == tg, bar);
            __builtin_amdgcn_fence(__ATOMIC_ACQUIRE, "agent");
            xb_add(&bar[XB_XGEN(b.x)], 1u);
            asm volatile("s_waitcnt vmcnt(0)" ::: "memory");
        } else {
            XB_SPIN(xb_ld(&bar[XB_XGEN(b.x)]) == gen, bar);
            __builtin_amdgcn_fence(__ATOMIC_ACQUIRE, "agent");
            asm volatile("s_waitcnt vmcnt(0)" ::: "memory");
        }
    }
    __syncthreads();
}

extern "C" __global__ void __launch_bounds__(512) mega(Params p) {
    extern __shared__ __attribute__((aligned(16))) unsigned char smem_raw[];
    LAS unsigned char* lds = (LAS unsigned char*)smem_raw;
    const int w = blockIdx.x, G = gridDim.x;
    volatile LAS unsigned* bst = (volatile LAS unsigned*)(lds + LDS_BYTES - 16);
    if (threadIdx.x == 0) { bst[0] = 0u; bst[1] = 0u; }
    __syncthreads();
    XcdBarrier xb; xb.bar = (unsigned*)(p.ws + WS_BAR); xb.x = 0; xb.st = bst;
    if (p.use_sync == 1) xb = xcd_barrier_post((unsigned*)(p.ws + WS_BAR), bst);
    for (int i = p.i_lo; i < p.i_hi; ++i) {
        #ifndef NO_WCONV
        if (i < 3) { stage_wconv(p, lds, i == 0 ? 0 : (i == 1 ? 2304 : 3968), i == 0 ? 2304 : (i == 1 ? 3968 : 4672)); __syncthreads(); }
#endif
        #ifndef NO_SCAN
        { const int s = i - 3; if (valid_slab(s)) { stage_scan(p, s, lds); __syncthreads(); } }
#endif
        const int sd = i - 9, s1 = i - 1, su = i - 7, so = i - 5;
        const int nd = valid_slab(sd) ? slab_panels(sd) * 4 : 0, n1 = valid_slab(s1) ? slab_panels(s1) * 36 : 0, nu = valid_slab(su) ? slab_panels(su) * 22 : 0, no = valid_slab(so) ? slab_panels(so) * 4 : 0;
        const int ns = (valid_slab(i - 3) && i - 3 < 8) ? 16 : 0;
        const int cs = (n1 + nu + no <= 3 * (G - (nd > 0 && sd >= SPLIT_FROM ? 2 * nd : nd) - ns)) ? 3 : 2;
        const bool dsplit = nd > 0 && sd >= SPLIT_FROM; const int ndw = dsplit ? 2 * nd : nd;
        if (nd) { DealDown S; S.w = w; S.G = G; S.n = ndw; S.npm = slab_panels(sd); S.split = dsplit ? 1 : 0;
            Gemm g; g.base = (const char*)p.ws; g.oA0 = (long)(WS_H + (size_t)(sd & 1) * SZ_H); g.dA1 = dsplit ? (long)4096 * 1408 * 2 : 0; g.dA2 = 0; g.oB0 = dsplit ? (long)WS_WD2 : (long)WS_WD; g.dB1 = dsplit ? (long)1024 * 1408 * 2 : 0; g.dB2 = 0; g.K = dsplit ? 1408 : 2816;
            EpiRes E; E.resp = nullptr; E.ress = nullptr; E.resb = (const bf16_t*)(p.ws + WS_X1B + (size_t)(sd & 3) * SZ_G1); E.pre = (bf16_t*)(p.ws + WS_PRE2 + (size_t)(sd & 1) * SZ_G1); E.pre2b = (bf16_t*)(p.ws + WS_PRE2B + (size_t)(sd & 1) * SZ_G1); E.y = p.out + O_YP; E.stats = (float*)(p.ws + WS_STATS); E.s = sd; E.soff = dsplit ? -1 : 2; E.mode = 1;
            pg8::gemm_phase<EpiRes, DealDown, false>(lds, g, S, E, nullptr); __syncthreads(); }
        if (n1 + nu + no) { Deal S; S.w = w; S.G = G; S.nd = ndw; S.ns = ns; S.cs = cs; S.n1 = n1; S.nu = nu; S.no = no; S.p1 = n1 ? slab_panels(s1) : 1; S.pu = nu ? slab_panels(su) : 1; S.po = no ? slab_panels(so) : 1;
            Gemm g; g.base = (const char*)p.ws; g.K = 1024;
            { const long a0 = (long)(WS_XB + (size_t)(s1 & 1) * SZ_XB), a1 = (long)(WS_X1B + (size_t)(su & 3) * SZ_G1), a2 = (long)(WS_MIX + (size_t)(so & 1) * SZ_G1);
              g.oA0 = a0; g.dA1 = a1 - a0; g.dA2 = a2 - a1; g.oB0 = (long)WS_WIN; g.dB1 = (long)WS_WUP - (long)WS_WIN; g.dB2 = (long)WS_WO - (long)WS_WUP; }
            EpiMulti E; E.e0.qkv = (bf16_t*)(p.ws + WS_QKV + (size_t)(s1 & 1) * SZ_QKV); E.e0.gate = (bf16_t*)(p.ws + WS_GATE + (size_t)(s1 & 3) * SZ_GATE); E.e0.gnorm = p.in[10];
            E.e1.av = (bf16_t*)(p.ws + WS_AV + (size_t)(su & 1) * SZ_AV);
            E.e2.resp = p.in[0]; E.e2.ress = p.in[1]; E.e2.resb = nullptr; E.e2.pre = (bf16_t*)(p.ws + WS_PRE1 + (size_t)(so & 1) * SZ_G1); E.e2.pre2b = nullptr; E.e2.y = nullptr; E.e2.stats = (float*)(p.ws + WS_STATS); E.e2.s = so; E.e2.soff = 0; E.e2.mode = 0;
            pg8::gemm_phase<EpiMulti, Deal, false>(lds, g, S, E, nullptr); __syncthreads(); }
        const int Gl = G - ns;
        int V = Gl, vid0 = w < Gl ? w : -1, vid1 = -1;
        { const int T = n1 + nu + no;
          if (ndw > 0 && T <= G - ndw - ns) {
              V = Gl - ndw; vid0 = (w >= ndw && w < Gl) ? w - ndw : -1; }
          else if (T > 0) { int rs = 0, before = 0, cap = 0;
              for (;;) { cap = G - (rs < 3 ? ndw : 0) - (rs < cs ? ns : 0); if (before + cap >= T || cap <= 0) break; before += cap; ++rs; }
              const int cl = T - before;
              const bool part = (w >= ndw || rs >= 3) && w < Gl; const int rank = w - (rs < 3 ? (w < ndw ? w : ndw) : 0);
              const int capl = cap - ((rs >= cs) ? ns : 0);
              if (cl > 0 && cl < capl) { V = Gl + (capl - cl); if (part && rank >= cl) vid1 = Gl + (rank - cl); } } }
        for (int rep_ = 0; rep_ < 2; ++rep_) { const int vid = rep_ ? vid1 : vid0; if (vid < 0) continue;
            if (valid_slab(i)) for (int r_ = 0; r_ < (p.pad & 15); ++r_) { stage_cvt(p, i, lds, vid, V); __syncthreads(); }
            if (valid_slab(i - 2)) for (int r_ = 0; r_ < ((p.pad >> 4) & 15); ++r_) { stage_prep(p, i - 2, lds, vid, V); __syncthreads(); }
            if (valid_slab(i - 4)) for (int r_ = 0; r_ < ((p.pad >> 8) & 15); ++r_) stage_merge(p, i - 4, vid, V);
            if (valid_slab(i - 6)) stage_ln(p, i - 6, 0, vid, V);
            if (valid_slab(i - 8)) for (int r_ = 0; r_ < ((p.pad >> 12) & 15); ++r_) stage_glu(p, i - 8, vid, V);
            if (valid_slab(i - 10)) stage_ln(p, i - 10, 1, vid, V);
        }
        if (i + 1 < p.i_hi) { if (p.use_sync == 1) xcd_barrier(xb); else if (p.use_sync == 2) cg::this_grid().sync(); }
    }
}

#ifndef REPS
#define REPS 0x11111
#endif
#ifndef MK_LAUNCHES
#define MK_LAUNCHES 1
#endif
extern "C" void kernel_launch(void* const* d_in, const int* in_sizes, int n_in, void* d_out, int out_size, void* d_ws, size_t ws_size, hipStream_t stream) {
    static int grid = 0;
    if (grid == 0) {
        int dev = 0, cus = 0, per_cu = 0;
        hipGetDevice(&dev); hipDeviceGetAttribute(&cus, hipDeviceAttributeMultiprocessorCount, dev);
        if (hipFuncSetAttribute((const void*)mega, hipFuncAttributeMaxDynamicSharedMemorySize, LDS_BYTES) != hipSuccess) fprintf(stderr, "hipFuncSetAttribute failed\n");
        if (hipOccupancyMaxActiveBlocksPerMultiprocessor(&per_cu, (const void*)mega, 512, LDS_BYTES) != hipSuccess || per_cu < 1) { fprintf(stderr, "occupancy query: %d\n", per_cu); per_cu = 1; }
        (void)hipGetLastError();
        grid = cus * 1;
        if (ws_size < WS_END) { fprintf(stderr, "workspace too small: %zu < %zu\n", ws_size, (size_t)WS_END); grid = -1; }
    }
    if (grid < 0) return;
    if (hipMemsetAsync((unsigned char*)d_ws + WS_BAR, 0, 16384, stream) != hipSuccess) fprintf(stderr, "memset of barrier words failed\n");
    Params p{};
    for (int i = 0; i < 20; ++i) p.in[i] = (const float*)d_in[i];
    p.out = (float*)d_out; p.ws = (unsigned char*)d_ws;
#if MK_LAUNCHES == 1
    p.i_lo = 0; p.i_hi = NINT; p.use_sync = 1; p.pad = REPS;
    void* args[] = {&p};
    hipError_t e = hipLaunchCooperativeKernel((const void*)mega, dim3(grid), dim3(512), args, LDS_BYTES, stream);
    if (e != hipSuccess) fprintf(stderr, "cooperative launch failed: %s (grid %d)\n", hipGetErrorString(e), grid);
#else
    for (int i = 0; i < NINT; ++i) { p.i_lo = i; p.i_hi = i + 1; p.use_sync = 0; p.pad = 0; hipLaunchKernelGGL(mega, dim3(grid), dim3(512), LDS_BYTES, stream, p); }
#endif
}
```

```cpp
#include <hip/hip_runtime.h>
#include <hip/hip_cooperative_groups.h>
#include <cstdio>
namespace cg = cooperative_groups;
__device__ __forceinline__ int opaque_tid() { int t; asm volatile("v_mov_b32 %0, %1" : "=v"(t) : "v"(threadIdx.x)); return t; }
namespace pg8 {
#define PG8_LAS __attribute__((address_space(3)))
typedef unsigned short bf16_t;
typedef short bf16x8 __attribute__((ext_vector_type(8)));
typedef float f32x4 __attribute__((ext_vector_type(4)));
typedef unsigned u32x4 __attribute__((ext_vector_type(4)));
constexpr int BM = 256, BK = 64, HALF = 128, HTB = HALF * BK * 2  , STAGE_BYTES = 8 * HTB, NXCD = 8, WGM = 8;
__host__ __device__ __forceinline__ int lds_byte(int r, int c) { const int st = (r >> 4) * 2 + (c >> 5), rr = r & 15, cc = c & 31, ob = rr * 64 + cc * 2; return st * 1024 + (ob ^ (((ob >> 9) & 1) << 5)); }
__host__ __device__ __forceinline__ void stage_rc(int b, int& R, int& C) { const int st = b / 1024, sb = b % 1024, swz = sb ^ (((sb >> 9) & 1) << 5); R = (st >> 1) * 16 + swz / 64; C = (st & 1) * 32 + (swz % 64) / 2; }
__host__ __device__ __forceinline__ int perm32(int rho) { const int n = rho >> 4, i = rho & 15; return 8 * (i >> 2) + 4 * n + (i & 3); }
struct Unit { int pm, pn, ty; };
struct Gemm { const char* base; long oA0, dA1, dA2, oB0, dB1, dB2; int K;
    __device__ __forceinline__ const char* selA(int ty) const { return base + oA0 + (long)(ty > 0) * dA1 + (long)(ty > 1) * dA2; }
    __device__ __forceinline__ const char* selB(int ty) const { return base + oB0 + (long)(ty > 0) * dB1 + (long)(ty > 1) * dB2; } };
typedef float f32x2c_ __attribute__((ext_vector_type(2))); typedef __bf16 bf16x2c_ __attribute__((ext_vector_type(2)));
__device__ __forceinline__ unsigned cvt_pk_bf16(float lo, float hi) { const f32x2c_ v = {lo, hi}; const bf16x2c_ b = __builtin_convertvector(v, bf16x2c_); return __builtin_bit_cast(unsigned, b); }
typedef float f32x2 __attribute__((ext_vector_type(2)));
template <class Epi, class Sched, bool STAMP = false>
__device__ __forceinline__ void gemm_phase(PG8_LAS unsigned char* lds, const Gemm g, const Sched& S, const Epi& E, unsigned long long* stamps) {
    const int tid = opaque_tid(), wid = __builtin_amdgcn_readfirstlane(tid >> 6), lane = tid & 63, wr = wid >> 2, wc = wid & 3, fr = lane & 15, fq = lane >> 4;
    const int K = g.K, nt = K / BK;
    int ts_lo = 0, ts_hi = 0, nts = 0; const unsigned long long rt_entry = STAMP ? (unsigned long long)wall_clock64() : 0ull;
#define PG8_STAMP() do { if (STAMP && wid == 0 && nts < 64) { const unsigned long long _c = (unsigned long long)clock64(); \
        ts_lo = (lane == nts) ? (int)(unsigned)_c : ts_lo; ts_hi = (lane == nts) ? (int)(unsigned)(_c >> 32) : ts_hi; ++nts; } } while (0)
    PG8_STAMP();
    unsigned voffA[2], voffB[2];
#pragma unroll
    for (int i = 0; i < 2; ++i) { int R, C; stage_rc(tid * 16 + i * 8192, R, C); const int Rb = Epi::PERM ? ((R & ~31) + perm32(R & 31)) : R;
        voffA[i] = (unsigned)(R * K + C) * 2u; voffB[i] = (unsigned)(Rb * K + C) * 2u; }
    const size_t kstep = (size_t)(BK * 2);
    const size_t hstep = (size_t)HALF * K * 2;
    const size_t tstep = 2 * hstep;
    const unsigned ldsw = (unsigned)wid * 1024u;
    const int aoff = lds_byte(wr * 64 + fr, fq * 8), boff = lds_byte(wc * 32 + fr, fq * 8);
#define PG8_SA(b, h) (((b) * 2 + (h)) * HTB)
#define PG8_SB(b, h) ((4 + (b) * 2 + (h)) * HTB)
#define PG8_STAGE(bufoff, gbase, voff) do { _Pragma("unroll") for (int _i = 0; _i < 2; ++_i) \
        __builtin_amdgcn_global_load_lds((const unsigned*)((const char*)(gbase) + (voff)[_i]), (PG8_LAS unsigned*)(lds + (bufoff) + ldsw + _i * 8192), 16, 0, 0); } while (0)
#define PG8_LDA(dst, b, h) do { _Pragma("unroll") for (int m = 0; m < 4; ++m) _Pragma("unroll") for (int k = 0; k < 2; ++k) dst[m][k] = *(const PG8_LAS bf16x8*)(lds + PG8_SA(b, h) + aoff + m * 2048 + k * 1024); } while (0)
#define PG8_LDB(dst, b, h) do { _Pragma("unroll") for (int n = 0; n < 2; ++n) _Pragma("unroll") for (int k = 0; k < 2; ++k) dst[n][k] = *(const PG8_LAS bf16x8*)(lds + PG8_SB(b, h) + boff + n * 2048 + k * 1024); } while (0)
#define PG8_MMA(ai, bj, At, Bt) do { __builtin_amdgcn_s_setprio(1); _Pragma("unroll") for (int m = 0; m < 4; ++m) _Pragma("unroll") for (int n = 0; n < 2; ++n) _Pragma("unroll") for (int k = 0; k < 2; ++k) \
        acc[ai][bj][m][n] = __builtin_amdgcn_mfma_f32_16x16x32_bf16(Bt[n][k], At[m][k], acc[ai][bj][m][n], 0, 0, 0); __builtin_amdgcn_s_setprio(0); } while (0)
#define PG8_WAIT_V(n) asm volatile("s_waitcnt vmcnt(" #n ")" ::: "memory")
#define PG8_WAIT_L(n) asm volatile("s_waitcnt lgkmcnt(" #n ")" ::: "memory")
#define PG8_BAR __builtin_amdgcn_s_barrier()
#define PG8_SCHED __builtin_amdgcn_sched_barrier(0)
    Unit cur, nxt; int ui = 0;
    if (!S.next(0, cur)) return;
    f32x4 acc[2][2][4][2];
#pragma unroll
    for (int a = 0; a < 2; ++a)
#pragma unroll
        for (int b = 0; b < 2; ++b)
#pragma unroll
            for (int m = 0; m < 4; ++m)
#pragma unroll
                for (int n = 0; n < 2; ++n) acc[a][b][m][n] = (f32x4){0.f, 0.f, 0.f, 0.f};
    bf16x8 At[4][2], B0[2][2], B1[2][2];
    const char* cA = g.selA(cur.ty) + (size_t)cur.pm * tstep; const char* cB = g.selB(cur.ty) + (size_t)cur.pn * tstep;
    S.a_ready(cur);
    PG8_STAGE(PG8_SB(0, 0), cB, voffB); PG8_STAGE(PG8_SA(0, 0), cA, voffA); PG8_STAGE(PG8_SB(0, 1), cB + hstep, voffB); PG8_STAGE(PG8_SA(0, 1), cA + hstep, voffA);
    if (wr == 1) PG8_BAR;
    PG8_WAIT_V(4); PG8_BAR;
    PG8_STAGE(PG8_SB(1, 0), cB + kstep, voffB); PG8_STAGE(PG8_SA(1, 0), cA + kstep, voffA); PG8_STAGE(PG8_SB(1, 1), cB + hstep + kstep, voffB);
    PG8_WAIT_V(6); PG8_BAR;
    PG8_STAMP();
    for (;;) {
        const bool has_next = S.next(ui + 1, nxt);
        const char* nA = has_next ? g.selA(nxt.ty) + (size_t)nxt.pm * tstep : cA; const char* nB = has_next ? g.selB(nxt.ty) + (size_t)nxt.pn * tstep : cB;
        for (int t = 0; t < nt; t += 2) {
            const bool last = (t == nt - 2);
            const char* a1 = cA + (size_t)(t + 1) * kstep;
            const char* a2 = last ? nA : cA + (size_t)(t + 2) * kstep; const char* b2 = last ? nB : cB + (size_t)(t + 2) * kstep;
            const char* a3 = a2 + kstep; const char* b3 = b2 + kstep;
            if (last && has_next) S.a_ready(nxt);
            PG8_LDB(B0, 0, 0); PG8_SCHED; PG8_LDA(At, 0, 0); PG8_STAGE(PG8_SA(1, 1), a1 + hstep, voffA);
            PG8_WAIT_L(8); PG8_BAR; PG8_WAIT_L(0); PG8_MMA(0, 0, At, B0); PG8_BAR; PG8_SCHED;
            PG8_LDB(B1, 0, 1); PG8_STAGE(PG8_SB(0, 0), b2, voffB);
            PG8_BAR; PG8_WAIT_L(0); PG8_MMA(0, 1, At, B1); PG8_BAR;
            PG8_LDA(At, 0, 1); PG8_STAGE(PG8_SA(0, 0), a2, voffA);
            PG8_BAR; PG8_WAIT_L(0); PG8_MMA(1, 0, At, B0); PG8_BAR; PG8_SCHED;
            PG8_STAGE(PG8_SB(0, 1), b2 + hstep, voffB);
            PG8_WAIT_V(6); PG8_BAR; PG8_MMA(1, 1, At, B1); PG8_BAR;
            PG8_LDB(B0, 1, 0); PG8_SCHED; PG8_LDA(At, 1, 0); PG8_STAGE(PG8_SA(0, 1), a2 + hstep, voffA);
            PG8_WAIT_L(8); PG8_BAR; PG8_WAIT_L(0); PG8_MMA(0, 0, At, B0); PG8_BAR; PG8_SCHED;
            PG8_LDB(B1, 1, 1); PG8_STAGE(PG8_SB(1, 0), b3, voffB);
            PG8_BAR; PG8_WAIT_L(0); PG8_MMA(0, 1, At, B1); PG8_BAR;
            PG8_LDA(At, 1, 1); PG8_STAGE(PG8_SA(1, 0), a3, voffA);
            PG8_BAR; PG8_WAIT_L(0); PG8_MMA(1, 0, At, B0); PG8_BAR; PG8_SCHED;
            PG8_STAGE(PG8_SB(1, 1), b3 + hstep, voffB);
            PG8_WAIT_V(6); PG8_BAR; PG8_MMA(1, 1, At, B1); PG8_BAR;
        }
        PG8_STAMP();
        if constexpr (!Epi::AFTER_DRAIN) { E(acc, cur, wr, wc, fr, fq); S.done(cur); }
        PG8_STAMP();
        if (!has_next) break;
#pragma unroll
        for (int a = 0; a < 2; ++a)
#pragma unroll
            for (int b = 0; b < 2; ++b)
#pragma unroll
                for (int m = 0; m < 4; ++m)
#pragma unroll
                    for (int n = 0; n < 2; ++n) acc[a][b][m][n] = (f32x4){0.f, 0.f, 0.f, 0.f};
        cur = nxt; cA = nA; cB = nB; ++ui;
    }
    PG8_WAIT_V(0);
    if (wr == 0) PG8_BAR;
    PG8_BAR;
    if constexpr (Epi::AFTER_DRAIN) { E.fused(acc, cur, wr, wc, fr, fq, lds, wid, lane); S.done(cur); }
    PG8_STAMP();
    if (STAMP && wid == 0) { stamps[lane] = lane < nts ? (((unsigned long long)(unsigned)ts_hi << 32) | (unsigned)ts_lo) : 0ull;
        if (lane == 62) stamps[62] = rt_entry; if (lane == 63) stamps[63] = (unsigned long long)wall_clock64(); }
#undef PG8_STAMP
#undef PG8_SA
#undef PG8_SB
#undef PG8_STAGE
#undef PG8_LDA
#undef PG8_LDB
#undef PG8_MMA
#undef PG8_WAIT_V
#undef PG8_WAIT_L
#undef PG8_BAR
#undef PG8_SCHED
}
}

using pg8::bf16_t; using pg8::bf16x8; using pg8::f32x4; using pg8::u32x4; using pg8::Unit; using pg8::Gemm; using pg8::cvt_pk_bf16;
typedef unsigned u32x2 __attribute__((ext_vector_type(2)));
#define LAS __attribute__((address_space(3)))
constexpr int NSLAB = 9, NSTAGE = 11, NINT = NSLAB + NSTAGE - 1;
constexpr int IN_DIM = 9232;
constexpr float ALPHA = 1.189207115002721f;
constexpr int LDS_BYTES = 152 * 1024;
constexpr size_t O_YP = 0, O_PGC = 34078720, O_PS = 34097152, O_PSC = 34359296, O_PFF = 34363392, O_SGC = 34374656, O_SS = 34669568, O_SSC = 38863872, O_SFF = 38929408;
constexpr int R_W = 0, R_QD = 16384, R_KT = 32768, R_QK = 49152, R_U = 57344, R_HDR = 73728, REC_BYTES = 73984;
constexpr size_t A256(size_t x) { return (x + 255) & ~(size_t)255; }
constexpr size_t WS_WIN = 0;
constexpr size_t WS_WO = WS_WIN + (size_t)9216 * 1024 * 2;
constexpr size_t WS_WUP = WS_WO + (size_t)1024 * 1024 * 2;
constexpr size_t WS_WD = WS_WUP + (size_t)5632 * 1024 * 2;
constexpr size_t WS_XB = WS_WD + (size_t)1024 * 2816 * 2;
constexpr size_t SZ_XB = (size_t)4096 * 1024 * 2;
constexpr size_t WS_AB = WS_XB + 2 * SZ_XB;
constexpr size_t WS_QKV = A256(WS_AB + (size_t)33280 * 16 * 4);
constexpr size_t SZ_QKV = (size_t)4096 * 3072 * 2;
constexpr size_t WS_GATE = WS_QKV + 2 * SZ_QKV;
constexpr size_t SZ_G1 = (size_t)4096 * 1024 * 2, SZ_GATE = 3 * SZ_G1;
constexpr size_t WS_REC = WS_GATE + 4 * SZ_GATE;
constexpr size_t SZ_REC = (size_t)512 * REC_BYTES;
constexpr size_t WS_ORAW = WS_REC + 2 * SZ_REC;
constexpr size_t WS_MIX = WS_ORAW + 2 * SZ_G1;
constexpr size_t WS_X1B = WS_MIX + 2 * SZ_G1;
constexpr size_t WS_AV = WS_X1B + 4 * SZ_G1;
constexpr size_t SZ_AV = (size_t)4096 * 5632 * 2;
constexpr size_t WS_H = WS_AV + 2 * SZ_AV;
constexpr size_t SZ_H = (size_t)4096 * 2816 * 2;
constexpr size_t WS_STATS = WS_H + 2 * SZ_H;
constexpr size_t WS_HQ = WS_STATS + (size_t)33280 * 16;
constexpr size_t SZ_HQ = (size_t)2 * 3 * 3072 * 4;
constexpr size_t WS_HS = WS_HQ + 2 * SZ_HQ;
constexpr size_t SZ_HS = (size_t)2 * 2 * 1024 * 4;
constexpr size_t WS_HF = WS_HS + 2 * SZ_HS;
constexpr size_t SZ_HF = (size_t)2 * 2 * 2816 * 4;
constexpr size_t WS_BAR = A256(WS_HF + 2 * SZ_HF);
constexpr size_t WS_PRE1 = WS_BAR + 16384;
constexpr size_t WS_PRE2 = WS_PRE1 + 2 * SZ_G1;
constexpr size_t WS_PRE2B = WS_PRE2 + 2 * SZ_G1;
constexpr size_t WS_WD2 = WS_PRE2B + 2 * SZ_G1;
constexpr size_t WS_END = WS_WD2 + (size_t)2 * 1024 * 1408 * 2;
constexpr int SPLIT_FROM = 5;

struct Params { const float* in[20]; float* out; unsigned char* ws; int i_lo, i_hi, use_sync, pad; };

__device__ __forceinline__ float bf2f(unsigned short b) { return __uint_as_float((unsigned)b << 16); }
__device__ __forceinline__ float bflo(unsigned w) { return __uint_as_float(w << 16); }
__device__ __forceinline__ float bfhi(unsigned w) { return __uint_as_float(w & 0xffff0000u); }
__device__ __forceinline__ unsigned short f2bf(float f) { return (unsigned short)(cvt_pk_bf16(f, 0.f) & 0xffffu); }
__device__ __forceinline__ float sigmoidf_(float x) { return __builtin_amdgcn_rcpf(1.0f + __expf(-x)); }
__device__ __forceinline__ float gelu_f(float v) {
    const float av = fabsf(v), t = __builtin_amdgcn_rcpf(av * 0.2316418882f + 1.0f);
    float q = t * 0.5307027145f + (-0.7265760135f); q = q * t + 0.7107068705f; q = q * t + (-0.142248368f); q = q * t + 0.127414796f; q = q * t;
    const float e = __builtin_amdgcn_exp2f(v * v * (-0.72134752044f)), m = v * (q * e);
    return v < 0.f ? m : v - m; }
typedef float f32x2_ __attribute__((ext_vector_type(2)));
__device__ __forceinline__ f32x2_ gelu_pk(f32x2_ v) {
    const f32x2_ av = __builtin_elementwise_abs(v), d = av * 0.2316418882f + 1.0f;
    f32x2_ t; t.x = __builtin_amdgcn_rcpf(d.x); t.y = __builtin_amdgcn_rcpf(d.y);
    f32x2_ q = t * 0.5307027145f + (-0.7265760135f); q = q * t + 0.7107068705f; q = q * t + (-0.142248368f); q = q * t + 0.127414796f; q = q * t;
    const f32x2_ s = (v * v) * (-0.72134752044f);
    f32x2_ e; e.x = __builtin_amdgcn_exp2f(s.x); e.y = __builtin_amdgcn_exp2f(s.y);
    const f32x2_ m = v * (q * e), r = v - m;
    f32x2_ o; o.x = v.x < 0.f ? m.x : r.x; o.y = v.y < 0.f ? m.y : r.y; return o;
}
__device__ __forceinline__ int slab_rows(int s) { return s < 8 ? 4096 : 512; }
__device__ __forceinline__ int slab_panels(int s) { return s < 8 ? 16 : 2; }
__device__ __forceinline__ int grow_of(int s, int lr) { return s < 8 ? ((lr >> 11) * 16384 + s * 2048 + (lr & 2047)) : (32768 + lr); }
__device__ __forceinline__ const float* xrow(const Params& p, int grow) { return grow < 32768 ? p.in[0] + (size_t)grow * 1024 : p.in[1] + (size_t)(grow - 32768) * 1024; }
__device__ __forceinline__ bool valid_slab(int s) { return s >= 0 && s < NSLAB; }

struct Deal {
    int w, G, nd, ns, cs, n1, nu, no, p1, pu, po;
    __device__ __forceinline__ int cand(int i) const { const int busy = w < nd ? 3 : (w >= G - ns ? cs : 0), r = busy + i;
        const int before = r * G - nd * (r < 3 ? r : 3) - ns * (r < cs ? r : cs), rank = w - (r < 3 ? (w < nd ? w : nd) : 0); return before + rank; }
    __device__ __forceinline__ static void map16(int j, int N, int& pm, int& pn) { const int x = j & 7, t = j >> 3; pm = 4 * (x & 3) + (t & 3); pn = 2 * (t >> 2) + (x >> 2); (void)N; }
    __device__ __forceinline__ bool next(int i, Unit& u) const { const int q = cand(i); if (q >= n1 + nu + no) return false;
        if (q < n1) { u.ty = 0; if (p1 == 16) map16(q, 36, u.pm, u.pn); else { u.pm = q % p1; u.pn = q / p1; } }
        else if (q < n1 + nu) { const int j = q - n1; u.ty = 1; if (pu == 16) map16(j, 22, u.pm, u.pn); else { u.pm = j % pu; u.pn = j / pu; } }
        else { const int j = q - n1 - nu; u.ty = 2; if (po == 16) map16(j, 4, u.pm, u.pn); else { u.pm = j % po; u.pn = j / po; } }
        return true; }
    __device__ __forceinline__ void a_ready(const Unit&) const {}
    __device__ __forceinline__ void done(const Unit&) const {}
};
struct DealDown {
    int w, G, n, npm, split;
    __device__ __forceinline__ bool next(int i, Unit& u) const { const int j = w + i * G; if (j >= n || (n <= G && i > 0)) return false; const int t = split ? (j >> 1) : j; u.pm = t % npm; u.pn = t / npm; u.ty = split ? (j & 1) : 0; return true; }
    __device__ __forceinline__ void a_ready(const Unit&) const {}
    __device__ __forceinline__ void done(const Unit&) const {}
};

struct EpiIn {
    static constexpr bool PERM = true, AFTER_DRAIN = false;
    bf16_t* qkv; bf16_t* gate; const float* gnorm;
    __device__ __forceinline__ void operator()(const f32x4 (&acc)[2][2][4][2], const Unit& u, int wr, int wc, int fr, int fq) const {
        const int row0 = u.pm * 256 + wr * 64 + fr;
        if (u.pn < 12) {
#pragma unroll
            for (int ai = 0; ai < 2; ++ai)
#pragma unroll
                for (int m = 0; m < 4; ++m) { bf16_t* rowp = qkv + (size_t)(row0 + ai * 128 + m * 16) * 3072 + u.pn * 256 + wc * 32 + 8 * fq;
#pragma unroll
                    for (int bj = 0; bj < 2; ++bj) { const f32x4 v0 = acc[ai][bj][m][0], v1 = acc[ai][bj][m][1]; u32x4 w;
                        w.x = cvt_pk_bf16(v0[0], v0[1]); w.y = cvt_pk_bf16(v0[2], v0[3]); w.z = cvt_pk_bf16(v1[0], v1[1]); w.w = cvt_pk_bf16(v1[2], v1[3]);
                        *(u32x4*)(rowp + bj * 128) = w; } }
        } else {
            const int type = (u.pn - 12) >> 3, j = (u.pn - 12) & 7, ch = j * 128 + wc * 32 + 8 * fq;
            bf16_t* base = gate + (size_t)type * 4096 * 1024 + ch;
            float gn[8];
#pragma unroll
            for (int k = 0; k < 8; ++k) gn[k] = (type == 0) ? gnorm[(ch + k) & 127] : 1.0f;
#pragma unroll
            for (int ai = 0; ai < 2; ++ai)
#pragma unroll
                for (int m = 0; m < 4; ++m) { float o[8];
#pragma unroll
                    for (int n = 0; n < 2; ++n)
#pragma unroll
                        for (int k = 0; k < 4; k += 2) { const f32x2_ X = {acc[ai][0][m][n][k], acc[ai][0][m][n][k + 1]}, Y = {acc[ai][1][m][n][k], acc[ai][1][m][n][k + 1]}; f32x2_ r;
                            if (type == 2) r = X * Y;
                            else { f32x2_ ey; ey.x = __expf(-Y.x); ey.y = __expf(-Y.y);
                                if (type == 0) { f32x2_ ex; ex.x = __expf(-X.x); ex.y = __expf(-X.y); const f32x2_ den = (ey + 1.0f) * (ex + 1.0f); f32x2_ rc; rc.x = __builtin_amdgcn_rcpf(den.x); rc.y = __builtin_amdgcn_rcpf(den.y);
                                    r = X * rc * (f32x2_){gn[n * 4 + k], gn[n * 4 + k + 1]}; }
                                else { const f32x2_ den = ey + 1.0f; f32x2_ rc; rc.x = __builtin_amdgcn_rcpf(den.x); rc.y = __builtin_amdgcn_rcpf(den.y); r = X * rc; } }
                            o[n * 4 + k] = r.x; o[n * 4 + k + 1] = r.y; }
                    u32x4 w; w.x = cvt_pk_bf16(o[0], o[1]); w.y = cvt_pk_bf16(o[2], o[3]); w.z = cvt_pk_bf16(o[4], o[5]); w.w = cvt_pk_bf16(o[6], o[7]);
                    __builtin_nontemporal_store(w, (u32x4*)(base + (size_t)(row0 + ai * 128 + m * 16) * 1024)); }
        }
    }
};
struct EpiUp {
    static constexpr bool PERM = true, AFTER_DRAIN = false;
    bf16_t* av;
    __device__ __forceinline__ void operator()(const f32x4 (&acc)[2][2][4][2], const Unit& u, int wr, int wc, int fr, int fq) const {
        const int row0 = u.pm * 256 + wr * 64 + fr;
#pragma unroll
        for (int ai = 0; ai < 2; ++ai)
#pragma unroll
            for (int m = 0; m < 4; ++m) { bf16_t* rowp = av + (size_t)(row0 + ai * 128 + m * 16) * 5632 + u.pn * 256 + wc * 32 + 8 * fq;
#pragma unroll
                for (int bj = 0; bj < 2; ++bj) { const f32x4 v0 = acc[ai][bj][m][0], v1 = acc[ai][bj][m][1]; u32x4 w;
                    w.x = cvt_pk_bf16(v0[0], v0[1]); w.y = cvt_pk_bf16(v0[2], v0[3]); w.z = cvt_pk_bf16(v1[0], v1[1]); w.w = cvt_pk_bf16(v1[2], v1[3]);
                    *(u32x4*)(rowp + bj * 128) = w; } }
    }
};
struct EpiRes {
    static constexpr bool PERM = true, AFTER_DRAIN = false;
    const float* resp; const float* ress; const bf16_t* resb; bf16_t* pre; bf16_t* pre2b; float* y; float* stats; int s, soff, mode;
    __device__ __forceinline__ void operator()(const f32x4 (&acc)[2][2][4][2], const Unit& u, int wr, int wc, int fr, int fq) const {
        const int col0 = u.pn * 256 + wc * 32 + 8 * fq;
#pragma unroll
        for (int ai = 0; ai < 2; ++ai)
#pragma unroll
            for (int m = 0; m < 4; ++m) {
                const int lr = u.pm * 256 + ai * 128 + wr * 64 + m * 16 + fr, grow = grow_of(s, lr);
                float sm = 0.f, sq = 0.f;
                if (mode == 1 && u.ty == 1) {
                    bf16_t* op = pre2b + (size_t)lr * 1024 + col0;
#pragma unroll
                    for (int bj = 0; bj < 2; ++bj) { const f32x4 v0 = acc[ai][bj][m][0], v1 = acc[ai][bj][m][1]; u32x4 w; w.x = cvt_pk_bf16(v0[0], v0[1]); w.y = cvt_pk_bf16(v0[2], v0[3]); w.z = cvt_pk_bf16(v1[0], v1[1]); w.w = cvt_pk_bf16(v1[2], v1[3]); *(u32x4*)(op + bj * 128) = w; }
                } else if (mode == 0) {
                    const float* rp = (grow < 32768 ? resp + (size_t)grow * 1024 : ress + (size_t)(grow - 32768) * 1024) + col0; bf16_t* op = pre + (size_t)lr * 1024 + col0;
#pragma unroll
                    for (int bj = 0; bj < 2; ++bj) { const f32x4 r0 = __builtin_nontemporal_load((const f32x4*)(rp + bj * 128)), r1 = __builtin_nontemporal_load((const f32x4*)(rp + bj * 128 + 4)); const f32x4 v0 = r0 * ALPHA + acc[ai][bj][m][0], v1 = r1 * ALPHA + acc[ai][bj][m][1];
                        u32x4 w; w.x = cvt_pk_bf16(v0[0], v0[1]); w.y = cvt_pk_bf16(v0[2], v0[3]); w.z = cvt_pk_bf16(v1[0], v1[1]); w.w = cvt_pk_bf16(v1[2], v1[3]); *(u32x4*)(op + bj * 128) = w;
                        sm += (v0[0] + v0[1]) + (v0[2] + v0[3]) + (v1[0] + v1[1]) + (v1[2] + v1[3]);
                        sq += (v0[0] * v0[0] + v0[1] * v0[1]) + (v0[2] * v0[2] + v0[3] * v0[3]) + (v1[0] * v1[0] + v1[1] * v1[1]) + (v1[2] * v1[2] + v1[3] * v1[3]); }
                } else {
                    const bf16_t* rp = resb + (size_t)lr * 1024 + col0; bf16_t* op = pre + (size_t)lr * 1024 + col0;
#pragma unroll
                    for (int bj = 0; bj < 2; ++bj) { const u32x4 rw = *(const u32x4*)(rp + bj * 128);
                        const f32x4 r0 = {bflo(rw.x), bfhi(rw.x), bflo(rw.y), bfhi(rw.y)}, r1 = {bflo(rw.z), bfhi(rw.z), bflo(rw.w), bfhi(rw.w)};
                        const f32x4 v0 = r0 * ALPHA + acc[ai][bj][m][0], v1 = r1 * ALPHA + acc[ai][bj][m][1];
                        u32x4 w; w.x = cvt_pk_bf16(v0[0], v0[1]); w.y = cvt_pk_bf16(v0[2], v0[3]); w.z = cvt_pk_bf16(v1[0], v1[1]); w.w = cvt_pk_bf16(v1[2], v1[3]); *(u32x4*)(op + bj * 128) = w;
                        sm += (v0[0] + v0[1]) + (v0[2] + v0[3]) + (v1[0] + v1[1]) + (v1[2] + v1[3]);
                        sq += (v0[0] * v0[0] + v0[1] * v0[1]) + (v0[2] * v0[2] + v0[3] * v0[3]) + (v1[0] * v1[0] + v1[1] * v1[1]) + (v1[2] * v1[2] + v1[3] * v1[3]); }
                }
                sm += __shfl_xor(sm, 16); sm += __shfl_xor(sm, 32); sq += __shfl_xor(sq, 16); sq += __shfl_xor(sq, 32);
                if (fq == 0 && soff >= 0) { atomicAdd(stats + (size_t)grow * 4 + soff, sm); atomicAdd(stats + (size_t)grow * 4 + soff + 1, sq); }
            }
    }
};
struct EpiMulti {
    static constexpr bool PERM = true, AFTER_DRAIN = false;
    EpiIn e0; EpiUp e1; EpiRes e2;
    __device__ __forceinline__ void operator()(const f32x4 (&acc)[2][2][4][2], const Unit& u, int wr, int wc, int fr, int fq) const {
        if (u.ty == 0) e0(acc, u, wr, wc, fr, fq); else if (u.ty == 1) e1(acc, u, wr, wc, fr, fq); else e2(acc, u, wr, wc, fr, fq); }
};

__device__ __forceinline__ int src_col_in(int np) {
    const int pn = np >> 8; if (pn < 12) return np;
    const int within = np & 255, half = within >> 7, cl = within & 127, type = (pn - 12) >> 3, j = (pn - 12) & 7;
    const int base = type == 0 ? (half ? 7184 : 3072) : (type == 1 ? (half ? 8208 : 4112) : (half ? 6160 : 5136));
    return base + j * 128 + cl;
}
__device__ void stage_wconv(const Params& p, LAS unsigned char* lds, int t_lo, int t_hi) {
    LAS float* t = (LAS float*)lds;
    const int tid = opaque_tid();
    for (int ti = t_lo + blockIdx.x; ti < t_hi; ti += gridDim.x) {
        const float* W; bf16_t* D; int N, K, tk, tn, which;
        if (ti < 2304) { which = 0; W = p.in[6]; D = (bf16_t*)(p.ws + WS_WIN); N = IN_DIM; K = 1024; tk = ti / 144; tn = ti % 144; }
        else if (ti < 2560) { const int q = ti - 2304; which = 1; W = p.in[12]; D = (bf16_t*)(p.ws + WS_WO); N = 1024; K = 1024; tk = q / 16; tn = q % 16; }
        else if (ti < 3968) { const int q = ti - 2560; which = 2; W = p.in[15]; D = (bf16_t*)(p.ws + WS_WUP); N = 5632; K = 1024; tk = q / 88; tn = q % 88; }
        else { const int q = ti - 3968; which = 3; W = p.in[17]; D = (bf16_t*)(p.ws + WS_WD); N = 1024; K = 2816; tk = q / 16; tn = q % 16; }
        const int c = tid & 63, r8 = tid >> 6;
        const int np = tn * 64 + c, sc = which == 0 ? src_col_in(np) : np;
#pragma unroll
        for (int i = 0; i < 8; ++i) { const int r = r8 + 8 * i; t[r * 65 + c] = W[(size_t)(tk * 64 + r) * N + sc]; }
        __syncthreads();
#pragma unroll
        for (int i = 0; i < 8; ++i) { const int rr = r8 + 8 * i; D[(size_t)(tn * 64 + rr) * K + tk * 64 + c] = f2bf(t[c * 65 + rr]); }
        if (which == 3) { bf16_t* D2 = (bf16_t*)(p.ws + WS_WD2) + (size_t)(tk >= 22) * 1024 * 1408 + (size_t)(tn * 64) * 1408 + (tk >= 22 ? tk - 22 : tk) * 64 + c;
#pragma unroll
            for (int i = 0; i < 8; ++i) { const int rr = r8 + 8 * i; D2[(size_t)rr * 1408] = f2bf(t[c * 65 + rr]); } }
        __syncthreads();
    }
}

__device__ void stage_cvt(const Params& p, int s, LAS unsigned char* lds, int vid, int V) {
    LAS float* sW = (LAS float*)lds;
    const int tid = opaque_tid(), wid = tid >> 6, lane = tid & 63;
    for (int idx = tid; idx < 4096; idx += 512) { const int k = idx >> 2, q = idx & 3; const f32x4 wv4 = *(const f32x4*)(p.in[6] + (size_t)k * IN_DIM + 4096 + q * 4);
#pragma unroll
        for (int j = 0; j < 4; ++j) sW[(q * 4 + j) * 1024 + k] = wv4[j]; }
    __syncthreads();
    bf16_t* xb = (bf16_t*)(p.ws + WS_XB + (size_t)(s & 1) * SZ_XB);
    float* ab = (float*)(p.ws + WS_AB); float* stats = (float*)(p.ws + WS_STATS);
    const int rows = slab_rows(s);
    for (int lr = (vid * 8 + wid) * 2; lr < rows; lr += V * 16) {
        const int grow0 = grow_of(s, lr), grow1 = grow_of(s, lr + 1); const float* xr0 = xrow(p, grow0); const float* xr1 = xrow(p, grow1);
        f32x4 xa[4], xc[4];
#pragma unroll
        for (int i = 0; i < 4; ++i) { xa[i] = __builtin_nontemporal_load((const f32x4*)(xr0 + lane * 4 + 256 * i)); xc[i] = __builtin_nontemporal_load((const f32x4*)(xr1 + lane * 4 + 256 * i)); }
#pragma unroll
        for (int i = 0; i < 4; ++i) { u32x2 w; w.x = cvt_pk_bf16(xa[i][0], xa[i][1]); w.y = cvt_pk_bf16(xa[i][2], xa[i][3]); *(u32x2*)(xb + (size_t)lr * 1024 + lane * 4 + 256 * i) = w;
            w.x = cvt_pk_bf16(xc[i][0], xc[i][1]); w.y = cvt_pk_bf16(xc[i][2], xc[i][3]); *(u32x2*)(xb + (size_t)(lr + 1) * 1024 + lane * 4 + 256 * i) = w; }
        float a0[16], a1[16];
#pragma unroll
        for (int o = 0; o < 16; ++o) { f32x4 s0 = {0.f, 0.f, 0.f, 0.f}, s1 = {0.f, 0.f, 0.f, 0.f};
#pragma unroll
            for (int i = 0; i < 4; ++i) { const f32x4 wv = *(const LAS f32x4*)(sW + o * 1024 + lane * 4 + 256 * i); s0 += xa[i] * wv; s1 += xc[i] * wv; }
            a0[o] = (s0[0] + s0[1]) + (s0[2] + s0[3]); a1[o] = (s1[0] + s1[1]) + (s1[2] + s1[3]); if ((o & 3) == 3) __builtin_amdgcn_sched_barrier(0); }
#pragma unroll
        for (int o = 0; o < 8; ++o) { const bool hi = lane & 32; const float k0 = hi ? a0[o + 8] : a0[o], s0 = hi ? a0[o] : a0[o + 8], k1 = hi ? a1[o + 8] : a1[o], s1 = hi ? a1[o] : a1[o + 8];
            a0[o] = k0 + __shfl_xor(s0, 32); a1[o] = k1 + __shfl_xor(s1, 32); }
#pragma unroll
        for (int o = 0; o < 4; ++o) { const bool hi = lane & 16; const float k0 = hi ? a0[o + 4] : a0[o], s0 = hi ? a0[o] : a0[o + 4], k1 = hi ? a1[o + 4] : a1[o], s1 = hi ? a1[o] : a1[o + 4];
            a0[o] = k0 + __shfl_xor(s0, 16); a1[o] = k1 + __shfl_xor(s1, 16); }
#pragma unroll
        for (int o = 0; o < 2; ++o) { const bool hi = lane & 8; const float k0 = hi ? a0[o + 2] : a0[o], s0 = hi ? a0[o] : a0[o + 2], k1 = hi ? a1[o + 2] : a1[o], s1 = hi ? a1[o] : a1[o + 2];
            a0[o] = k0 + __shfl_xor(s0, 8); a1[o] = k1 + __shfl_xor(s1, 8); }
        { const bool hi = lane & 4; const float k0 = hi ? a0[1] : a0[0], s0 = hi ? a0[0] : a0[1], k1 = hi ? a1[1] : a1[0], s1 = hi ? a1[0] : a1[1];
            a0[0] = k0 + __shfl_xor(s0, 4); a1[0] = k1 + __shfl_xor(s1, 4); }
        a0[0] += __shfl_xor(a0[0], 1); a0[0] += __shfl_xor(a0[0], 2); a1[0] += __shfl_xor(a1[0], 1); a1[0] += __shfl_xor(a1[0], 2);
        if ((lane & 3) == 0) { const int o = ((lane >> 5) & 1) * 8 + ((lane >> 4) & 1) * 4 + ((lane >> 3) & 1) * 2 + ((lane >> 2) & 1); ab[(size_t)grow0 * 16 + o] = a0[0]; ab[(size_t)grow1 * 16 + o] = a1[0]; }
        if (lane < 4) { stats[(size_t)grow0 * 4 + lane] = 0.f; stats[(size_t)grow1 * 4 + lane] = 0.f; }
    }
}

constexpr int P_G = 0, P_BETA = 256, P_EG = 512, P_ET = 768, P_KB = 1024, P_QB = 18432, P_RT = 35840, P_ABF = 69632, P_ADIAG = 78336, P_TB = 82432;
constexpr int P_OW = 1024  , P_OU = 19456, P_OQD = 86016, P_OKT = 104448, P_OQK = 122880;
__device__ __forceinline__ int pslot(int chunk) { return (chunk + (chunk >> 3)) * 16; }
__device__ __forceinline__ bf16x8 mk8(unsigned a, unsigned b, unsigned c, unsigned d) { u32x4 v = {a, b, c, d}; return __builtin_bit_cast(bf16x8, v); }
__device__ void prep_unit(const Params& p, int s, int idx, LAS unsigned char* lds) {
    const int tid = opaque_tid(), wid = tid >> 6, lane = tid & 63;
    const bool sample = (s == 8);
    int h, lr0, grow0, ntok, recidx, hb  ; bool first, last;
    if (!sample) { const int b = idx >> 8, rem = idx & 255, c = rem >> 3; h = rem & 7; lr0 = b * 2048 + c * 64; grow0 = b * 16384 + s * 2048 + c * 64; ntok = 64; recidx = (b * 8 + h) * 32 + c; hb = b; first = (c == 0); last = (c == 31); }
    else { const int seq = idx >> 3; h = idx & 7; lr0 = seq * 16; grow0 = 32768 + seq * 16; ntok = 16; recidx = idx; hb = seq; first = true; last = true; }
    LAS float* sG = (LAS float*)(lds + P_G); LAS float* sBeta = (LAS float*)(lds + P_BETA); LAS float* sEG = (LAS float*)(lds + P_EG); LAS float* sET = (LAS float*)(lds + P_ET);
    unsigned char* rec = p.ws + WS_REC + (size_t)(s & 1) * SZ_REC + (size_t)recidx * REC_BYTES;
    const bf16_t* qkv = (const bf16_t*)(p.ws + WS_QKV + (size_t)(s & 1) * SZ_QKV);
    if (wid == 0) {
        const int t = lane; const bool v = t < ntok; const int gr = grow0 + (v ? t : 0);
        const float* ab = (const float*)(p.ws + WS_AB) + (size_t)gr * 16;
        const float bl = ab[h], al = ab[8 + h] + p.in[9][h];
        const float sp = al > 20.f ? al : log1pf(__expf(al));
        float g = v ? -__expf(p.in[8][h]) * sp : 0.f; const float beta = v ? sigmoidf_(bl) : 0.f;
#pragma unroll
        for (int d = 1; d < 64; d <<= 1) { const float o = __shfl_up(g, d); if (lane >= d) g += o; }
        const float gl = __shfl(g, 63);
        sG[t] = g; sBeta[t] = beta; sEG[t] = __expf(g); sET[t] = __expf(gl - g);
        if (lane == 0) *(float*)(rec + R_HDR) = __expf(gl);
    }
    __syncthreads();
    const float* cw = p.in[7];
#pragma unroll
    for (int it = 0; it < 3; ++it) {
        const int i = it * 512 + tid, o = i & 15, rest = i >> 4, tensor = rest % 3, tp = rest / 3, t0 = 2 * tp;
        const int cb = tensor * 1024 + h * 128 + o * 8;
        float x[5][8];
#pragma unroll
        for (int r = 0; r < 5; ++r) { const int t = t0 - 3 + r;
            if (t >= 0 || !first) { const u32x4 w = *(const u32x4*)(qkv + (size_t)(lr0 + t) * 3072 + cb);
                x[r][0] = bflo(w.x); x[r][1] = bfhi(w.x); x[r][2] = bflo(w.y); x[r][3] = bfhi(w.y); x[r][4] = bflo(w.z); x[r][5] = bfhi(w.z); x[r][6] = bflo(w.w); x[r][7] = bfhi(w.w); }
            else if (sample) { const float* hp = p.in[2] + ((size_t)hb * 3 + (3 + t)) * 3072 + cb;
#pragma unroll
                for (int k = 0; k < 8; ++k) x[r][k] = hp[k]; }
            else if (s == 0) {
#pragma unroll
                for (int k = 0; k < 8; ++k) x[r][k] = 0.f; }
            else { const float* hp = (const float*)(p.ws + WS_HQ + (size_t)((s - 1) & 1) * SZ_HQ) + ((size_t)hb * 3 + (3 + t)) * 3072 + cb;
#pragma unroll
                for (int k = 0; k < 8; ++k) x[r][k] = hp[k]; } }
        if (last && t0 + 1 == ntok - 1) {
#pragma unroll
            for (int r = 0; r < 3; ++r) {
                float* d1 = sample ? p.out + O_SGC + ((size_t)hb * 3 + r) * 3072 + cb : (float*)(p.ws + WS_HQ + (size_t)(s & 1) * SZ_HQ) + ((size_t)hb * 3 + r) * 3072 + cb;
#pragma unroll
                for (int k = 0; k < 8; ++k) d1[k] = x[2 + r][k];
                if (!sample && s == 7) { float* d2 = p.out + O_PGC + ((size_t)hb * 3 + r) * 3072 + cb;
#pragma unroll
                    for (int k = 0; k < 8; ++k) d2[k] = x[2 + r][k]; } } }
        f32x2_ yk[8]; f32x2_ ssv = {0.f, 0.f};
        float cw0[8], cw1[8], cw2[8], cw3[8];
        { const f32x4 q0 = *(const f32x4*)(cw + cb), q1 = *(const f32x4*)(cw + cb + 4), q2 = *(const f32x4*)(cw + 3072 + cb), q3 = *(const f32x4*)(cw + 3072 + cb + 4), q4 = *(const f32x4*)(cw + 6144 + cb), q5 = *(const f32x4*)(cw + 6144 + cb + 4), q6 = *(const f32x4*)(cw + 9216 + cb), q7 = *(const f32x4*)(cw + 9216 + cb + 4);
#pragma unroll
          for (int k = 0; k < 4; ++k) { cw0[k] = q0[k]; cw0[4 + k] = q1[k]; cw1[k] = q2[k]; cw1[4 + k] = q3[k]; cw2[k] = q4[k]; cw2[4 + k] = q5[k]; cw3[k] = q6[k]; cw3[4 + k] = q7[k]; } }
#pragma unroll
        for (int k = 0; k < 8; ++k) { const float w0 = cw0[k], w1 = cw1[k], w2 = cw2[k], w3 = cw3[k];
            f32x2_ ab = (f32x2_){x[0][k], x[1][k]} * w0 + (f32x2_){x[1][k], x[2][k]} * w1 + (f32x2_){x[2][k], x[3][k]} * w2 + (f32x2_){x[3][k], x[4][k]} * w3;
            f32x2_ ex; ex.x = __expf(-ab.x); ex.y = __expf(-ab.y); const f32x2_ den = ex + 1.0f; f32x2_ rc; rc.x = __builtin_amdgcn_rcpf(den.x); rc.y = __builtin_amdgcn_rcpf(den.y);
            ab = ab * rc; yk[k] = ab; ssv += ab * ab; }
        float ss0 = ssv.x, ss1 = ssv.y;
#pragma unroll
        for (int d = 1; d < 16; d <<= 1) { ss0 += __shfl_xor(ss0, d); ss1 += __shfl_xor(ss1, d); }
        const int t1 = t0 + 1; const bool v0 = t0 < ntok, v1 = t1 < ntok;
        f32x2_ mm;
        if (tensor == 0) { mm.x = rsqrtf(ss0 + 1e-6f) * 0.08838834764831845f; mm.y = rsqrtf(ss1 + 1e-6f) * 0.08838834764831845f; }
        else if (tensor == 1) { mm.x = rsqrtf(ss0 + 1e-6f); mm.y = rsqrtf(ss1 + 1e-6f); }
        else { mm.x = 1.f; mm.y = 1.f; }
        float y0[8], y1[8];
#pragma unroll
        for (int k = 0; k < 8; ++k) { f32x2_ q = yk[k] * mm; q.x = v0 ? q.x : 0.f; q.y = v1 ? q.y : 0.f; yk[k] = q; y0[k] = q.x; y1[k] = q.y; }
        const float b0 = sBeta[t0], b1 = sBeta[t1], eg0 = sEG[t0], eg1 = sEG[t1], et0 = sET[t0], et1 = sET[t1];
        const f32x2_ egv = {eg0, eg1}, etv = {et0, et1}, bv = {b0, b1}, begv = bv * egv;
        if (tensor == 0) {
            u32x4 w; w.x = cvt_pk_bf16(y0[0], y0[1]); w.y = cvt_pk_bf16(y0[2], y0[3]); w.z = cvt_pk_bf16(y0[4], y0[5]); w.w = cvt_pk_bf16(y0[6], y0[7]);
            *(LAS u32x4*)(lds + P_QB + t0 * 272 + o * 16) = w;
            w.x = cvt_pk_bf16(y1[0], y1[1]); w.y = cvt_pk_bf16(y1[2], y1[3]); w.z = cvt_pk_bf16(y1[4], y1[5]); w.w = cvt_pk_bf16(y1[6], y1[7]);
            *(LAS u32x4*)(lds + P_QB + t1 * 272 + o * 16) = w;
            const int kb = o >> 2, oo = o & 3, half = oo >> 1, g0 = (oo & 1) * 2;
#pragma unroll
            for (int tt = 0; tt < 2; ++tt) { const int t = t0 + tt; const float e = tt ? eg1 : eg0; const float* yy = tt ? y1 : y0; const int mt = t >> 4, m = t & 15;
                const int ck = (mt * 4 + kb) * 64 + g0 * 16 + m;
                u32x2 a; a.x = cvt_pk_bf16(yy[0] * e, yy[1] * e); a.y = cvt_pk_bf16(yy[2] * e, yy[3] * e); *(LAS u32x2*)(lds + P_OQD + pslot(ck) + half * 8) = a;
                a.x = cvt_pk_bf16(yy[4] * e, yy[5] * e); a.y = cvt_pk_bf16(yy[6] * e, yy[7] * e); *(LAS u32x2*)(lds + P_OQD + pslot(ck + 16) + half * 8) = a; }
        } else if (tensor == 1) {
            u32x4 w; w.x = cvt_pk_bf16(y0[0], y0[1]); w.y = cvt_pk_bf16(y0[2], y0[3]); w.z = cvt_pk_bf16(y0[4], y0[5]); w.w = cvt_pk_bf16(y0[6], y0[7]);
            *(LAS u32x4*)(lds + P_KB + t0 * 272 + o * 16) = w;
            w.x = cvt_pk_bf16(y1[0], y1[1]); w.y = cvt_pk_bf16(y1[2], y1[3]); w.z = cvt_pk_bf16(y1[4], y1[5]); w.w = cvt_pk_bf16(y1[6], y1[7]);
            *(LAS u32x4*)(lds + P_KB + t1 * 272 + o * 16) = w;
            const int dt = o >> 1, kb = t0 >> 5, r = t0 & 31, half = r >> 4, rr = r & 15, gp = rr >> 2, ep = half * 4 + (rr & 3);
#pragma unroll
            for (int k = 0; k < 8; ++k) { const int m = (o & 1) * 8 + k;
                const f32x2_ r1 = yk[k] * begv, r2 = yk[k] * etv;
                *(LAS unsigned*)(lds + P_RT + (128 + o * 8 + k) * 132 + t0 * 2) = cvt_pk_bf16(r1.x, r1.y);
                *(LAS unsigned*)(lds + P_OKT + pslot((dt * 2 + kb) * 64 + gp * 16 + m) + ep * 2) = cvt_pk_bf16(r2.x, r2.y); }
        } else {
#pragma unroll
            for (int k = 0; k < 8; ++k) { const f32x2_ r1 = yk[k] * bv; *(LAS unsigned*)(lds + P_RT + (o * 8 + k) * 132 + t0 * 2) = cvt_pk_bf16(r1.x, r1.y); }
        }
    }
    __syncthreads();
    const int n = lane & 15, g = lane >> 4;
    {
        const int itile = wid >> 1;
        bf16x8 ak[4], aq[4];
#pragma unroll
        for (int kb = 0; kb < 4; ++kb) { ak[kb] = *(const LAS bf16x8*)(lds + P_KB + (itile * 16 + n) * 272 + kb * 64 + g * 16); aq[kb] = *(const LAS bf16x8*)(lds + P_QB + (itile * 16 + n) * 272 + kb * 64 + g * 16); }
#pragma unroll
        for (int jj = 0; jj < 2; ++jj) { const int jt = (wid & 1) * 2 + jj;
            f32x4 ckk = {0.f, 0.f, 0.f, 0.f}, cqk = {0.f, 0.f, 0.f, 0.f};
#pragma unroll
            for (int kb = 0; kb < 4; ++kb) { const bf16x8 bk = *(const LAS bf16x8*)(lds + P_KB + (jt * 16 + n) * 272 + kb * 64 + g * 16);
                ckk = __builtin_amdgcn_mfma_f32_16x16x32_bf16(ak[kb], bk, ckk, 0, 0, 0); cqk = __builtin_amdgcn_mfma_f32_16x16x32_bf16(aq[kb], bk, cqk, 0, 0, 0); }
            const int j = jt * 16 + n; const float Gj = sG[j];
#pragma unroll
            for (int e = 0; e < 4; ++e) { const int i = itile * 16 + 4 * g + e; const float dd = fminf(sG[i] - Gj, 0.f), ex = __expf(dd);
                const float av = (j < i) ? sBeta[i] * ckk[e] * ex : 0.f, qv = (j <= i) ? cqk[e] * ex : 0.f;
                *(LAS bf16_t*)(lds + P_ABF + i * 136 + j * 2) = f2bf(-av);
                if (itile == jt) *(LAS float*)(lds + P_ADIAG + ((itile * 16 + 4 * g + e) * 16 + n) * 4) = av;
                const int kb2 = jt >> 1, half = jt & 1, gp = n >> 2, ep = half * 4 + (n & 3), m = 4 * g + e;
                *(LAS bf16_t*)(lds + P_OQK + pslot((itile * 2 + kb2) * 64 + gp * 16 + m) + ep * 2) = f2bf(qv); }
        }
    }
    __syncthreads();
    if (wid == 0) {
        const int blk = lane >> 4, c = lane & 15; const LAS float* A = (const LAS float*)(lds + P_ADIAG) + blk * 256;
        float T[16];
#pragma unroll
        for (int r = 0; r < 16; ++r) { float a = (r == c) ? 1.f : 0.f;
#pragma unroll
            for (int jx = 0; jx < r; ++jx) a -= A[r * 16 + jx] * T[jx];
            T[r] = a; }
#pragma unroll
        for (int r = 0; r < 16; ++r) *(LAS bf16_t*)(lds + P_TB + (blk * 16 + r) * 40 + c * 2) = f2bf(T[r]);
    }
    __syncthreads();
    {
        bf16x8 Xop[2][2];
#pragma unroll
        for (int a = 0; a < 2; ++a)
#pragma unroll
            for (int b = 0; b < 2; ++b) Xop[a][b] = mk8(0u, 0u, 0u, 0u);
        unsigned xw[2][2][4];
#pragma unroll
        for (int a = 0; a < 2; ++a)
#pragma unroll
            for (int b = 0; b < 2; ++b)
#pragma unroll
                for (int c = 0; c < 4; ++c) xw[a][b][c] = 0u;
#pragma unroll
        for (int blk = 0; blk < 4; ++blk) {
            f32x4 acc[2];
#pragma unroll
            for (int ct = 0; ct < 2; ++ct) { const int f = 32 * wid + 16 * ct + n; const LAS unsigned* rp = (const LAS unsigned*)(lds + P_RT + f * 132 + 32 * blk + 8 * g);
                const unsigned r0 = rp[0], r1 = rp[1]; acc[ct] = (f32x4){bflo(r0), bfhi(r0), bflo(r1), bfhi(r1)}; }
            if (blk >= 1) { const LAS unsigned char* ap = lds + P_ABF + (blk * 16 + n) * 136 + 8 * g; const u32x2 a0 = *(const LAS u32x2*)ap, a1 = *(const LAS u32x2*)(ap + 32);
                const bf16x8 A = mk8(a0.x, a0.y, a1.x, a1.y);
#pragma unroll
                for (int ct = 0; ct < 2; ++ct) acc[ct] = __builtin_amdgcn_mfma_f32_16x16x32_bf16(A, mk8(xw[0][ct][0], xw[0][ct][1], xw[0][ct][2], xw[0][ct][3]), acc[ct], 0, 0, 0); }
            if (blk == 3) { const LAS unsigned char* ap = lds + P_ABF + (blk * 16 + n) * 136 + 64 + 8 * g; const u32x2 a0 = *(const LAS u32x2*)ap, a1 = *(const LAS u32x2*)(ap + 32);
                const bf16x8 A = mk8(a0.x, a0.y, a1.x, a1.y);
#pragma unroll
                for (int ct = 0; ct < 2; ++ct) acc[ct] = __builtin_amdgcn_mfma_f32_16x16x32_bf16(A, mk8(xw[1][ct][0], xw[1][ct][1], xw[1][ct][2], xw[1][ct][3]), acc[ct], 0, 0, 0); }
            const u32x2 tv = *(const LAS u32x2*)(lds + P_TB + (blk * 16 + n) * 40 + 8 * g);
            const bf16x8 Top = mk8(tv.x, tv.y, 0u, 0u);
#pragma unroll
            for (int ct = 0; ct < 2; ++ct) {
                const bf16x8 Yop = mk8(cvt_pk_bf16(acc[ct][0], acc[ct][1]), cvt_pk_bf16(acc[ct][2], acc[ct][3]), 0u, 0u);
                f32x4 x = {0.f, 0.f, 0.f, 0.f}; x = __builtin_amdgcn_mfma_f32_16x16x32_bf16(Top, Yop, x, 0, 0, 0);
                const unsigned p0 = cvt_pk_bf16(x[0], x[1]), p1 = cvt_pk_bf16(x[2], x[3]);
                xw[blk >> 1][ct][(blk & 1) * 2] = p0; xw[blk >> 1][ct][(blk & 1) * 2 + 1] = p1;
                if (wid < 4) { const int wv = 2 * wid + ct; u32x2 st; st.x = p0; st.y = p1; *(LAS u32x2*)(lds + P_OU + ((wv * 4 + blk) * 64 + lane) * 8) = st; }
                else { const int kbp = wid - 4, gp = n >> 2, ep = ct * 4 + (n & 3);
#pragma unroll
                    for (int e = 0; e < 4; ++e) { const int mp = 4 * g + e; *(LAS bf16_t*)(lds + P_OW + pslot((blk * 4 + kbp) * 64 + gp * 16 + mp) + ep * 2) = f2bf(-x[e]); } }
            }
        }
        (void)Xop;
    }
    __syncthreads();
#pragma unroll
    for (int i = 0; i < 9; ++i) { const int c = i * 512 + tid;
        int off; if (i < 2) off = P_OW + pslot(c); else if (i < 4) off = P_OQD + pslot(c - 1024); else if (i < 6) off = P_OKT + pslot(c - 2048); else if (i < 7) off = P_OQK + pslot(c - 3072); else off = P_OU + (c - 3584) * 16;
        *(u32x4*)(rec + (size_t)c * 16) = *(const LAS u32x4*)(lds + off); }
    __syncthreads();
}
__device__ void stage_prep(const Params& p, int s, LAS unsigned char* lds, int vid, int V) {
    const int nu = s < 8 ? 512 : 256;
    for (int idx = vid; idx < nu; idx += V) prep_unit(p, s, idx, lds);
}

__device__ void scan_chain(const Params& p, int s, int chain, LAS unsigned char* lds) {
    const int tid = opaque_tid(), wv = tid >> 6, lane = tid & 63, n = lane & 15, g = lane >> 4;
    const bool sample = (s == 8);
    int h, lr0, nch, ntok; const unsigned char* rec; const float* Sin; float* Sout;
    if (!sample) { const int b = chain >> 3; h = chain & 7; lr0 = b * 2048; nch = 32; ntok = 64; rec = p.ws + WS_REC + (size_t)(s & 1) * SZ_REC + (size_t)chain * 32 * REC_BYTES;
        Sout = p.out + O_PS + (size_t)chain * 16384; Sin = s == 0 ? nullptr : Sout; }
    else { const int seq = chain >> 3; h = chain & 7; lr0 = seq * 16; nch = 1; ntok = 16; rec = p.ws + WS_REC + (size_t)(s & 1) * SZ_REC + (size_t)chain * REC_BYTES;
        Sin = p.in[3] + (size_t)chain * 16384; Sout = p.out + O_SS + (size_t)chain * 16384; }
    bf16_t* orow = (bf16_t*)(p.ws + WS_ORAW + (size_t)(s & 1) * SZ_G1) + (size_t)(lr0 + lane) * 1024 + h * 128 + wv * 16;
    f32x4 S[8];
#pragma unroll
    for (int dt = 0; dt < 8; ++dt) S[dt] = (f32x4){0.f, 0.f, 0.f, 0.f};
    if (Sin) {
#pragma unroll
        for (int i = 0; i < 8; ++i) *(LAS u32x4*)(lds + (i * 512 + tid) * 16) = *(const u32x4*)((const unsigned char*)Sin + (size_t)(i * 512 + tid) * 16);
        __syncthreads();
        const LAS float* sp = (const LAS float*)lds + (4 * g) * 128 + wv * 16 + n;
#pragma unroll
        for (int dt = 0; dt < 8; ++dt)
#pragma unroll
            for (int e = 0; e < 4; ++e) S[dt][e] = sp[(dt * 16 + e) * 128];
        __syncthreads();
    }
    u32x4 pre[9];
#pragma unroll
    for (int i = 0; i < 9; ++i) pre[i] = __builtin_nontemporal_load((const u32x4*)(rec + (size_t)(i * 512 + tid) * 16));
#pragma unroll
    for (int i = 0; i < 9; ++i) *(LAS u32x4*)(lds + (i * 512 + tid) * 16) = pre[i];
    __syncthreads();
#pragma unroll 1
    for (int c = 0; c < nch; ++c) {
        const unsigned char* rc = rec + (size_t)c * REC_BYTES;
        const bool more = c + 1 < nch;
        if (more) {
#pragma unroll
            for (int i = 0; i < 9; ++i) pre[i] = __builtin_nontemporal_load((const u32x4*)(rc + REC_BYTES + (size_t)(i * 512 + tid) * 16)); }
        const float gamma = *(const float*)(rc + R_HDR);
        const LAS unsigned char* cur = lds + (c & 1) * 73728;
        bf16x8 Sop[4];
#pragma unroll
        for (int kb = 0; kb < 4; ++kb) Sop[kb] = mk8(cvt_pk_bf16(S[2 * kb][0], S[2 * kb][1]), cvt_pk_bf16(S[2 * kb][2], S[2 * kb][3]), cvt_pk_bf16(S[2 * kb + 1][0], S[2 * kb + 1][1]), cvt_pk_bf16(S[2 * kb + 1][2], S[2 * kb + 1][3]));
        f32x4 vn[4], oa[4];
#pragma unroll
        for (int mt = 0; mt < 4; ++mt) { const u32x2 uu = *(const LAS u32x2*)(cur + R_U + ((wv * 4 + mt) * 64 + lane) * 8);
            f32x4 a = {bflo(uu.x), bfhi(uu.x), bflo(uu.y), bfhi(uu.y)}; f32x4 o = {0.f, 0.f, 0.f, 0.f};
#pragma unroll
            for (int kb = 0; kb < 4; ++kb) { const bf16x8 wf = *(const LAS bf16x8*)(cur + R_W + ((mt * 4 + kb) * 64 + lane) * 16); const bf16x8 qf = *(const LAS bf16x8*)(cur + R_QD + ((mt * 4 + kb) * 64 + lane) * 16);
                a = __builtin_amdgcn_mfma_f32_16x16x32_bf16(wf, Sop[kb], a, 0, 0, 0); o = __builtin_amdgcn_mfma_f32_16x16x32_bf16(qf, Sop[kb], o, 0, 0, 0); }
            vn[mt] = a; oa[mt] = o; __builtin_amdgcn_sched_barrier(0); }
        bf16x8 Vop[2];
#pragma unroll
        for (int kb = 0; kb < 2; ++kb) Vop[kb] = mk8(cvt_pk_bf16(vn[2 * kb][0], vn[2 * kb][1]), cvt_pk_bf16(vn[2 * kb][2], vn[2 * kb][3]), cvt_pk_bf16(vn[2 * kb + 1][0], vn[2 * kb + 1][1]), cvt_pk_bf16(vn[2 * kb + 1][2], vn[2 * kb + 1][3]));
#pragma unroll
        for (int mt = 0; mt < 4; ++mt) {
#pragma unroll
            for (int kb = 0; kb < 2; ++kb) { const bf16x8 qk = *(const LAS bf16x8*)(cur + R_QK + ((mt * 2 + kb) * 64 + lane) * 16); oa[mt] = __builtin_amdgcn_mfma_f32_16x16x32_bf16(qk, Vop[kb], oa[mt], 0, 0, 0); }
            { LAS unsigned char* wreg = (LAS unsigned char*)cur + R_U + wv * 2048 + (mt * 16 + 4 * g) * 32 + n * 2;
#pragma unroll
              for (int e = 0; e < 4; ++e) *(LAS bf16_t*)(wreg + e * 32) = f2bf(oa[mt][e]); }
            __builtin_amdgcn_sched_barrier(0); }
        { const LAS unsigned char* wreg = cur + R_U + wv * 2048 + lane * 32; const u32x4 o0 = *(const LAS u32x4*)wreg, o1 = *(const LAS u32x4*)(wreg + 16);
          if (lane < ntok) { bf16_t* op = orow + (size_t)c * 64 * 1024; *(u32x4*)op = o0; *(u32x4*)(op + 8) = o1; } }
#pragma unroll
        for (int dt = 0; dt < 8; ++dt) { S[dt] *= gamma;
#pragma unroll
            for (int kb = 0; kb < 2; ++kb) { const bf16x8 kf = *(const LAS bf16x8*)(cur + R_KT + ((dt * 2 + kb) * 64 + lane) * 16); S[dt] = __builtin_amdgcn_mfma_f32_16x16x32_bf16(kf, Vop[kb], S[dt], 0, 0, 0); } if (dt & 1) __builtin_amdgcn_sched_barrier(0); }
        if (more) {
#pragma unroll
            for (int i = 0; i < 9; ++i) *(LAS u32x4*)(lds + ((c + 1) & 1) * 73728 + (i * 512 + tid) * 16) = pre[i]; }
        __syncthreads();
    }
    {
        LAS float* sp = (LAS float*)lds + (4 * g) * 128 + wv * 16 + n;
#pragma unroll
        for (int dt = 0; dt < 8; ++dt)
#pragma unroll
            for (int e = 0; e < 4; ++e) sp[(dt * 16 + e) * 128] = S[dt][e];
        __syncthreads();
#pragma unroll
        for (int i = 0; i < 8; ++i) *(u32x4*)((unsigned char*)Sout + (size_t)(i * 512 + tid) * 16) = *(const LAS u32x4*)(lds + (i * 512 + tid) * 16);
    }
}
__device__ void stage_scan(const Params& p, int s, LAS unsigned char* lds) {
    const int G = gridDim.x;
    if (s < 8) { const int j = G - 1 - (int)blockIdx.x; for (int ch = j; ch < 16; ch += G) { scan_chain(p, s, ch, lds); __syncthreads(); } }
    else { for (int ch = blockIdx.x; ch < 256; ch += G) { scan_chain(p, s, ch, lds); __syncthreads(); } }
}

__device__ void stage_merge(const Params& p, int s, int vid, int V) {
    const int tid = opaque_tid(), wid = tid >> 6, lane = tid & 63;
    const bool sample = (s == 8); const int rows = slab_rows(s);
    const bf16_t* oraw = (const bf16_t*)(p.ws + WS_ORAW + (size_t)(s & 1) * SZ_G1);
    const bf16_t* gE = (const bf16_t*)(p.ws + WS_GATE + (size_t)(s & 3) * SZ_GATE); const bf16_t* gR = gE + (size_t)4096 * 1024; const bf16_t* gP = gR + (size_t)4096 * 1024;
    bf16_t* mix = (bf16_t*)(p.ws + WS_MIX + (size_t)(s & 1) * SZ_G1);
    const float* scw = p.in[11];
    const int nitem = (rows >> 2) * 2;
    for (int it = vid * 8 + wid; it < nitem; it += V * 8) {
        const int lr0 = (it >> 1) * 4, ch = ((it & 1) * 64 + lane) * 8;
        const int hb = sample ? (lr0 >> 4) : (lr0 >> 11), tl0 = sample ? (lr0 & 15) : (lr0 & 2047), tlast = sample ? 15 : 2047;
        float w0[8], w1[8], w2[8], pm2[8], pm1[8];
        { const f32x4 q0 = *(const f32x4*)(scw + ch), q1 = *(const f32x4*)(scw + ch + 4), q2 = *(const f32x4*)(scw + 1024 + ch), q3 = *(const f32x4*)(scw + 1024 + ch + 4), q4 = *(const f32x4*)(scw + 2048 + ch), q5 = *(const f32x4*)(scw + 2048 + ch + 4);
#pragma unroll
          for (int k = 0; k < 4; ++k) { w0[k] = q0[k]; w0[4 + k] = q1[k]; w1[k] = q2[k]; w1[4 + k] = q3[k]; w2[k] = q4[k]; w2[4 + k] = q5[k]; } }
        if (tl0 > 0) { const u32x4 u0 = *(const u32x4*)(gP + (size_t)(lr0 - 2) * 1024 + ch), u1 = *(const u32x4*)(gP + (size_t)(lr0 - 1) * 1024 + ch);
            pm2[0] = bflo(u0.x); pm2[1] = bfhi(u0.x); pm2[2] = bflo(u0.y); pm2[3] = bfhi(u0.y); pm2[4] = bflo(u0.z); pm2[5] = bfhi(u0.z); pm2[6] = bflo(u0.w); pm2[7] = bfhi(u0.w);
            pm1[0] = bflo(u1.x); pm1[1] = bfhi(u1.x); pm1[2] = bflo(u1.y); pm1[3] = bfhi(u1.y); pm1[4] = bflo(u1.z); pm1[5] = bfhi(u1.z); pm1[6] = bflo(u1.w); pm1[7] = bfhi(u1.w); }
        else { const float* hp = sample ? p.in[4] + (size_t)hb * 2 * 1024 + ch : (s == 0 ? nullptr : (const float*)(p.ws + WS_HS + (size_t)((s - 1) & 1) * SZ_HS) + (size_t)hb * 2 * 1024 + ch);
#pragma unroll
            for (int k = 0; k < 8; ++k) { pm2[k] = hp ? hp[k] : 0.f; pm1[k] = hp ? hp[1024 + k] : 0.f; } }
#pragma unroll
        for (int r = 0; r < 4; ++r) { const int lr = lr0 + r;
            const u32x4 ow = *(const u32x4*)(oraw + (size_t)lr * 1024 + ch);
            const float o[8] = {bflo(ow.x), bfhi(ow.x), bflo(ow.y), bfhi(ow.y), bflo(ow.z), bfhi(ow.z), bflo(ow.w), bfhi(ow.w)};
            float ss = 0.f;
#pragma unroll
            for (int k = 0; k < 8; ++k) ss += o[k] * o[k];
#pragma unroll
            for (int d = 1; d < 16; d <<= 1) ss += __shfl_xor(ss, d);
            const float rstd = rsqrtf(ss * (1.0f / 128.0f) + 1e-6f);
            const u32x4 ew = __builtin_nontemporal_load((const u32x4*)(gE + (size_t)lr * 1024 + ch)), rw = __builtin_nontemporal_load((const u32x4*)(gR + (size_t)lr * 1024 + ch)), pw = *(const u32x4*)(gP + (size_t)lr * 1024 + ch);
            const float E[8] = {bflo(ew.x), bfhi(ew.x), bflo(ew.y), bfhi(ew.y), bflo(ew.z), bfhi(ew.z), bflo(ew.w), bfhi(ew.w)};
            const float R[8] = {bflo(rw.x), bfhi(rw.x), bflo(rw.y), bfhi(rw.y), bflo(rw.z), bfhi(rw.z), bflo(rw.w), bfhi(rw.w)};
            const float P[8] = {bflo(pw.x), bfhi(pw.x), bflo(pw.y), bfhi(pw.y), bflo(pw.z), bfhi(pw.z), bflo(pw.w), bfhi(pw.w)};
            float m[8];
#pragma unroll
            for (int k = 0; k < 8; k += 2) { const f32x2_ c3 = (f32x2_){w0[k], w0[k + 1]} * (f32x2_){pm2[k], pm2[k + 1]} + (f32x2_){w1[k], w1[k + 1]} * (f32x2_){pm1[k], pm1[k + 1]} + (f32x2_){w2[k], w2[k + 1]} * (f32x2_){P[k], P[k + 1]};
                const f32x2_ mm = (f32x2_){o[k], o[k + 1]} * rstd * (f32x2_){E[k], E[k + 1]} + (f32x2_){R[k], R[k + 1]} * c3; m[k] = mm.x; m[k + 1] = mm.y; pm2[k] = pm1[k]; pm2[k + 1] = pm1[k + 1]; pm1[k] = P[k]; pm1[k + 1] = P[k + 1]; }
            u32x4 w; w.x = cvt_pk_bf16(m[0], m[1]); w.y = cvt_pk_bf16(m[2], m[3]); w.z = cvt_pk_bf16(m[4], m[5]); w.w = cvt_pk_bf16(m[6], m[7]);
            *(u32x4*)(mix + (size_t)lr * 1024 + ch) = w; }
        if (tl0 + 3 == tlast) {
            float* d1 = sample ? p.out + O_SSC + (size_t)hb * 2 * 1024 + ch : (float*)(p.ws + WS_HS + (size_t)(s & 1) * SZ_HS) + (size_t)hb * 2 * 1024 + ch;
#pragma unroll
            for (int k = 0; k < 8; ++k) { d1[k] = pm2[k]; d1[1024 + k] = pm1[k]; }
            if (!sample && s == 7) { float* d2 = p.out + O_PSC + (size_t)hb * 2 * 1024 + ch;
#pragma unroll
                for (int k = 0; k < 8; ++k) { d2[k] = pm2[k]; d2[1024 + k] = pm1[k]; } } }
    }
}

__device__ void stage_ln(const Params& p, int s, int which, int vid, int V) {
    const int tid = opaque_tid(), wid = tid >> 6, lane = tid & 63; const int rows = slab_rows(s);
    const float* gam = p.in[which ? 18 : 13]; const float* bet = p.in[which ? 19 : 14];
    const float* stats = (const float*)(p.ws + WS_STATS); bf16_t* x1b = (bf16_t*)(p.ws + WS_X1B + (size_t)(s & 3) * SZ_G1);
    const bf16_t* pre1 = (const bf16_t*)(p.ws + (which ? WS_PRE2 : WS_PRE1) + (size_t)(s & 1) * SZ_G1);
    for (int lr = vid * 8 + wid; lr < rows; lr += V * 8) {
        const int grow = grow_of(s, lr); float* yp = p.out + O_YP + (size_t)grow * 1024;
        f32x4 v[4];
#pragma unroll
        for (int i = 0; i < 4; ++i) { const u32x2 q = __builtin_nontemporal_load((const u32x2*)(pre1 + (size_t)lr * 1024 + lane * 4 + 256 * i)); v[i] = (f32x4){bflo(q.x), bfhi(q.x), bflo(q.y), bfhi(q.y)}; }
        float mu, rstd;
        if (which && s >= SPLIT_FROM) {
            const bf16_t* p2 = (const bf16_t*)(p.ws + WS_PRE2B + (size_t)(s & 1) * SZ_G1) + (size_t)lr * 1024; float sm = 0.f;
#pragma unroll
            for (int i = 0; i < 4; ++i) { const u32x2 q = *(const u32x2*)(p2 + lane * 4 + 256 * i); v[i] += (f32x4){bflo(q.x), bfhi(q.x), bflo(q.y), bfhi(q.y)}; sm += (v[i][0] + v[i][1]) + (v[i][2] + v[i][3]); }
#pragma unroll
            for (int d = 32; d >= 1; d >>= 1) sm += __shfl_xor(sm, d);
            mu = sm * (1.0f / 1024.0f); float sq = 0.f;
#pragma unroll
            for (int i = 0; i < 4; ++i) { const f32x4 dv = v[i] - mu; sq += (dv[0] * dv[0] + dv[1] * dv[1]) + (dv[2] * dv[2] + dv[3] * dv[3]); }
#pragma unroll
            for (int d = 32; d >= 1; d >>= 1) sq += __shfl_xor(sq, d);
            rstd = rsqrtf(sq * (1.0f / 1024.0f) + 1e-5f);
        } else {
            const float sm = stats[(size_t)grow * 4 + which * 2], sq = stats[(size_t)grow * 4 + which * 2 + 1];
            mu = sm * (1.0f / 1024.0f); const float var = fmaxf(sq * (1.0f / 1024.0f) - mu * mu, 0.f); rstd = rsqrtf(var + 1e-5f);
        }
#pragma unroll
        for (int i = 0; i < 4; ++i) { const int c = lane * 4 + 256 * i; const f32x4 gg = *(const f32x4*)(gam + c), bb = *(const f32x4*)(bet + c);
            const f32x4 o = (v[i] - mu) * rstd * gg + bb;
            if (which) __builtin_nontemporal_store(o, (f32x4*)(yp + c)); else { u32x2 w; w.x = cvt_pk_bf16(o[0], o[1]); w.y = cvt_pk_bf16(o[2], o[3]); *(u32x2*)(x1b + (size_t)lr * 1024 + c) = w; } }
    }
}

__device__ void stage_glu(const Params& p, int s, int vid, int V) {
    const bool sample = (s == 8); const int rows = slab_rows(s);
    const bf16_t* av = (const bf16_t*)(p.ws + WS_AV + (size_t)(s & 1) * SZ_AV); bf16_t* hh = (bf16_t*)(p.ws + WS_H + (size_t)(s & 1) * SZ_H);
    const float* fw = p.in[16];
    const int total = (rows >> 3) * 352;
    const int tid = opaque_tid();
    for (int it = vid * 512 + tid; it < total; it += V * 512) {
        const int blk = it / 352, oc = it - blk * 352, ch = oc * 8, lr0 = blk * 8;
        const int hb = sample ? (lr0 >> 4) : (lr0 >> 11), tl0 = sample ? (lr0 & 15) : (lr0 & 2047), tlast = sample ? 15 : 2047;
        float w0[8], w1[8], w2[8], am2[8], am1[8];
        { const f32x4 q0 = *(const f32x4*)(fw + ch), q1 = *(const f32x4*)(fw + ch + 4), q2 = *(const f32x4*)(fw + 2816 + ch), q3 = *(const f32x4*)(fw + 2816 + ch + 4), q4 = *(const f32x4*)(fw + 5632 + ch), q5 = *(const f32x4*)(fw + 5632 + ch + 4);
#pragma unroll
          for (int k = 0; k < 4; ++k) { w0[k] = q0[k]; w0[4 + k] = q1[k]; w1[k] = q2[k]; w1[4 + k] = q3[k]; w2[k] = q4[k]; w2[4 + k] = q5[k]; } }
        if (tl0 > 0) { const u32x4 u0 = *(const u32x4*)(av + (size_t)(lr0 - 2) * 5632 + ch), u1 = *(const u32x4*)(av + (size_t)(lr0 - 1) * 5632 + ch);
            am2[0] = bflo(u0.x); am2[1] = bfhi(u0.x); am2[2] = bflo(u0.y); am2[3] = bfhi(u0.y); am2[4] = bflo(u0.z); am2[5] = bfhi(u0.z); am2[6] = bflo(u0.w); am2[7] = bfhi(u0.w);
            am1[0] = bflo(u1.x); am1[1] = bfhi(u1.x); am1[2] = bflo(u1.y); am1[3] = bfhi(u1.y); am1[4] = bflo(u1.z); am1[5] = bfhi(u1.z); am1[6] = bflo(u1.w); am1[7] = bfhi(u1.w); }
        else { const float* hp = sample ? p.in[5] + (size_t)hb * 2 * 2816 + ch : (s == 0 ? nullptr : (const float*)(p.ws + WS_HF + (size_t)((s - 1) & 1) * SZ_HF) + (size_t)hb * 2 * 2816 + ch);
#pragma unroll
            for (int k = 0; k < 8; ++k) { am2[k] = hp ? hp[k] : 0.f; am1[k] = hp ? hp[2816 + k] : 0.f; } }
#pragma unroll
        for (int r = 0; r < 8; ++r) {
            const u32x4 aw = *(const u32x4*)(av + (size_t)(lr0 + r) * 5632 + ch), vw = *(const u32x4*)(av + (size_t)(lr0 + r) * 5632 + 2816 + ch);
            const float a[8] = {bflo(aw.x), bfhi(aw.x), bflo(aw.y), bfhi(aw.y), bflo(aw.z), bfhi(aw.z), bflo(aw.w), bfhi(aw.w)};
            const float v[8] = {bflo(vw.x), bfhi(vw.x), bflo(vw.y), bfhi(vw.y), bflo(vw.z), bfhi(vw.z), bflo(vw.w), bfhi(vw.w)};
            float o[8];
#pragma unroll
            for (int k = 0; k < 8; k += 2) { const f32x2_ c3 = (f32x2_){w0[k], w0[k + 1]} * (f32x2_){am2[k], am2[k + 1]} + (f32x2_){w1[k], w1[k + 1]} * (f32x2_){am1[k], am1[k + 1]} + (f32x2_){w2[k], w2[k + 1]} * (f32x2_){a[k], a[k + 1]};
                const f32x2_ g2 = gelu_pk(c3) * (f32x2_){v[k], v[k + 1]}; o[k] = g2.x; o[k + 1] = g2.y; am2[k] = am1[k]; am2[k + 1] = am1[k + 1]; am1[k] = a[k]; am1[k + 1] = a[k + 1]; }
            u32x4 w; w.x = cvt_pk_bf16(o[0], o[1]); w.y = cvt_pk_bf16(o[2], o[3]); w.z = cvt_pk_bf16(o[4], o[5]); w.w = cvt_pk_bf16(o[6], o[7]);
            if (s >= SPLIT_FROM) *(u32x4*)(hh + (size_t)(ch >= 1408) * 4096 * 1408 + (size_t)(lr0 + r) * 1408 + (ch >= 1408 ? ch - 1408 : ch)) = w;
            else *(u32x4*)(hh + (size_t)(lr0 + r) * 2816 + ch) = w;
        }
        if (tl0 + 7 == tlast) {
            float* d1 = sample ? p.out + O_SFF + (size_t)hb * 2 * 2816 + ch : (float*)(p.ws + WS_HF + (size_t)(s & 1) * SZ_HF) + (size_t)hb * 2 * 2816 + ch;
#pragma unroll
            for (int k = 0; k < 8; ++k) { d1[k] = am2[k]; d1[2816 + k] = am1[k]; }
            if (!sample && s == 7) { float* d2 = p.out + O_PFF + (size_t)hb * 2 * 2816 + ch;
#pragma unroll
                for (int k = 0; k < 8; ++k) { d2[k] = am2[k]; d2[2816 + k] = am1[k]; } } }
    }
}

#define XB_TMO      128
#define XB_XCNT(j)  (256  + 64 * (j))
#define XB_XSUB(j)  (1280 + 64 * (j))
#define XB_XGEN(j)  (2304 + 64 * (j))
#define XB_TOP      3328
#define XB_TOPGEN   3392
#define XCD_BAR_WORDS 3456
#define XB_SPIN_CAP (1u << 22)
__device__ __forceinline__ unsigned xb_ld(unsigned* p)              { return __hip_atomic_load(p, __ATOMIC_RELAXED, __HIP_MEMORY_SCOPE_AGENT); }
__device__ __forceinline__ unsigned xb_add(unsigned* p, unsigned v) { return __hip_atomic_fetch_add(p, v, __ATOMIC_RELAXED, __HIP_MEMORY_SCOPE_AGENT); }
__device__ __forceinline__ unsigned xb_xcc_id() { return (unsigned)__builtin_amdgcn_s_getreg((3 << 11) | 20) & 0xFu; }
#define XB_SPIN(cond, bar) do { unsigned _sp = 0; while (cond) { __builtin_amdgcn_s_sleep(1); \
    if ((++_sp & 255u) == 0u) { if (xb_ld(&(bar)[XB_TMO])) break; if (_sp > XB_SPIN_CAP) { atomicAdd(&(bar)[XB_TMO], 1u); break; } } } } while (0)
struct XcdBarrier { unsigned* bar; unsigned x; volatile LAS unsigned* st; };
__device__ __forceinline__ XcdBarrier xcd_barrier_post(unsigned* bar, volatile LAS unsigned* st) {
    XcdBarrier b; b.bar = bar; b.x = xb_xcc_id(); b.st = st;
    if (threadIdx.x == 0) (void)xb_add(&bar[XB_XCNT(b.x)], 1u);
    return b;
}
__device__ __forceinline__ void xcd_barrier_complete(unsigned* bar, unsigned x, unsigned& nloc, unsigned& nx) {
    const unsigned G = gridDim.x * gridDim.y * gridDim.z;
    unsigned sum, cnt, mine, sp = 0u;
    for (;;) {
        sum = 0u; cnt = 0u; mine = 0u;
#pragma unroll
        for (unsigned j = 0; j < 16; ++j) { const unsigned c = xb_ld(&bar[XB_XCNT(j)]); sum += c; cnt += (c > 0u) ? 1u : 0u; mine = (j == x) ? c : mine; }
        if (sum == G) break;
        __builtin_amdgcn_s_sleep(1);
        if ((++sp & 255u) == 0u) { if (xb_ld(&bar[XB_TMO])) break; if (sp > XB_SPIN_CAP) { atomicAdd(&bar[XB_TMO], 1u); break; } }
    }
    nloc = mine > 0u ? mine : 1u; nx = cnt > 0u ? cnt : 1u;
}
__device__ __forceinline__ void xcd_barrier(const XcdBarrier& b) {
    asm volatile("s_waitcnt vmcnt(0)" ::: "memory");
    __syncthreads();
    if (threadIdx.x == 0) {
        unsigned* bar = b.bar;
        __builtin_amdgcn_s_waitcnt(0);
        unsigned nloc = b.st[0], nx = b.st[1];
        if (nloc == 0u) { xcd_barrier_complete(bar, b.x, nloc, nx); b.st[0] = nloc; b.st[1] = nx; }
        const unsigned old = xb_add(&bar[XB_XSUB(b.x)], 1u);
        const unsigned gen = old / nloc;
        if (old + 1u == (gen + 1u) * nloc) {
            __builtin_amdgcn_fence(__ATOMIC_RELEASE, "agent");
            asm volatile("s_waitcnt vmcnt(0)" ::: "memory");
            const unsigned og = xb_add(&bar[XB_TOP], 1u);
            const unsigned tg = og / nx;
            if (og + 1u == (tg + 1u) * nx) xb_add(&bar[XB_TOPGEN], 1u);
            else XB_SPIN(xb_ld(&bar[XB_TOPGEN]) == tg, bar);
            __builtin_amdgcn_fence(__ATOMIC_ACQUIRE, "agent");
            xb_add(&bar[XB_XGEN(b.x)], 1u);
            asm volatile("s_waitcnt vmcnt(0)" ::: "memory");
        } else {
            XB_SPIN(xb_ld(&bar[XB_XGEN(b.x)]) == gen, bar);
            __builtin_amdgcn_fence(__ATOMIC_ACQUIRE, "agent");
            asm volatile("s_waitcnt vmcnt(0)" ::: "memory");
        }
    }
    __syncthreads();
}

extern "C" __global__ void __launch_bounds__(512) mega(Params p) {
    extern __shared__ __attribute__((aligned(16))) unsigned char smem_raw[];
    LAS unsigned char* lds = (LAS unsigned char*)smem_raw;
    const int w = blockIdx.x, G = gridDim.x;
    volatile LAS unsigned* bst = (volatile LAS unsigned*)(lds + LDS_BYTES - 16);
    if (threadIdx.x == 0) { bst[0] = 0u; bst[1] = 0u; }
    __syncthreads();
    XcdBarrier xb; xb.bar = (unsigned*)(p.ws + WS_BAR); xb.x = 0; xb.st = bst;
    if (p.use_sync == 1) xb = xcd_barrier_post((unsigned*)(p.ws + WS_BAR), bst);
    for (int i = p.i_lo; i < p.i_hi; ++i) {
        #ifndef NO_WCONV
        if (i < 3) { stage_wconv(p, lds, i == 0 ? 0 : (i == 1 ? 2304 : 3968), i == 0 ? 2304 : (i == 1 ? 3968 : 4672)); __syncthreads(); }
#endif
        #ifndef NO_SCAN
        { const int s = i - 3; if (valid_slab(s)) { stage_scan(p, s, lds); __syncthreads(); } }
#endif
        const int sd = i - 9, s1 = i - 1, su = i - 7, so = i - 5;
        const int nd = valid_slab(sd) ? slab_panels(sd) * 4 : 0, n1 = valid_slab(s1) ? slab_panels(s1) * 36 : 0, nu = valid_slab(su) ? slab_panels(su) * 22 : 0, no = valid_slab(so) ? slab_panels(so) * 4 : 0;
        const int ns = (valid_slab(i - 3) && i - 3 < 8) ? 16 : 0;
        const int cs = (n1 + nu + no <= 3 * (G - (nd > 0 && sd >= SPLIT_FROM ? 2 * nd : nd) - ns)) ? 3 : 2;
        const bool dsplit = nd > 0 && sd >= SPLIT_FROM; const int ndw = dsplit ? 2 * nd : nd;
        if (nd) { DealDown S; S.w = w; S.G = G; S.n = ndw; S.npm = slab_panels(sd); S.split = dsplit ? 1 : 0;
            Gemm g; g.base = (const char*)p.ws; g.oA0 = (long)(WS_H + (size_t)(sd & 1) * SZ_H); g.dA1 = dsplit ? (long)4096 * 1408 * 2 : 0; g.dA2 = 0; g.oB0 = dsplit ? (long)WS_WD2 : (long)WS_WD; g.dB1 = dsplit ? (long)1024 * 1408 * 2 : 0; g.dB2 = 0; g.K = dsplit ? 1408 : 2816;
            EpiRes E; E.resp = nullptr; E.ress = nullptr; E.resb = (const bf16_t*)(p.ws + WS_X1B + (size_t)(sd & 3) * SZ_G1); E.pre = (bf16_t*)(p.ws + WS_PRE2 + (size_t)(sd & 1) * SZ_G1); E.pre2b = (bf16_t*)(p.ws + WS_PRE2B + (size_t)(sd & 1) * SZ_G1); E.y = p.out + O_YP; E.stats = (float*)(p.ws + WS_STATS); E.s = sd; E.soff = dsplit ? -1 : 2; E.mode = 1;
            pg8::gemm_phase<EpiRes, DealDown, false>(lds, g, S, E, nullptr); __syncthreads(); }
        if (n1 + nu + no) { Deal S; S.w = w; S.G = G; S.nd = ndw; S.ns = ns; S.cs = cs; S.n1 = n1; S.nu = nu; S.no = no; S.p1 = n1 ? slab_panels(s1) : 1; S.pu = nu ? slab_panels(su) : 1; S.po = no ? slab_panels(so) : 1;
            Gemm g; g.base = (const char*)p.ws; g.K = 1024;
            { const long a0 = (long)(WS_XB + (size_t)(s1 & 1) * SZ_XB), a1 = (long)(WS_X1B + (size_t)(su & 3) * SZ_G1), a2 = (long)(WS_MIX + (size_t)(so & 1) * SZ_G1);
              g.oA0 = a0; g.dA1 = a1 - a0; g.dA2 = a2 - a1; g.oB0 = (long)WS_WIN; g.dB1 = (long)WS_WUP - (long)WS_WIN; g.dB2 = (long)WS_WO - (long)WS_WUP; }
            EpiMulti E; E.e0.qkv = (bf16_t*)(p.ws + WS_QKV + (size_t)(s1 & 1) * SZ_QKV); E.e0.gate = (bf16_t*)(p.ws + WS_GATE + (size_t)(s1 & 3) * SZ_GATE); E.e0.gnorm = p.in[10];
            E.e1.av = (bf16_t*)(p.ws + WS_AV + (size_t)(su & 1) * SZ_AV);
            E.e2.resp = p.in[0]; E.e2.ress = p.in[1]; E.e2.resb = nullptr; E.e2.pre = (bf16_t*)(p.ws + WS_PRE1 + (size_t)(so & 1) * SZ_G1); E.e2.pre2b = nullptr; E.e2.y = nullptr; E.e2.stats = (float*)(p.ws + WS_STATS); E.e2.s = so; E.e2.soff = 0; E.e2.mode = 0;
            pg8::gemm_phase<EpiMulti, Deal, false>(lds, g, S, E, nullptr); __syncthreads(); }
        const int Gl = G - ns;
        int V = Gl, vid0 = w < Gl ? w : -1, vid1 = -1;
        { const int T = n1 + nu + no;
          if (ndw > 0 && T <= G - ndw - ns) {
              V = Gl - ndw; vid0 = (w >= ndw && w < Gl) ? w - ndw : -1; }
          else if (T > 0) { int rs = 0, before = 0, cap = 0;
              for (;;) { cap = G - (rs < 3 ? ndw : 0) - (rs < cs ? ns : 0); if (before + cap >= T || cap <= 0) break; before += cap; ++rs; }
              const int cl = T - before;
              const bool part = (w >= ndw || rs >= 3) && w < Gl; const int rank = w - (rs < 3 ? (w < ndw ? w : ndw) : 0);
              const int capl = cap - ((rs >= cs) ? ns : 0);
              if (cl > 0 && cl < capl) { V = Gl + (capl - cl); if (part && rank >= cl) vid1 = Gl + (rank - cl); } } }
        for (int rep_ = 0; rep_ < 2; ++rep_) { const int vid = rep_ ? vid1 : vid0; if (vid < 0) continue;
            if (valid_slab(i)) for (int r_ = 0; r_ < (p.pad & 15); ++r_) { stage_cvt(p, i, lds, vid, V); __syncthreads(); }
            if (valid_slab(i - 2)) for (int r_ = 0; r_ < ((p.pad >> 4) & 15); ++r_) { stage_prep(p, i - 2, lds, vid, V); __syncthreads(); }
            if (valid_slab(i - 4)) for (int r_ = 0; r_ < ((p.pad >> 8) & 15); ++r_) stage_merge(p, i - 4, vid, V);
            if (valid_slab(i - 6)) stage_ln(p, i - 6, 0, vid, V);
            if (valid_slab(i - 8)) for (int r_ = 0; r_ < ((p.pad >> 12) & 15); ++r_) stage_glu(p, i - 8, vid, V);
            if (valid_slab(i - 10)) stage_ln(p, i - 10, 1, vid, V);
        }
        if (i + 1 < p.i_hi) { if (p.use_sync == 1) xcd_barrier(xb); else if (p.use_sync == 2) cg::this_grid().sync(); }
    }
}

#ifndef REPS
#define REPS 0x11111
#endif
#ifndef MK_LAUNCHES
#define MK_LAUNCHES 1
#endif
extern "C" void kernel_launch(void* const* d_in, const int* in_sizes, int n_in, void* d_out, int out_size, void* d_ws, size_t ws_size, hipStream_t stream) {
    static int grid = 0;
    if (grid == 0) {
        int dev = 0, cus = 0, per_cu = 0;
        hipGetDevice(&dev); hipDeviceGetAttribute(&cus, hipDeviceAttributeMultiprocessorCount, dev);
        if (hipFuncSetAttribute((const void*)mega, hipFuncAttributeMaxDynamicSharedMemorySize, LDS_BYTES) != hipSuccess) fprintf(stderr, "hipFuncSetAttribute failed\n");
        if (hipOccupancyMaxActiveBlocksPerMultiprocessor(&per_cu, (const void*)mega, 512, LDS_BYTES) != hipSuccess || per_cu < 1) { fprintf(stderr, "occupancy query: %d\n", per_cu); per_cu = 1; }
        (void)hipGetLastError();
        grid = cus * 1;
        if (ws_size < WS_END) { fprintf(stderr, "workspace too small: %zu < %zu\n", ws_size, (size_t)WS_END); grid = -1; }
    }
    if (grid < 0) return;
    if (hipMemsetAsync((unsigned char*)d_ws + WS_BAR, 0, 16384, stream) != hipSuccess) fprintf(stderr, "memset of barrier words failed\n");
    Params p{};
    for (int i = 0; i < 20; ++i) p.in[i] = (const float*)d_in[i];
    p.out = (float*)d_out; p.ws = (unsigned char*)d_ws;
#if MK_LAUNCHES == 1
    p.i_lo = 0; p.i_hi = NINT; p.use_sync = 1; p.pad = REPS;
    void* args[] = {&p};
    hipError_t e = hipLaunchCooperativeKernel((const void*)mega, dim3(grid), dim3(512), args, LDS_BYTES, stream);
    if (e != hipSuccess) fprintf(stderr, "cooperative launch failed: %s (grid %d)\n", hipGetErrorString(e), grid);
#else
    for (int i = 0; i < NINT; ++i) { p.i_lo = i; p.i_hi = i + 1; p.use_sync = 0; p.pad = 0; hipLaunchKernelGGL(mega, dim3(grid), dim3(512), LDS_BYTES, stream, p); }
#endif
}
```
